# Optimizing an MI355X kernel written in HIP

```python
import jax, jax.numpy as jnp
from jax import lax
import numpy as np

D_MODEL = 2048
BATCH = 4
SEQ = 2048
DEPTH = 1

MIX_WIDTH = D_MODEL
CONV_WIDTH = MIX_WIDTH // 4
ATTN_WIDTH = MIX_WIDTH - CONV_WIDTH
HEAD_DIM = 64
N_ATTN_HEADS = ATTN_WIDTH // HEAD_DIM
CONV_K = 3
ROT_DIM = HEAD_DIM // 4
ROPE_THETA = 500000.0
DILATED_PATTERNS = ((128, 1), (512, 4), (2048, 16))
BLOCK = 128
N_EXPERTS = 32
TOP_K = 4
D_EXPERT = D_MODEL
SWIGLU_LIMIT = 7.0
SWIGLU_ALPHA = 1.702
EXPERT_BLOCK = 128
EPS = 1e-5
IN_COLS = 3 * CONV_WIDTH + 3 * ATTN_WIDTH

kernel_name = "hybrid_conv_dilated_attn_moe"


def rmsnorm(x, g):
    xf = x.astype(jnp.float32)
    y = xf * lax.rsqrt(jnp.mean(xf * xf, axis=-1, keepdims=True) + EPS)
    return (y * g.astype(jnp.float32)).astype(x.dtype)


def partial_rotary(t):
    S_ = t.shape[1]
    inv_freq = ROPE_THETA ** (-jnp.arange(0, ROT_DIM, 2, dtype=jnp.float32) / ROT_DIM)
    ang = jnp.arange(S_, dtype=jnp.float32)[:, None] * inv_freq[None, :]
    cos = jnp.cos(ang)[None, :, None, :]
    sin = jnp.sin(ang)[None, :, None, :]
    rot = t[..., :ROT_DIM].astype(jnp.float32)
    x1, x2 = rot[..., :ROT_DIM // 2], rot[..., ROT_DIM // 2:]
    rotated = jnp.concatenate([x1 * cos - x2 * sin, x2 * cos + x1 * sin], axis=-1)
    return jnp.concatenate([rotated.astype(t.dtype), t[..., ROT_DIM:]], axis=-1)


def causal_short_conv(u, w):
    C = u.shape[-1]
    return lax.conv_general_dilated(
        u, w[:, None, :].astype(u.dtype), window_strides=(1,), padding=[(CONV_K - 1, 0)],
        dimension_numbers=("NWC", "WIO", "NWC"), feature_group_count=C)


def banded_causal_attention(q, k, v, window):
    B_, L, G, Dh = q.shape
    nblk = -(-L // BLOCK)
    pad = nblk * BLOCK - L
    padcfg = ((0, 0), (0, pad), (0, 0), (0, 0))
    qb = jnp.pad(q, padcfg).reshape(B_, nblk, BLOCK, G, Dh)
    kb = jnp.pad(k, padcfg).reshape(B_, nblk, BLOCK, G, Dh)
    vb = jnp.pad(v, padcfg).reshape(B_, nblk, BLOCK, G, Dh)
    zero = jnp.zeros_like(kb[:, :1])
    kk = jnp.concatenate([jnp.concatenate([zero, kb[:, :-1]], axis=1), kb], axis=2)
    vv = jnp.concatenate([jnp.concatenate([zero, vb[:, :-1]], axis=1), vb], axis=2)
    s = jnp.einsum("bnqgd,bnkgd->bngqk", qb, kk).astype(jnp.float32) * (Dh ** -0.5)
    qpos = BLOCK + jnp.arange(BLOCK)
    kpos = jnp.arange(2 * BLOCK)
    dist = qpos[:, None] - kpos[None, :]
    band = (dist >= 0) & (dist <= window)
    key_abs = jnp.arange(nblk)[:, None, None] * BLOCK - BLOCK + kpos[None, None, :]
    mask = band[None] & (key_abs >= 0)
    s = jnp.where(mask[None, :, None], s, -jnp.inf)
    m = jnp.max(s, axis=-1, keepdims=True)
    p = jnp.exp(s - m)
    l = jnp.sum(p, axis=-1, keepdims=True)
    o = jnp.einsum("bngqk,bnkgd->bnqgd", p, vv.astype(jnp.float32)) / jnp.swapaxes(l, 2, 3)
    lse = jnp.swapaxes((m + jnp.log(l))[..., 0], 2, 3)
    o = o.reshape(B_, nblk * BLOCK, G, Dh)[:, :L]
    lse = lse.reshape(B_, nblk * BLOCK, G)[:, :L]
    return o, lse


def dilated_branch(q, k, v, window, dilation):
    B_, S_, H, Dh = q.shape
    L = S_ // dilation
    to_cls = lambda t: t.reshape(B_, L, dilation * H, Dh)
    o, lse = banded_causal_attention(to_cls(q), to_cls(k), to_cls(v), window // dilation)
    return o.reshape(B_, S_, H, Dh), lse.reshape(B_, S_, H)


def dilated_attention(q, k, v):
    outs, lses = [], []
    for window, dilation in DILATED_PATTERNS:
        o, lse = dilated_branch(q, k, v, window, dilation)
        outs.append(o)
        lses.append(lse)
    wts = jax.nn.softmax(jnp.stack(lses, axis=0), axis=0)
    o = jnp.sum(wts[..., None] * jnp.stack(outs, axis=0), axis=0)
    return o.astype(q.dtype)


def clamped_swiglu_expert(xb, w_gu, b_gu, w_dn, b_dn):
    gu = xb @ w_gu + b_gu
    gate, up = gu[:, :D_EXPERT], gu[:, D_EXPERT:]
    gate = jnp.minimum(gate, SWIGLU_LIMIT)
    up = jnp.clip(up, -SWIGLU_LIMIT, SWIGLU_LIMIT)
    act = (up + 1.0) * (gate * jax.nn.sigmoid(SWIGLU_ALPHA * gate))
    return act @ w_dn + b_dn


def moe_ffn(h, w_router, b_router, w_gate_up, b_gate_up, w_down, b_down):
    B_, S_, D = h.shape
    N = B_ * S_
    t = h.reshape(N, D)
    logits = (t @ w_router + b_router).astype(jnp.float32)
    top_val, top_idx = lax.top_k(logits, TOP_K)
    gates = jax.nn.softmax(top_val, axis=-1)
    A = N * TOP_K
    flat_e = top_idx.reshape(A)
    order = jnp.argsort(flat_e)
    sorted_e = flat_e[order]
    sorted_tok = order // TOP_K
    counts = jnp.bincount(flat_e, length=N_EXPERTS)
    starts = jnp.cumsum(counts) - counts
    padded = ((counts + EXPERT_BLOCK - 1) // EXPERT_BLOCK) * EXPERT_BLOCK
    pad_ends = jnp.cumsum(padded)
    pad_starts = pad_ends - padded
    n_blocks = -(-A // EXPERT_BLOCK) + N_EXPERTS
    dest = pad_starts[sorted_e] + (jnp.arange(A) - starts[sorted_e])
    buf = jnp.zeros((n_blocks * EXPERT_BLOCK, D), t.dtype).at[dest].set(t[sorted_tok])
    block_e = jnp.minimum(
        jnp.searchsorted(pad_ends, jnp.arange(n_blocks) * EXPERT_BLOCK, side="right"), N_EXPERTS - 1)

    def run_block(args):
        xb, e = args
        return clamped_swiglu_expert(xb, w_gate_up[e], b_gate_up[e], w_down[e], b_down[e])

    y = lax.map(run_block, (buf.reshape(n_blocks, EXPERT_BLOCK, D), block_e)).reshape(-1, D)
    y_assign = y[dest] * gates.reshape(A)[order][:, None].astype(y.dtype)
    out = jax.ops.segment_sum(y_assign, sorted_tok, num_segments=N)
    return out.reshape(B_, S_, D)


def hybrid_layer(x, mix_norm_g, w_in, conv_w, conv_norm_g, attn_norm_g, w_out,
                 ffn_norm_g, w_router, b_router, w_gate_up, b_gate_up, w_down, b_down):
    B_, S_, _ = x.shape
    h = rmsnorm(x, mix_norm_g)
    proj = h @ w_in
    c0, c1, c2 = CONV_WIDTH, 2 * CONV_WIDTH, 3 * CONV_WIDTH
    conv_x, conv_b, conv_c = proj[..., :c0], proj[..., c0:c1], proj[..., c1:c2]
    q = proj[..., c2:c2 + ATTN_WIDTH].reshape(B_, S_, N_ATTN_HEADS, HEAD_DIM)
    k = proj[..., c2 + ATTN_WIDTH:c2 + 2 * ATTN_WIDTH].reshape(B_, S_, N_ATTN_HEADS, HEAD_DIM)
    v = proj[..., c2 + 2 * ATTN_WIDTH:].reshape(B_, S_, N_ATTN_HEADS, HEAD_DIM)
    y_conv = conv_b * causal_short_conv(conv_c * conv_x, conv_w)
    y_attn = dilated_attention(partial_rotary(q), partial_rotary(k), v).reshape(B_, S_, ATTN_WIDTH)
    mixed = jnp.concatenate([rmsnorm(y_conv, conv_norm_g), rmsnorm(y_attn, attn_norm_g)], axis=-1)
    x = x + mixed @ w_out
    x = x + moe_ffn(rmsnorm(x, ffn_norm_g), w_router, b_router, w_gate_up, b_gate_up, w_down, b_down)
    return x


def setup_inputs(seed: int = 0) -> dict:
    key = jax.random.key(seed)
    ks = jax.random.split(key, 16)
    nrm = lambda k, shape, scale: jax.random.normal(k, shape, jnp.float32) * scale
    gain = lambda k, shape: 1.0 + 0.02 * jax.random.normal(k, shape, jnp.float32)
    return {
        "x": nrm(ks[0], (BATCH, SEQ, D_MODEL), 1.0),
        "mix_norm_g": gain(ks[1], (DEPTH, D_MODEL)),
        "w_in": nrm(ks[2], (DEPTH, D_MODEL, IN_COLS), D_MODEL ** -0.5),
        "conv_w": nrm(ks[3], (DEPTH, CONV_K, CONV_WIDTH), CONV_K ** -0.5),
        "conv_norm_g": gain(ks[4], (DEPTH, CONV_WIDTH)),
        "attn_norm_g": gain(ks[5], (DEPTH, ATTN_WIDTH)),
        "w_out": nrm(ks[6], (DEPTH, MIX_WIDTH, D_MODEL), MIX_WIDTH ** -0.5),
        "ffn_norm_g": gain(ks[7], (DEPTH, D_MODEL)),
        "w_router": nrm(ks[8], (DEPTH, D_MODEL, N_EXPERTS), D_MODEL ** -0.5),
        "b_router": nrm(ks[9], (DEPTH, N_EXPERTS), 0.01),
        "w_gate_up": nrm(ks[10], (DEPTH, N_EXPERTS, D_MODEL, 2 * D_EXPERT), D_MODEL ** -0.5),
        "b_gate_up": nrm(ks[11], (DEPTH, N_EXPERTS, 2 * D_EXPERT), 0.02),
        "w_down": nrm(ks[12], (DEPTH, N_EXPERTS, D_EXPERT, D_MODEL), D_EXPERT ** -0.5),
        "b_down": nrm(ks[13], (DEPTH, N_EXPERTS, D_MODEL), 0.02),
        "final_norm_g": gain(ks[14], (D_MODEL,)),
    }


def reference(x, mix_norm_g, w_in, conv_w, conv_norm_g, attn_norm_g, w_out, ffn_norm_g,
              w_router, b_router, w_gate_up, b_gate_up, w_down, b_down, final_norm_g):
    for layer in range(DEPTH):
        x = hybrid_layer(x, mix_norm_g[layer], w_in[layer], conv_w[layer], conv_norm_g[layer],
                         attn_norm_g[layer], w_out[layer], ffn_norm_g[layer], w_router[layer],
                         b_router[layer], w_gate_up[layer], b_gate_up[layer], w_down[layer],
                         b_down[layer])
    return rmsnorm(x, final_norm_g)
```

```cpp
#include <hip/hip_runtime.h>
#include <cstdio>
#include <cstdint>
namespace pg8 {
#define PG8_LAS __attribute__((address_space(3)))
typedef unsigned short bf16_t;
typedef short bf16x8 __attribute__((ext_vector_type(8)));
typedef float f32x4 __attribute__((ext_vector_type(4)));
typedef unsigned u32x4 __attribute__((ext_vector_type(4)));
constexpr int BM = 256, BK = 64, HALF = 128, HTB = HALF * BK * 2  , STAGE_BYTES = 8 * HTB, NXCD = 8, WGM = 8;

__host__ __device__ __forceinline__ int lds_byte(int r, int c) { const int st = (r >> 4) * 2 + (c >> 5), rr = r & 15, cc = c & 31, ob = rr * 64 + cc * 2; return st * 1024 + (ob ^ (((ob >> 9) & 1) << 5)); }
__host__ __device__ __forceinline__ void stage_rc(int b, int& R, int& C) { const int st = b / 1024, sb = b % 1024, swz = sb ^ (((sb >> 9) & 1) << 5); R = (st >> 1) * 16 + swz / 64; C = (st & 1) * 32 + (swz % 64) / 2; }
__host__ __device__ __forceinline__ int perm32(int rho) { const int n = rho >> 4, i = rho & 15; return 8 * (i >> 2) + 4 * n + (i & 3); }

struct Unit { int pm, pn, e, cn; };
struct Gemm { const bf16_t* A; const bf16_t* Bt; int M, N, K; };

struct StaticOrder {
    int nM, nN, nwg, G, c;
    __host__ __device__ void init(int M, int N, int G_, int c_) { nM = M / BM; nN = N / BM; nwg = nM * nN; G = G_; c = c_; }
    __host__ __device__ bool next(int i, Unit& u) const {
        const long L = (long)i * G + c; if (L >= nwg) return false;
        int wgid = (int)L; { const int q = nwg / NXCD, r = nwg % NXCD, xcd = wgid % NXCD, off = wgid / NXCD; wgid = (xcd < r ? xcd * (q + 1) : r * (q + 1) + (xcd - r) * q) + off; }
        const int nig = WGM * nN, gid = wgid / nig, fm = gid * WGM, gsz = (nM - fm) < WGM ? (nM - fm) : WGM;
        u.pm = fm + ((wgid % nig) % gsz); u.pn = (wgid % nig) / gsz; u.e = 0; u.cn = u.pn; return true;
    }
    __device__ __forceinline__ void a_ready(const Unit&) const {}
    __device__ __forceinline__ void done(const Unit&) const {}
};
struct GroupedOrder {
    const PG8_LAS int* TS; int nN, G, v;
    __device__ __forceinline__ bool next(int i, Unit& u) const {
        const int U = i * G + v; const int total = __builtin_amdgcn_readfirstlane(TS[32] * nN); if (U >= total) return false;
        int e = 0;
#pragma unroll 1
        for (int j = 1; j < 32; ++j) e += (TS[j] * nN <= U) ? 1 : 0;
        const int t0 = TS[e], nt = TS[e + 1] - t0, loc = U - t0 * nN; const int pn = loc / nt, rt = loc - pn * nt;
        u.pm = __builtin_amdgcn_readfirstlane(t0 + rt); u.pn = __builtin_amdgcn_readfirstlane(e * nN + pn); u.e = __builtin_amdgcn_readfirstlane(e); u.cn = __builtin_amdgcn_readfirstlane(pn); return true;
    }
    __device__ __forceinline__ void a_ready(const Unit&) const {}
    __device__ __forceinline__ void done(const Unit&) const {}
};

__device__ __forceinline__ unsigned cvt_pk_bf16(float lo, float hi) { unsigned r; asm volatile("v_cvt_pk_bf16_f32 %0, %1, %2" : "=v"(r) : "v"(lo), "v"(hi)); return r; }

struct EpiBf16Plain {
    static constexpr bool PERM = true, AFTER_DRAIN = false;
    bf16_t* O; int ldc;
    __device__ __forceinline__ void operator()(const f32x4 (&acc)[2][2][4][2], const Unit& u, int wr, int wc, int fr, int fq) const {
        const int row0 = u.pm * BM + wr * 64 + fr, col0 = u.cn * BM + wc * 32 + 8 * fq;
#pragma unroll
        for (int ai = 0; ai < 2; ++ai)
#pragma unroll
            for (int m = 0; m < 4; ++m) { bf16_t* rowp = O + (size_t)(row0 + ai * HALF + m * 16) * ldc + col0;
#pragma unroll
                for (int bj = 0; bj < 2; ++bj) { const f32x4 v0 = acc[ai][bj][m][0], v1 = acc[ai][bj][m][1];
                    u32x4 w; w.x = cvt_pk_bf16(v0[0], v0[1]); w.y = cvt_pk_bf16(v0[2], v0[3]); w.z = cvt_pk_bf16(v1[0], v1[1]); w.w = cvt_pk_bf16(v1[2], v1[3]);
                    *(u32x4*)(rowp + bj * HALF) = w; } }
    }
};
struct EpiResF32 {
    static constexpr bool PERM = false, AFTER_DRAIN = false;
    const float* base; float* out; int ldc;
    __device__ __forceinline__ void operator()(const f32x4 (&acc)[2][2][4][2], const Unit& u, int wr, int wc, int fr, int fq) const {
        const int row0 = u.pm * BM + wr * 64 + fr, col0 = u.cn * BM + wc * 32 + 4 * fq;
#pragma unroll
        for (int ai = 0; ai < 2; ++ai)
#pragma unroll
            for (int m = 0; m < 4; ++m) { const size_t off = (size_t)(row0 + ai * HALF + m * 16) * ldc + col0;
#pragma unroll
                for (int bj = 0; bj < 2; ++bj)
#pragma unroll
                    for (int n = 0; n < 2; ++n) { const f32x4 b = *(const f32x4*)(base + off + bj * HALF + n * 16); *(f32x4*)(out + off + bj * HALF + n * 16) = acc[ai][bj][m][n] + b; } }
    }
};
__device__ __forceinline__ float swiglu1(float g, float up) {
    g = fminf(g, 7.0f); up = fminf(fmaxf(up, -7.0f), 7.0f);
    const float e = __builtin_amdgcn_exp2f(g * (-1.702f * 1.4426950408889634f));
    return (up + 1.0f) * g * __builtin_amdgcn_rcpf(1.0f + e);
}
struct EpiSwiGLU {
    static constexpr bool PERM = true, AFTER_DRAIN = false;
    bf16_t* O; const float* bias;
    __device__ __forceinline__ void operator()(const f32x4 (&acc)[2][2][4][2], const Unit& u, int wr, int wc, int fr, int fq) const {
        const int row0 = u.pm * BM + wr * 64 + fr, colj = u.cn * HALF + wc * 32 + 8 * fq;
        const float* bg = bias + (size_t)u.e * 4096 + colj;
        const f32x4 bg0 = *(const f32x4*)(bg), bg1 = *(const f32x4*)(bg + 4), bu0 = *(const f32x4*)(bg + 2048), bu1 = *(const f32x4*)(bg + 2048 + 4);
#pragma unroll
        for (int ai = 0; ai < 2; ++ai)
#pragma unroll
            for (int m = 0; m < 4; ++m) { bf16_t* rowp = O + (size_t)(row0 + ai * HALF + m * 16) * 2048 + colj;
                const f32x4 g0 = acc[ai][0][m][0] + bg0, g1 = acc[ai][0][m][1] + bg1, u0 = acc[ai][1][m][0] + bu0, u1 = acc[ai][1][m][1] + bu1;
                u32x4 w; w.x = cvt_pk_bf16(swiglu1(g0[0], u0[0]), swiglu1(g0[1], u0[1])); w.y = cvt_pk_bf16(swiglu1(g0[2], u0[2]), swiglu1(g0[3], u0[3]));
                w.z = cvt_pk_bf16(swiglu1(g1[0], u1[0]), swiglu1(g1[1], u1[1])); w.w = cvt_pk_bf16(swiglu1(g1[2], u1[2]), swiglu1(g1[3], u1[3]));
                *(u32x4*)rowp = w; }
    }
};
template <class Epi, class Sched, bool ALIGN_EPI = false, bool SP2 = false>
__device__ __forceinline__ void gemm_phase(PG8_LAS unsigned char* lds, const Gemm g, const Sched& S, const Epi& E) {
    const int tid = threadIdx.x, wid = __builtin_amdgcn_readfirstlane(tid >> 6), lane = tid & 63, wr = wid >> 2, wc = wid & 3, fr = lane & 15, fq = lane >> 4;
    const int K = g.K, nt = K / BK;
    unsigned voffA[2], voffB[2];
#pragma unroll
    for (int i = 0; i < 2; ++i) { int R, C; stage_rc(tid * 16 + i * 8192, R, C); const int Rb = Epi::PERM ? ((R & ~31) + perm32(R & 31)) : R;
        voffA[i] = (unsigned)(R * K + C) * 2u; voffB[i] = (unsigned)(Rb * K + C) * 2u; }
    const size_t kstep = (size_t)(BK * 2);
    const size_t hstep = (size_t)HALF * K * 2;
    const size_t tstep = 2 * hstep;
    const unsigned ldsw = (unsigned)wid * 1024u;
    const int aoff = lds_byte(wr * 64 + fr, fq * 8), boff = lds_byte(wc * 32 + fr, fq * 8);
#define PG8_SA(b, h) (((b) * 2 + (h)) * HTB)
#define PG8_SB(b, h) ((4 + (b) * 2 + (h)) * HTB)
#define PG8_STAGE(bufoff, gbase, voff) do { _Pragma("unroll") for (int _i = 0; _i < 2; ++_i) \
        __builtin_amdgcn_global_load_lds((const unsigned*)((const char*)(gbase) + (voff)[_i]), (PG8_LAS unsigned*)(lds + (bufoff) + ldsw + _i * 8192), 16, 0, 0); } while (0)
#define PG8_LDA(dst, b, h) do { _Pragma("unroll") for (int m = 0; m < 4; ++m) _Pragma("unroll") for (int k = 0; k < 2; ++k) dst[m][k] = *(const PG8_LAS bf16x8*)(lds + PG8_SA(b, h) + aoff + m * 2048 + k * 1024); } while (0)
#define PG8_LDB(dst, b, h) do { _Pragma("unroll") for (int n = 0; n < 2; ++n) _Pragma("unroll") for (int k = 0; k < 2; ++k) dst[n][k] = *(const PG8_LAS bf16x8*)(lds + PG8_SB(b, h) + boff + n * 2048 + k * 1024); } while (0)
#define PG8_MMA(ai, bj, At, Bt) do { __builtin_amdgcn_s_setprio(1); _Pragma("unroll") for (int m = 0; m < 4; ++m) _Pragma("unroll") for (int n = 0; n < 2; ++n) _Pragma("unroll") for (int k = 0; k < 2; ++k) \
        acc[ai][bj][m][n] = __builtin_amdgcn_mfma_f32_16x16x32_bf16(Bt[n][k], At[m][k], acc[ai][bj][m][n], 0, 0, 0); __builtin_amdgcn_s_setprio(0); } while (0)
#define PG8_WAIT_V(n) asm volatile("s_waitcnt vmcnt(" #n ")" ::: "memory")
#define PG8_WAIT_L(n) asm volatile("s_waitcnt lgkmcnt(" #n ")" ::: "memory")
#define PG8_BAR __builtin_amdgcn_s_barrier()
#define PG8_SCHED __builtin_amdgcn_sched_barrier(0)
    Unit cur, nxt; int ui = 0;
    if (!S.next(0, cur)) return;
    f32x4 acc[2][2][4][2];
#pragma unroll
    for (int a = 0; a < 2; ++a)
#pragma unroll
        for (int b = 0; b < 2; ++b)
#pragma unroll
            for (int m = 0; m < 4; ++m)
#pragma unroll
                for (int n = 0; n < 2; ++n) acc[a][b][m][n] = (f32x4){0.f, 0.f, 0.f, 0.f};
    bf16x8 At[4][2], B0[2][2], B1[2][2];
    const char* cA = (const char*)g.A + (size_t)cur.pm * tstep; const char* cB = (const char*)g.Bt + (size_t)cur.pn * tstep;
    S.a_ready(cur);
    if constexpr (SP2) {
        PG8_STAGE(PG8_SB(0, 0), cB, voffB); PG8_STAGE(PG8_SB(0, 1), cB + hstep, voffB); PG8_STAGE(PG8_SA(0, 0), cA, voffA); PG8_STAGE(PG8_SA(0, 1), cA + hstep, voffA);
        if (wr == 1) PG8_BAR;
        PG8_WAIT_V(2); PG8_BAR;
        PG8_STAGE(PG8_SB(1, 0), cB + kstep, voffB); PG8_STAGE(PG8_SA(1, 0), cA + kstep, voffA); PG8_STAGE(PG8_SB(1, 1), cB + hstep + kstep, voffB);
        PG8_WAIT_V(6); PG8_BAR;
    } else {
        PG8_STAGE(PG8_SB(0, 0), cB, voffB); PG8_STAGE(PG8_SA(0, 0), cA, voffA); PG8_STAGE(PG8_SB(0, 1), cB + hstep, voffB); PG8_STAGE(PG8_SA(0, 1), cA + hstep, voffA);
        if (wr == 1) PG8_BAR;
        PG8_WAIT_V(4); PG8_BAR;
        PG8_STAGE(PG8_SB(1, 0), cB + kstep, voffB); PG8_STAGE(PG8_SA(1, 0), cA + kstep, voffA); PG8_STAGE(PG8_SB(1, 1), cB + hstep + kstep, voffB);
        PG8_WAIT_V(6); PG8_BAR;
    }
    for (;;) {
        const bool has_next = S.next(ui + 1, nxt);
        const char* nA = has_next ? (const char*)g.A + (size_t)nxt.pm * tstep : cA; const char* nB = has_next ? (const char*)g.Bt + (size_t)nxt.pn * tstep : cB;
        for (int t = 0; t < nt; t += 2) {
            const bool last = (t == nt - 2);
            const char* a1 = cA + (size_t)(t + 1) * kstep;
            const char* a2 = last ? nA : cA + (size_t)(t + 2) * kstep; const char* b2 = last ? nB : cB + (size_t)(t + 2) * kstep;
            const char* a3 = a2 + kstep; const char* b3 = b2 + kstep;
            if (last && has_next) S.a_ready(nxt);
            if constexpr (SP2) {
            PG8_LDB(B0, 0, 0); PG8_LDB(B1, 0, 1); PG8_SCHED; PG8_LDA(At, 0, 0); PG8_STAGE(PG8_SA(1, 1), a1 + hstep, voffA);
            PG8_WAIT_V(8); PG8_WAIT_L(0); PG8_BAR; PG8_MMA(0, 0, At, B0); PG8_MMA(0, 1, At, B1); PG8_BAR; PG8_SCHED;
            PG8_LDA(At, 0, 1); PG8_STAGE(PG8_SB(0, 0), b2, voffB); PG8_STAGE(PG8_SB(0, 1), b2 + hstep, voffB); PG8_STAGE(PG8_SA(0, 0), a2, voffA);
            PG8_WAIT_V(8); PG8_WAIT_L(0); PG8_BAR; PG8_MMA(1, 0, At, B0); PG8_MMA(1, 1, At, B1); PG8_BAR; PG8_SCHED;
            PG8_LDB(B0, 1, 0); PG8_LDB(B1, 1, 1); PG8_SCHED; PG8_LDA(At, 1, 0); PG8_STAGE(PG8_SA(0, 1), a2 + hstep, voffA);
            PG8_WAIT_V(8); PG8_WAIT_L(0); PG8_BAR; PG8_MMA(0, 0, At, B0); PG8_MMA(0, 1, At, B1); PG8_BAR; PG8_SCHED;
            PG8_LDA(At, 1, 1); PG8_STAGE(PG8_SB(1, 0), b3, voffB); PG8_STAGE(PG8_SB(1, 1), b3 + hstep, voffB); PG8_STAGE(PG8_SA(1, 0), a3, voffA);
            PG8_WAIT_V(8); PG8_WAIT_L(0); PG8_BAR; PG8_MMA(1, 0, At, B0); PG8_MMA(1, 1, At, B1); PG8_BAR; PG8_SCHED;
            } else {
            PG8_LDB(B0, 0, 0); PG8_SCHED; PG8_LDA(At, 0, 0); PG8_STAGE(PG8_SA(1, 1), a1 + hstep, voffA);
            PG8_WAIT_L(8); PG8_BAR; PG8_WAIT_L(0); PG8_MMA(0, 0, At, B0); PG8_BAR; PG8_SCHED;
            PG8_LDB(B1, 0, 1); PG8_STAGE(PG8_SB(0, 0), b2, voffB);
            PG8_BAR; PG8_WAIT_L(0); PG8_MMA(0, 1, At, B1); PG8_BAR;
            PG8_LDA(At, 0, 1); PG8_STAGE(PG8_SA(0, 0), a2, voffA);
            PG8_BAR; PG8_WAIT_L(0); PG8_MMA(1, 0, At, B0); PG8_BAR; PG8_SCHED;
            PG8_STAGE(PG8_SB(0, 1), b2 + hstep, voffB);
            PG8_WAIT_V(6); PG8_BAR; PG8_MMA(1, 1, At, B1); PG8_BAR;
            PG8_LDB(B0, 1, 0); PG8_SCHED; PG8_LDA(At, 1, 0); PG8_STAGE(PG8_SA(0, 1), a2 + hstep, voffA);
            PG8_WAIT_L(8); PG8_BAR; PG8_WAIT_L(0); PG8_MMA(0, 0, At, B0); PG8_BAR; PG8_SCHED;
            PG8_LDB(B1, 1, 1); PG8_STAGE(PG8_SB(1, 0), b3, voffB);
            PG8_BAR; PG8_WAIT_L(0); PG8_MMA(0, 1, At, B1); PG8_BAR;
            PG8_LDA(At, 1, 1); PG8_STAGE(PG8_SA(1, 0), a3, voffA);
            PG8_BAR; PG8_WAIT_L(0); PG8_MMA(1, 0, At, B0); PG8_BAR; PG8_SCHED;
            PG8_STAGE(PG8_SB(1, 1), b3 + hstep, voffB);
            PG8_WAIT_V(6); PG8_BAR; PG8_MMA(1, 1, At, B1); PG8_BAR;
            }
        }
        if constexpr (ALIGN_EPI) { if (wr == 0) PG8_BAR; }
        if constexpr (!Epi::AFTER_DRAIN) { E(acc, cur, wr, wc, fr, fq); S.done(cur); }
        if (!has_next) break;
#pragma unroll
        for (int a = 0; a < 2; ++a)
#pragma unroll
            for (int b = 0; b < 2; ++b)
#pragma unroll
                for (int m = 0; m < 4; ++m)
#pragma unroll
                    for (int n = 0; n < 2; ++n) acc[a][b][m][n] = (f32x4){0.f, 0.f, 0.f, 0.f};
        cur = nxt; cA = nA; cB = nB; ++ui;
        if constexpr (ALIGN_EPI) { if (wr == 1) PG8_BAR; }
    }
    PG8_WAIT_V(0);
    if constexpr (!ALIGN_EPI) { if (wr == 0) PG8_BAR; }
    PG8_BAR;
    if constexpr (Epi::AFTER_DRAIN) { E.fused(acc, cur, wr, wc, fr, fq, lds, wid, lane); S.done(cur); }
#undef PG8_SA
#undef PG8_SB
#undef PG8_STAGE
#undef PG8_LDA
#undef PG8_LDB
#undef PG8_MMA
#undef PG8_WAIT_V
#undef PG8_WAIT_L
#undef PG8_BAR
#undef PG8_SCHED
}
}
#define GAS __attribute__((address_space(1)))
#define LAS __attribute__((address_space(3)))
typedef unsigned short bf16;
typedef unsigned v4u __attribute__((ext_vector_type(4)));
typedef float f32x4 __attribute__((ext_vector_type(4)));
typedef short bf16x8 __attribute__((ext_vector_type(8)));
typedef GAS unsigned gu32;
typedef GAS unsigned long long gu64;
#define RLX_AGENT __ATOMIC_RELAXED, __HIP_MEMORY_SCOPE_AGENT
#define LDS_WAIT() asm volatile("s_waitcnt lgkmcnt(0)" ::: "memory")
#define VM_WAIT() asm volatile("s_waitcnt vmcnt(0)" ::: "memory")
__device__ __forceinline__ unsigned long long rt() { return __builtin_amdgcn_s_memrealtime(); }
__device__ __forceinline__ unsigned f2bf(float f) { unsigned u = __builtin_bit_cast(unsigned, f); return (u + 0x7fffu + ((u >> 16) & 1u)) >> 16; }
__device__ __forceinline__ unsigned pk2(float lo, float hi) { return f2bf(lo) | (f2bf(hi) << 16); }

#define XB_TMO      128
#define XB_XCNT(j)  (256  + 64 * (j))
#define XB_XSUB(j)  (1280 + 64 * (j))
#define XB_XGEN(j)  (2304 + 64 * (j))
#define XB_TOP      3328
#define XB_TOPGEN   3392
#define XCD_BAR_WORDS 3456
#define XB_SPIN_CAP (1u << 18)

__device__ __forceinline__ unsigned xb_ld(unsigned* p)              { return __hip_atomic_load(p, __ATOMIC_RELAXED, __HIP_MEMORY_SCOPE_AGENT); }
__device__ __forceinline__ unsigned xb_add(unsigned* p, unsigned v) { return __hip_atomic_fetch_add(p, v, __ATOMIC_RELAXED, __HIP_MEMORY_SCOPE_AGENT); }
__device__ __forceinline__ unsigned xb_xcc_id() { return (unsigned)__builtin_amdgcn_s_getreg((3 << 11) | 20) & 0xFu; }
#define XB_SPIN(cond, bar) do { unsigned _sp = 0; while (cond) { __builtin_amdgcn_s_sleep(1); \
    if ((++_sp & 255u) == 0u) { if (xb_ld(&(bar)[XB_TMO])) break; if (_sp > XB_SPIN_CAP) { atomicAdd(&(bar)[XB_TMO], 1u); break; } } } } while (0)

struct XcdBarrier {
    unsigned* bar; unsigned x;
    volatile LAS unsigned* st;
};

__device__ __forceinline__ XcdBarrier xcd_barrier_post(unsigned* bar, volatile LAS unsigned* st) {
    XcdBarrier b; b.bar = bar; b.x = xb_xcc_id(); b.st = st;
    if (threadIdx.x == 0) (void)xb_add(&bar[XB_XCNT(b.x)], 1u);
    return b;
}
__device__ __forceinline__ void xcd_barrier_complete(unsigned* bar, unsigned x, unsigned& nloc, unsigned& nx) {
    const unsigned G = gridDim.x * gridDim.y * gridDim.z;
    unsigned sum, cnt, mine, sp = 0u;
    for (;;) {
        sum = 0u; cnt = 0u; mine = 0u;
#pragma unroll
        for (unsigned j = 0; j < 16; ++j) { const unsigned c = xb_ld(&bar[XB_XCNT(j)]); sum += c; cnt += (c > 0u) ? 1u : 0u; mine = (j == x) ? c : mine; }
        if (sum == G) break;
        __builtin_amdgcn_s_sleep(1);
        if ((++sp & 255u) == 0u) { if (xb_ld(&bar[XB_TMO])) break; if (sp > XB_SPIN_CAP) { atomicAdd(&bar[XB_TMO], 1u); break; } }
    }
    nloc = mine > 0u ? mine : 1u; nx = cnt > 0u ? cnt : 1u;
}

__device__ __forceinline__ void xcd_barrier(const XcdBarrier& b) {
    asm volatile("s_waitcnt vmcnt(0)" ::: "memory");
    __syncthreads();
    if (threadIdx.x == 0) {
        unsigned* bar = b.bar;
        __builtin_amdgcn_s_waitcnt(0);
        unsigned nloc = b.st[0], nx = b.st[1];
        if (nloc == 0u) { xcd_barrier_complete(bar, b.x, nloc, nx); b.st[0] = nloc; b.st[1] = nx; }
        const unsigned old = xb_add(&bar[XB_XSUB(b.x)], 1u);
        const unsigned gen = old / nloc;
        if (old + 1u == (gen + 1u) * nloc) {
            __builtin_amdgcn_fence(__ATOMIC_RELEASE, "agent");
            asm volatile("s_waitcnt vmcnt(0)" ::: "memory");
            const unsigned og = xb_add(&bar[XB_TOP], 1u);
            const unsigned tg = og / nx;
            if (og + 1u == (tg + 1u) * nx) xb_add(&bar[XB_TOPGEN], 1u);
            else XB_SPIN(xb_ld(&bar[XB_TOPGEN]) == tg, bar);
            __builtin_amdgcn_fence(__ATOMIC_ACQUIRE, "agent");
            xb_add(&bar[XB_XGEN(b.x)], 1u);
            asm volatile("s_waitcnt vmcnt(0)" ::: "memory");
        } else {
            XB_SPIN(xb_ld(&bar[XB_XGEN(b.x)]) == gen, bar);
            __builtin_amdgcn_fence(__ATOMIC_ACQUIRE, "agent");
            asm volatile("s_waitcnt vmcnt(0)" ::: "memory");
        }
    }
    __syncthreads();
}

constexpr int NB = 4, SEQ = 2048, DM = 2048, NTOK = NB * SEQ, INC = 6144, CW = 512, AW = 1536, NH = 24, HD = 64, NE = 32, TOPK = 4, DE = 2048;
constexpr int QOFF = 1536, KOFF = 3072, VOFF = 4608;
constexpr int MAXSLOT = NTOK * TOPK + NE * 256;
constexpr float EPS = 1e-5f;
typedef unsigned u32x2v __attribute__((ext_vector_type(2)));
constexpr int NWAVES = 8;
#ifndef MK_N_LAUNCHES
#define MK_N_LAUNCHES 1
#endif
constexpr int NPH = 10;

constexpr size_t MiB = 1u << 20;
constexpr size_t WS_CTL = 0, CTL_ZERO_BYTES = 1 * MiB;
constexpr size_t WS_ROPE = 1 * MiB;
constexpr size_t WS_TOKE = 2 * MiB, WS_TOKR = WS_TOKE + 128 * 1024, WS_TOKG = WS_TOKR + 128 * 1024;
constexpr size_t WS_LIST = 3 * MiB;
constexpr size_t WS_WIN = 8 * MiB;
constexpr size_t WS_WO = 32 * MiB;
constexpr size_t WS_XN = 40 * MiB;
constexpr size_t WS_PROJ = 72 * MiB;
constexpr size_t WS_YATT = 168 * MiB;
constexpr size_t WS_MIXED = 192 * MiB;
constexpr size_t WS_X1 = 224 * MiB;
constexpr size_t WS_XN2 = 288 * MiB;
constexpr size_t WS_XS = 320 * MiB;
constexpr size_t WS_ACT = 480 * MiB;
constexpr size_t WS_Y = 640 * MiB;
constexpr size_t WS_WGU = 1024 * MiB;
constexpr size_t WS_WDN = 1536 * MiB;
constexpr size_t WS_END = 1792 * MiB;
constexpr int CW_TMO = 0, CW_CODE = 1;
constexpr int CW_BAR = 4096;
constexpr int CW_CNT = 8192;
constexpr int CW_ATTQ = 12288;
constexpr int RING_BYTES = 131072;
constexpr int LDSCTL_OFF = RING_BYTES;
constexpr int MISC_OFF = LDSCTL_OFF + 320;
constexpr int TAB_TS = LDSCTL_OFF + 1024;
constexpr int TAB_CN = LDSCTL_OFF + 1024 + 256;
constexpr int LDS_BYTES = 147456;

__device__ __forceinline__ float wave_sum(float v) {
#pragma unroll
    for (int o = 1; o < 64; o <<= 1) v += __shfl_xor(v, o);
    return v;
}
__device__ __forceinline__ float bf_lo(unsigned w) { return __uint_as_float(w << 16); }
__device__ __forceinline__ float bf_hi(unsigned w) { return __uint_as_float(w & 0xffff0000u); }

__device__ __forceinline__ void p0_transpose_item(const float* W, int N, int K, bf16* WT, int k0, int n0, int out_row0, LAS float* scr, int lane) {
#pragma unroll 8
    for (int i = 0; i < 32; ++i) { const int kk = 2 * i + (lane >> 5); scr[kk * 33 + (lane & 31)] = W[(size_t)(k0 + kk) * N + n0 + (lane & 31)]; }
    LDS_WAIT(); asm volatile("" ::: "memory");
    const int c = lane & 7;
#pragma unroll
    for (int j = 0; j < 4; ++j) { const int n = (lane >> 3) + 8 * j; const LAS float* s = scr + (8 * c) * 33 + n;
        v4u o; o.x = pk2(s[0 * 33], s[1 * 33]); o.y = pk2(s[2 * 33], s[3 * 33]); o.z = pk2(s[4 * 33], s[5 * 33]); o.w = pk2(s[6 * 33], s[7 * 33]);
        *(GAS v4u*)(WT + (size_t)(out_row0 + n) * K + k0 + 8 * c) = o; }
    LDS_WAIT(); asm volatile("" ::: "memory");
}

namespace att {
typedef short s16x8 __attribute__((ext_vector_type(8)));
typedef short s16x4 __attribute__((ext_vector_type(4)));
typedef float f32x16 __attribute__((ext_vector_type(16)));
typedef unsigned u32x4 __attribute__((ext_vector_type(4)));
constexpr int VP = 144;
constexpr int WAVE_LDS = 32 * VP;
constexpr float C2 = 0.125f * 1.4426950408889634f;
constexpr int NITEMS = 16 * NB * NH * 4;

__device__ __forceinline__ void load_rot(s16x8 (&f)[4], const bf16* rowp, int pos, int h, const float* rope, float scale, bool do_scale) {
    u32x4 w[4];
#pragma unroll
    for (int d0 = 0; d0 < 4; ++d0) w[d0] = *(const u32x4*)(rowp + 16 * d0 + 8 * h);
    u32x4 oth; oth.x = __shfl_xor(w[0].x, 32); oth.y = __shfl_xor(w[0].y, 32); oth.z = __shfl_xor(w[0].z, 32); oth.w = __shfl_xor(w[0].w, 32);
    const f32x4 c0 = *(const f32x4*)(rope + pos * 16), c1 = *(const f32x4*)(rope + pos * 16 + 4), s0 = *(const f32x4*)(rope + pos * 16 + 8), s1 = *(const f32x4*)(rope + pos * 16 + 12);
    const float sg = h ? 1.0f : -1.0f;
    float r[8];
    r[0] = bf_lo(w[0].x) * c0[0] + sg * bf_lo(oth.x) * s0[0]; r[1] = bf_hi(w[0].x) * c0[1] + sg * bf_hi(oth.x) * s0[1];
    r[2] = bf_lo(w[0].y) * c0[2] + sg * bf_lo(oth.y) * s0[2]; r[3] = bf_hi(w[0].y) * c0[3] + sg * bf_hi(oth.y) * s0[3];
    r[4] = bf_lo(w[0].z) * c1[0] + sg * bf_lo(oth.z) * s1[0]; r[5] = bf_hi(w[0].z) * c1[1] + sg * bf_hi(oth.z) * s1[1];
    r[6] = bf_lo(w[0].w) * c1[2] + sg * bf_lo(oth.w) * s1[2]; r[7] = bf_hi(w[0].w) * c1[3] + sg * bf_hi(oth.w) * s1[3];
    if (do_scale) {
#pragma unroll
        for (int j = 0; j < 8; ++j) r[j] *= scale;
#pragma unroll
        for (int d0 = 1; d0 < 4; ++d0) { u32x4 t = w[d0];
            t.x = pk2(bf_lo(t.x) * scale, bf_hi(t.x) * scale); t.y = pk2(bf_lo(t.y) * scale, bf_hi(t.y) * scale); t.z = pk2(bf_lo(t.z) * scale, bf_hi(t.z) * scale); t.w = pk2(bf_lo(t.w) * scale, bf_hi(t.w) * scale); w[d0] = t; }
    }
    w[0].x = pk2(r[0], r[1]); w[0].y = pk2(r[2], r[3]); w[0].z = pk2(r[4], r[5]); w[0].w = pk2(r[6], r[7]);
#pragma unroll
    for (int d0 = 0; d0 < 4; ++d0) f[d0] = __builtin_bit_cast(s16x8, w[d0]);
}
typedef short v4i16_t __attribute__((ext_vector_type(4)));
__device__ __forceinline__ s16x4 vtr(LAS const char* p) { return __builtin_bit_cast(s16x4, __builtin_amdgcn_ds_read_tr16_b64_v4i16((LAS v4i16_t*)p)); }

template <bool MOD4>
__device__ __forceinline__ void tile(const bf16* Kb, const bf16* Vb, const float* rope, LAS char* vl, int lane, int abase, int kp_off, int kp_mul, int bq, unsigned W,
                                     const s16x8 (&qf)[4], f32x16& o0, f32x16& o1, float& mrun, float& lrun) {
    const int h = lane >> 5;
    { }
    const int aK = abase + (lane & 31); const int posK = kp_off + kp_mul * (aK < 0 ? 0 : aK);
    s16x8 kf[4]; load_rot(kf, Kb + (size_t)posK * INC, posK, h, rope, 1.0f, false);
    { const int iv = lane >> 1, hv = lane & 1; const int aV = abase + iv; const int posV = kp_off + kp_mul * (aV < 0 ? 0 : aV);
      const u32x4* vs = (const u32x4*)(Vb + (size_t)posV * INC + 32 * hv);
      const u32x4 v0 = vs[0], v1 = vs[1], v2 = vs[2], v3 = vs[3];
      LAS u32x4* vd = (LAS u32x4*)(vl + iv * VP + hv * 64);
      vd[0] = v0; vd[1] = v1; vd[2] = v2; vd[3] = v3; }
    f32x16 s = {};
#pragma unroll
    for (int d0 = 0; d0 < 4; ++d0) s = __builtin_amdgcn_mfma_f32_32x32x16_bf16(kf[d0], qf[d0], s, 0, 0, 0);
    const int t0 = bq - abase - 4 * h;
    float mx = -INFINITY;
#pragma unroll
    for (int r = 0; r < 16; ++r) { const int dd = t0 - ((r & 3) + 8 * (r >> 2));
        bool ok = ((unsigned)dd <= W) && (dd <= bq); if (MOD4) ok = ok && ((dd & 3) == 0);
        s[r] = ok ? s[r] : -INFINITY; mx = fmaxf(mx, s[r]); }
    mx = fmaxf(mx, __shfl_xor(mx, 32));
    const float mnew = fmaxf(mrun, mx), alpha = __builtin_amdgcn_exp2f(mrun - mnew); mrun = mnew;
    float ps = 0.f;
#pragma unroll
    for (int r = 0; r < 16; ++r) { s[r] = __builtin_amdgcn_exp2f(s[r] - mnew); ps += s[r]; }
    lrun = lrun * alpha + ps;
#pragma unroll
    for (int r = 0; r < 16; ++r) { o0[r] *= alpha; o1[r] *= alpha; }
    u32x4 p0, p1;
    p0.x = pk2(s[0], s[1]); p0.y = pk2(s[2], s[3]); p0.z = pk2(s[4], s[5]); p0.w = pk2(s[6], s[7]);
    p1.x = pk2(s[8], s[9]); p1.y = pk2(s[10], s[11]); p1.z = pk2(s[12], s[13]); p1.w = pk2(s[14], s[15]);
    const s16x8 pf0 = __builtin_bit_cast(s16x8, p0), pf1 = __builtin_bit_cast(s16x8, p1);
    const int g = lane >> 4, qq = (lane & 15) >> 2, pp = lane & 3;
    LAS const char* vb = vl + (4 * h + qq) * VP + (16 * (g & 1) + 4 * pp) * 2;
#pragma unroll
    for (int sstep = 0; sstep < 2; ++sstep) {
#pragma unroll
        for (int dh = 0; dh < 2; ++dh) {
            const s16x4 lo = vtr(vb + (16 * sstep) * VP + dh * 64), hi = vtr(vb + (16 * sstep + 8) * VP + dh * 64);
            const s16x8 vf = (s16x8){lo[0], lo[1], lo[2], lo[3], hi[0], hi[1], hi[2], hi[3]};
            if (dh == 0) o0 = __builtin_amdgcn_mfma_f32_32x32x16_bf16(vf, sstep ? pf1 : pf0, o0, 0, 0, 0);
            else         o1 = __builtin_amdgcn_mfma_f32_32x32x16_bf16(vf, sstep ? pf1 : pf0, o1, 0, 0, 0);
        }
    }
}

__device__ __forceinline__ void item(int it, const bf16* PROJ, bf16* YATT, const float* rope, LAS char* vl, int lane) {
    const int mb = 15 - it / 384; int rest = it % 384; const int b = rest / 96; rest -= b * 96; const int head = rest >> 2, r4 = rest & 3;
    const int m0 = mb * 32, q = lane & 31, h = lane >> 5;
    const int qpos = r4 + 4 * (m0 + q);
    const bf16* base = PROJ + (size_t)b * SEQ * INC;
    s16x8 qf[4]; load_rot(qf, base + (size_t)qpos * INC + QOFF + head * HD, qpos, h, rope, C2, true);
    f32x16 o0 = {}, o1 = {}; float mrun = -1e30f, lrun = 0.f;
    const bf16* Kb = base + KOFF + head * HD; const bf16* Vb = base + VOFF + head * HD;
#pragma unroll 1
    for (int t = 0; t < 8; ++t) { const int ab = 4 * m0 - 128 + 32 * t; if (ab + 31 < 0) continue; tile<false>(Kb, Vb, rope, vl, lane, ab, 0, 1, qpos, 128u, qf, o0, o1, mrun, lrun); }
#pragma unroll 1
    for (int t = 0; t < 5; ++t) { const int ab = m0 - 128 + 32 * t; if (ab + 31 < 0) continue; tile<false>(Kb, Vb, rope, vl, lane, ab, r4, 4, m0 + q, 128u, qf, o0, o1, mrun, lrun); }
#pragma unroll 1
    for (int t = 0; t <= mb; ++t) tile<true>(Kb, Vb, rope, vl, lane, 32 * t, r4, 4, m0 + q, 0x7fffffffu, qf, o0, o1, mrun, lrun);
    const float inv = 1.0f / (lrun + __shfl_xor(lrun, 32));
    bf16* orow = YATT + (size_t)(b * SEQ + qpos) * AW + head * HD + 4 * h;
#pragma unroll
    for (int gq = 0; gq < 4; ++gq) {
        u32x2v a, c; a.x = pk2(o0[4 * gq] * inv, o0[4 * gq + 1] * inv); a.y = pk2(o0[4 * gq + 2] * inv, o0[4 * gq + 3] * inv);
        c.x = pk2(o1[4 * gq] * inv, o1[4 * gq + 1] * inv); c.y = pk2(o1[4 * gq + 2] * inv, o1[4 * gq + 3] * inv);
        *(u32x2v*)(orow + 8 * gq) = a; *(u32x2v*)(orow + 32 + 8 * gq) = c; }
}
}

struct Args { const float* in[15]; float* out; unsigned char* ws; int ph_lo, ph_hi; };
static_assert(sizeof(Args) == 15 * 8 + 8 + 8 + 8, "Args has no padding");

__global__ void __launch_bounds__(NWAVES * 64, 2) fwd(Args args) {
    extern __shared__ __attribute__((aligned(16))) unsigned char lds[];
    LAS unsigned char* L = (LAS unsigned char*)lds;
    volatile LAS unsigned* MISC = (volatile LAS unsigned*)(L + MISC_OFF);
    const int tid = threadIdx.x, lane = tid & 63, wave = __builtin_amdgcn_readfirstlane(tid >> 6);
    const int G = gridDim.x; const int bx = blockIdx.x; const int vcu = (G % 8 == 0) ? (bx % 8) * (G / 8) + bx / 8 : bx;
    unsigned char* ws = args.ws;
    gu32* ctl = (gu32*)(ws + WS_CTL);
    const float* x = args.in[0]; const float* mix_g = args.in[1]; const float* w_in = args.in[2]; const float* conv_w = args.in[3]; const float* conv_g = args.in[4];
    const float* attn_g = args.in[5]; const float* w_out = args.in[6]; const float* ffn_g = args.in[7]; const float* w_router = args.in[8]; const float* b_router = args.in[9];
    const float* w_gu = args.in[10]; const float* b_gu = args.in[11]; const float* w_dn = args.in[12]; const float* b_dn = args.in[13]; const float* fin_g = args.in[14];
    float* out = args.out;
    float* ROPE = (float*)(ws + WS_ROPE);
    int* TOKE = (int*)(ws + WS_TOKE); int* TOKR = (int*)(ws + WS_TOKR); float* TOKG = (float*)(ws + WS_TOKG); int* LIST = (int*)(ws + WS_LIST);
    bf16* WIN = (bf16*)(ws + WS_WIN); bf16* WO = (bf16*)(ws + WS_WO); bf16* XN = (bf16*)(ws + WS_XN); bf16* PROJ = (bf16*)(ws + WS_PROJ); bf16* YATT = (bf16*)(ws + WS_YATT);
    bf16* MIXED = (bf16*)(ws + WS_MIXED); float* X1 = (float*)(ws + WS_X1); bf16* XN2 = (bf16*)(ws + WS_XN2); bf16* XS = (bf16*)(ws + WS_XS); bf16* ACT = (bf16*)(ws + WS_ACT);
    bf16* YB = (bf16*)(ws + WS_Y); bf16* WGU = (bf16*)(ws + WS_WGU); bf16* WDN = (bf16*)(ws + WS_WDN);

    for (int u = tid; u < (LDS_BYTES - LDSCTL_OFF) / 4; u += NWAVES * 64) ((LAS unsigned*)(L + LDSCTL_OFF))[u] = 0u;
    __syncthreads();
    XcdBarrier bar; bar.bar = (unsigned*)(ctl + CW_BAR); bar.x = 0; bar.st = nullptr;
    if (MK_N_LAUNCHES == 1) bar = xcd_barrier_post((unsigned*)(ctl + CW_BAR), MISC + 8);
    const int lo = args.ph_lo, hi = args.ph_hi;
#define IN(k) (lo <= (k) && (k) < hi)
#define BOTH(k) (IN(k) && IN((k) + 1))
#define GRID_BAR() do { if (MK_N_LAUNCHES == 1) xcd_barrier(bar); } while (0)
    const int gw = vcu * NWAVES + wave, NGW = G * NWAVES;

    if (IN(0)) {
        LAS float* scr = (LAS float*)(L + wave * 16384);
        constexpr int I_IN = 32 * (INC / 32), I_O = 32 * (DM / 32), I_GU = 32 * (4096 / 32), I_DN = 32 * (DM / 32);
        constexpr int NIT = I_IN + I_O + NE * I_GU + NE * I_DN;
        for (int it = gw; it < NIT; it += NGW) {
            int r = it;
            if (r < I_IN) { const int nblk = INC / 32, kb = r / nblk, nb = r % nblk; p0_transpose_item(w_in, INC, DM, WIN, 64 * kb, 32 * nb, 32 * nb, scr, lane); continue; } r -= I_IN;
            if (r < I_O) { const int nblk = DM / 32, kb = r / nblk, nb = r % nblk; p0_transpose_item(w_out, DM, DM, WO, 64 * kb, 32 * nb, 32 * nb, scr, lane); continue; } r -= I_O;
            if (r < NE * I_GU) { const int e = r / I_GU, rr = r % I_GU; const int nblk = 4096 / 32, kb = rr / nblk, nb = rr % nblk; const int n0 = 32 * nb;
                const int orow = (n0 < 2048) ? ((n0 >> 7) * 256 + (n0 & 127)) : ((((n0 - 2048) >> 7) * 256) + 128 + ((n0 - 2048) & 127));
                p0_transpose_item(w_gu + (size_t)e * 2048 * 4096, 4096, DM, WGU + (size_t)e * 4096 * 2048, 64 * kb, n0, orow, scr, lane); continue; } r -= NE * I_GU;
            { const int e = r / I_DN, rr = r % I_DN; const int nblk = DM / 32, kb = rr / nblk, nb = rr % nblk;
                p0_transpose_item(w_dn + (size_t)e * 2048 * 2048, DM, DE, WDN + (size_t)e * 2048 * 2048, 64 * kb, 32 * nb, 32 * nb, scr, lane); }
        }
        for (int i = gw * 64 + lane; i < SEQ * 8; i += NGW * 64) { const int pos = i >> 3, f = i & 7;
            const float inv_freq = exp2f(-(float)f * 0.125f * 18.931568569324174f);
            const float ang = (float)pos * inv_freq;
            const double a = (double)ang; const double k = rint(a * 0.15915494309189535); const float red = (float)(a - k * 6.283185307179586);
            ROPE[pos * 16 + f] = cosf(red); ROPE[pos * 16 + 8 + f] = sinf(red); }
        for (int m = gw; m < NTOK; m += NGW) {
            const GAS f32x4* xr = (const GAS f32x4*)(x + (size_t)m * DM) + lane; const GAS f32x4* gr = (const GAS f32x4*)mix_g + lane;
            f32x4 v[8]; float s = 0.f;
#pragma unroll
            for (int j = 0; j < 8; ++j) { v[j] = xr[64 * j]; s += (v[j].x * v[j].x + v[j].y * v[j].y) + (v[j].z * v[j].z + v[j].w * v[j].w); }
            const float rstd = 1.0f / sqrtf(wave_sum(s) * (1.0f / DM) + EPS);
            GAS u32x2v* o8 = (GAS u32x2v*)(XN + (size_t)m * DM) + lane;
#pragma unroll
            for (int j = 0; j < 8; ++j) { const f32x4 gg = gr[64 * j]; u32x2v o; o.x = pk2(v[j].x * rstd * gg.x, v[j].y * rstd * gg.y); o.y = pk2(v[j].z * rstd * gg.z, v[j].w * rstd * gg.w); o8[64 * j] = o; }
        }
        if (BOTH(0)) GRID_BAR();
    }

    if (IN(1)) {
        pg8::Gemm g{XN, WIN, NTOK, INC, DM}; pg8::StaticOrder S; S.init(NTOK, INC, G, (int)blockIdx.x);
        pg8::EpiBf16Plain E{PROJ, INC};
        pg8::gemm_phase<pg8::EpiBf16Plain, pg8::StaticOrder, true, true>(L, g, S, E);
        if (BOTH(1)) GRID_BAR();
    }

    if (IN(2)) {
        LAS char* vl = (LAS char*)(L + wave * att::WAVE_LDS);
        for (;;) {
            int it = 0; if (lane == 0) it = (int)__hip_atomic_fetch_add(ctl + CW_ATTQ, 1u, __ATOMIC_RELAXED, __HIP_MEMORY_SCOPE_AGENT);
            it = __builtin_amdgcn_readfirstlane(it);
            if (it >= att::NITEMS) break;
            att::item(it, PROJ, YATT, ROPE, vl, lane);
        }
        if (BOTH(2)) GRID_BAR();
    }

    if (IN(3)) {
        for (int m = gw; m < NTOK; m += NGW) {
            const int spos = m & (SEQ - 1);
            const bf16* pr = PROJ + (size_t)m * INC + 8 * lane;
            float u[3][8];
#pragma unroll
            for (int d = 0; d < 3; ++d) {
                const int back = 2 - d;
                if (spos >= back) { const v4u cx = *(const v4u*)(pr - (size_t)back * INC); const v4u cc = *(const v4u*)(pr - (size_t)back * INC + 2 * CW);
                    u[d][0] = bf_lo(cx.x) * bf_lo(cc.x); u[d][1] = bf_hi(cx.x) * bf_hi(cc.x); u[d][2] = bf_lo(cx.y) * bf_lo(cc.y); u[d][3] = bf_hi(cx.y) * bf_hi(cc.y);
                    u[d][4] = bf_lo(cx.z) * bf_lo(cc.z); u[d][5] = bf_hi(cx.z) * bf_hi(cc.z); u[d][6] = bf_lo(cx.w) * bf_lo(cc.w); u[d][7] = bf_hi(cx.w) * bf_hi(cc.w); }
                else {
#pragma unroll
                    for (int j = 0; j < 8; ++j) u[d][j] = 0.f; }
            }
            const v4u cb = *(const v4u*)(pr + CW);
            float bb[8] = {bf_lo(cb.x), bf_hi(cb.x), bf_lo(cb.y), bf_hi(cb.y), bf_lo(cb.z), bf_hi(cb.z), bf_lo(cb.w), bf_hi(cb.w)};
            float y[8]; float s = 0.f;
#pragma unroll
            for (int j = 0; j < 8; ++j) { const int c = 8 * lane + j; const float acc = conv_w[c] * u[0][j] + conv_w[CW + c] * u[1][j] + conv_w[2 * CW + c] * u[2][j]; y[j] = bb[j] * acc; s += y[j] * y[j]; }
            const float rc = 1.0f / sqrtf(wave_sum(s) * (1.0f / CW) + EPS);
            { v4u o; const float* gq = conv_g + 8 * lane;
              o.x = pk2(y[0] * rc * gq[0], y[1] * rc * gq[1]); o.y = pk2(y[2] * rc * gq[2], y[3] * rc * gq[3]); o.z = pk2(y[4] * rc * gq[4], y[5] * rc * gq[5]); o.w = pk2(y[6] * rc * gq[6], y[7] * rc * gq[7]);
              *(v4u*)(MIXED + (size_t)m * DM + 8 * lane) = o; }
            const bf16* ya = YATT + (size_t)m * AW + 8 * lane;
            v4u a[3]; float s2 = 0.f;
#pragma unroll
            for (int j = 0; j < 3; ++j) { a[j] = *(const v4u*)(ya + 512 * j);
                const float f0 = bf_lo(a[j].x), f1 = bf_hi(a[j].x), f2 = bf_lo(a[j].y), f3 = bf_hi(a[j].y), f4 = bf_lo(a[j].z), f5 = bf_hi(a[j].z), f6 = bf_lo(a[j].w), f7 = bf_hi(a[j].w);
                s2 += (f0 * f0 + f1 * f1) + (f2 * f2 + f3 * f3) + (f4 * f4 + f5 * f5) + (f6 * f6 + f7 * f7); }
            const float ra = 1.0f / sqrtf(wave_sum(s2) * (1.0f / AW) + EPS);
#pragma unroll
            for (int j = 0; j < 3; ++j) { const float* gq = attn_g + 512 * j + 8 * lane; v4u o;
                o.x = pk2(bf_lo(a[j].x) * ra * gq[0], bf_hi(a[j].x) * ra * gq[1]); o.y = pk2(bf_lo(a[j].y) * ra * gq[2], bf_hi(a[j].y) * ra * gq[3]);
                o.z = pk2(bf_lo(a[j].z) * ra * gq[4], bf_hi(a[j].z) * ra * gq[5]); o.w = pk2(bf_lo(a[j].w) * ra * gq[6], bf_hi(a[j].w) * ra * gq[7]);
                *(v4u*)(MIXED + (size_t)m * DM + CW + 512 * j + 8 * lane) = o; }
        }
        if (BOTH(3)) GRID_BAR();
    }

    if (IN(4)) {
        pg8::Gemm g{MIXED, WO, NTOK, DM, DM}; pg8::StaticOrder S; S.init(NTOK, DM, G, (int)blockIdx.x);
        pg8::EpiResF32 E{x, X1, DM};
        pg8::gemm_phase<pg8::EpiResF32, pg8::StaticOrder, false, true>(L, g, S, E);
        if (BOTH(4)) GRID_BAR();
    }

    if (IN(5)) {
        LAS float* H2 = (LAS float*)L;
        LAS float* PART = (LAS float*)(L + 65536);
        for (int grp = vcu; grp < NTOK / 8; grp += G) {
            const int tok = grp * 8 + wave;
            {
                const GAS f32x4* xr = (const GAS f32x4*)(X1 + (size_t)tok * DM) + lane; const GAS f32x4* gr = (const GAS f32x4*)ffn_g + lane;
                f32x4 v[8]; float s = 0.f;
#pragma unroll
                for (int j = 0; j < 8; ++j) { v[j] = xr[64 * j]; s += (v[j].x * v[j].x + v[j].y * v[j].y) + (v[j].z * v[j].z + v[j].w * v[j].w); }
                const float rstd = 1.0f / sqrtf(wave_sum(s) * (1.0f / DM) + EPS);
                GAS u32x2v* o8 = (GAS u32x2v*)(XN2 + (size_t)tok * DM) + lane;
#pragma unroll
                for (int j = 0; j < 8; ++j) { const f32x4 gg = gr[64 * j]; f32x4 hh; hh.x = v[j].x * rstd * gg.x; hh.y = v[j].y * rstd * gg.y; hh.z = v[j].z * rstd * gg.z; hh.w = v[j].w * rstd * gg.w;
                    u32x2v o; o.x = pk2(hh.x, hh.y); o.y = pk2(hh.z, hh.w); o8[64 * j] = o;
                    *(LAS f32x4*)(H2 + wave * 2048 + 4 * lane + 256 * j) = hh; }
            }
            __syncthreads();
            {
                const int e = lane & 31, kbase = 256 * wave + 128 * (lane >> 5);
                float acc[8];
#pragma unroll
                for (int t = 0; t < 8; ++t) acc[t] = 0.f;
#pragma unroll 2
                for (int kk = 0; kk < 128; kk += 4) { const int k = kbase + kk;
                    const float w0 = w_router[(size_t)(k + 0) * NE + e], w1 = w_router[(size_t)(k + 1) * NE + e], w2 = w_router[(size_t)(k + 2) * NE + e], w3 = w_router[(size_t)(k + 3) * NE + e];
#pragma unroll
                    for (int t = 0; t < 8; ++t) { const f32x4 hv = *(const LAS f32x4*)(H2 + t * 2048 + k); acc[t] += (hv.x * w0 + hv.y * w1) + (hv.z * w2 + hv.w * w3); } }
#pragma unroll
                for (int t = 0; t < 8; ++t) { acc[t] += __shfl_xor(acc[t], 32); if (lane < 32) PART[(wave * 8 + t) * 32 + e] = acc[t]; }
            }
            __syncthreads();
            {
                float lg = -INFINITY;
                if (lane < 32) { float s = b_router[lane];
#pragma unroll
                    for (int w = 0; w < 8; ++w) s += PART[(w * 8 + wave) * 32 + lane]; lg = s; }
                float tv[4]; int ti[4];
#pragma unroll
                for (int k = 0; k < 4; ++k) { float bv = lg; int bi = lane;
#pragma unroll
                    for (int o = 1; o < 64; o <<= 1) { const float ov = __shfl_xor(bv, o); const int oi = __shfl_xor(bi, o); if (ov > bv || (ov == bv && oi < bi)) { bv = ov; bi = oi; } }
                    tv[k] = bv; ti[k] = bi; if (lane == bi) lg = -INFINITY; }
                const float e1 = __expf(tv[1] - tv[0]), e2 = __expf(tv[2] - tv[0]), e3 = __expf(tv[3] - tv[0]); const float den = 1.0f / (1.0f + e1 + e2 + e3);
                if (lane < 4) { const int ee = lane == 0 ? ti[0] : lane == 1 ? ti[1] : lane == 2 ? ti[2] : ti[3]; const float gg = (lane == 0 ? 1.0f : lane == 1 ? e1 : lane == 2 ? e2 : e3) * den;
                    const int rank = (int)__hip_atomic_fetch_add(ctl + CW_CNT + 16 * ee, 1u, __ATOMIC_RELAXED, __HIP_MEMORY_SCOPE_AGENT);
                    LIST[ee * NTOK + rank] = tok; TOKE[tok * 4 + lane] = ee; TOKR[tok * 4 + lane] = rank; TOKG[tok * 4 + lane] = gg; }
            }
            __syncthreads();
        }
        if (BOTH(5)) GRID_BAR();
    }

    LAS int* TS = (LAS int*)(L + TAB_TS); LAS int* CN = (LAS int*)(L + TAB_CN);
    if (hi > 6) {
        if (tid == 0) { int acc = 0; for (int e = 0; e < NE; ++e) { const int c = (int)__hip_atomic_load(ctl + CW_CNT + 16 * e, __ATOMIC_RELAXED, __HIP_MEMORY_SCOPE_AGENT); CN[e] = c; TS[e] = acc; acc += (c + 255) >> 8; } TS[NE] = acc; }
        __syncthreads();
    }

    if (IN(6)) {
        const int nrows = TS[NE] * 256;
        for (int row = gw; row < nrows; row += NGW) {
            const int rt = row >> 8; int e = 0;
#pragma unroll 1
            for (int j = 1; j < NE; ++j) e += (TS[j] <= rt) ? 1 : 0;
            const int rank = row - TS[e] * 256; const bool valid = rank < CN[e];
            v4u v[4];
            if (valid) { const int tok = LIST[e * NTOK + rank]; const v4u* src = (const v4u*)(XN2 + (size_t)tok * DM) + lane;
#pragma unroll
                for (int j = 0; j < 4; ++j) v[j] = src[64 * j]; }
            else {
#pragma unroll
                for (int j = 0; j < 4; ++j) v[j] = (v4u){0u, 0u, 0u, 0u}; }
            v4u* dst = (v4u*)(XS + (size_t)row * DM) + lane;
#pragma unroll
            for (int j = 0; j < 4; ++j) dst[64 * j] = v[j];
        }
        if (BOTH(6)) GRID_BAR();
    }

    if (IN(7)) {
        pg8::Gemm g{XS, WGU, MAXSLOT, NE * 4096, DM}; pg8::GroupedOrder S{(const PG8_LAS int*)TS, 16, G, vcu};
        pg8::EpiSwiGLU E{ACT, b_gu};
        pg8::gemm_phase<pg8::EpiSwiGLU, pg8::GroupedOrder, true, true>(L, g, S, E);
        if (BOTH(7)) GRID_BAR();
    }

    if (IN(8)) {
        pg8::Gemm g{ACT, WDN, MAXSLOT, NE * 2048, DE}; pg8::GroupedOrder S{(const PG8_LAS int*)TS, 8, G, vcu};
        pg8::EpiBf16Plain E{YB, DM};
        pg8::gemm_phase<pg8::EpiBf16Plain, pg8::GroupedOrder, true, true>(L, g, S, E);
        if (BOTH(8)) GRID_BAR();
    }

    if (IN(9)) {
        unsigned poison = __hip_atomic_load(ctl + CW_BAR + XB_TMO, RLX_AGENT) != 0u;
        for (int m = gw; m < NTOK; m += NGW) {
            const GAS f32x4* xr = (const GAS f32x4*)(X1 + (size_t)m * DM) + lane;
            f32x4 v[8];
#pragma unroll
            for (int j = 0; j < 8; ++j) v[j] = xr[64 * j];
#pragma unroll 1
            for (int k = 0; k < TOPK; ++k) { const int e = TOKE[m * 4 + k], rank = TOKR[m * 4 + k]; const float gt = TOKG[m * 4 + k];
                const size_t slot = (size_t)TS[e] * 256 + rank;
                const GAS u32x2v* yr = (const GAS u32x2v*)(YB + slot * DM) + lane; const GAS f32x4* br = (const GAS f32x4*)(b_dn + (size_t)e * DM) + lane;
#pragma unroll
                for (int j = 0; j < 8; ++j) { const u32x2v yy = yr[64 * j]; const f32x4 bb = br[64 * j];
                    v[j].x += gt * (bf_lo(yy.x) + bb.x); v[j].y += gt * (bf_hi(yy.x) + bb.y); v[j].z += gt * (bf_lo(yy.y) + bb.z); v[j].w += gt * (bf_hi(yy.y) + bb.w); } }
            float s = 0.f;
#pragma unroll
            for (int j = 0; j < 8; ++j) s += (v[j].x * v[j].x + v[j].y * v[j].y) + (v[j].z * v[j].z + v[j].w * v[j].w);
            float rstd = 1.0f / sqrtf(wave_sum(s) * (1.0f / DM) + EPS);
            if (poison) rstd = __builtin_nanf("");
            GAS f32x4* orow = (GAS f32x4*)(out + (size_t)m * DM) + lane; const GAS f32x4* gr = (const GAS f32x4*)fin_g + lane;
#pragma unroll
            for (int j = 0; j < 8; ++j) { const f32x4 gg = gr[64 * j]; f32x4 o; o.x = v[j].x * rstd * gg.x; o.y = v[j].y * rstd * gg.y; o.z = v[j].z * rstd * gg.z; o.w = v[j].w * rstd * gg.w; orow[64 * j] = o; }
        }
    }
#undef IN
#undef BOTH
#undef GRID_BAR
}

extern "C" void kernel_launch(void* const* d_in, const int* in_sizes, int n_in, void* d_out, int out_size, void* d_ws, size_t ws_size, hipStream_t stream) {
    static int grid = 0;
    if (grid == 0) {
        if (n_in != 15 || in_sizes[0] != NTOK * DM || out_size != NTOK * DM || ws_size < WS_END) { fprintf(stderr, "kernel_launch: unexpected shapes / workspace (n_in %d, ws %zu)\n", n_in, ws_size); grid = -1; return; }
        int dev = 0, cus = 0, per_cu = 0;
        if (hipGetDevice(&dev) != hipSuccess || hipDeviceGetAttribute(&cus, hipDeviceAttributeMultiprocessorCount, dev) != hipSuccess) { grid = -1; return; }
        if (hipFuncSetAttribute((const void*)fwd, hipFuncAttributeMaxDynamicSharedMemorySize, LDS_BYTES) != hipSuccess) { fprintf(stderr, "kernel_launch: hipFuncSetAttribute failed\n"); grid = -1; return; }
        if (hipOccupancyMaxActiveBlocksPerMultiprocessor(&per_cu, (const void*)fwd, NWAVES * 64, LDS_BYTES) != hipSuccess || per_cu < 1) fprintf(stderr, "kernel_launch: occupancy query says %d\n", per_cu);
        (void)hipGetLastError();
        grid = cus;
    }
    if (grid < 0) return;
    if (hipMemsetAsync((char*)d_ws + WS_CTL, 0, CTL_ZERO_BYTES, stream) != hipSuccess) return;
    Args a{};
    for (int i = 0; i < 15; ++i) a.in[i] = (const float*)d_in[i];
    a.out = (float*)d_out; a.ws = (unsigned char*)d_ws;
    if (MK_N_LAUNCHES == 1) { a.ph_lo = 0; a.ph_hi = NPH; hipLaunchKernelGGL(fwd, dim3(grid), dim3(NWAVES * 64), LDS_BYTES, stream, a); }
    else { for (int p = 0; p < NPH; ++p) { a.ph_lo = p; a.ph_hi = p + 1; hipLaunchKernelGGL(fwd, dim3(grid), dim3(NWAVES * 64), LDS_BYTES, stream, a); } }
    const hipError_t le = hipPeekAtLastError();
    if (le != hipSuccess) fprintf(stderr, "kernel_launch: launch failed: %s\n", hipGetErrorName(le));
}
```

```cpp
#include <hip/hip_runtime.h>
#include <cstdio>
#include <cstdint>
namespace pg8 {
#define PG8_LAS __attribute__((address_space(3)))
typedef unsigned short bf16_t;
typedef short bf16x8 __attribute__((ext_vector_type(8)));
typedef float f32x4 __attribute__((ext_vector_type(4)));
typedef unsigned u32x4 __attribute__((ext_vector_type(4)));
constexpr int BM = 256, BK = 64, HALF = 128, HTB = HALF * BK * 2  , STAGE_BYTES = 8 * HTB, NXCD = 8, WGM = 8;

__host__ __device__ __forceinline__ int lds_byte(int r, int c) { const int st = (r >> 4) * 2 + (c >> 5), rr = r & 15, cc = c & 31, ob = rr * 64 + cc * 2; return st * 1024 + (ob ^ (((ob >> 9) & 1) << 5)); }
__host__ __device__ __forceinline__ void stage_rc(int b, int& R, int& C) { const int st = b / 1024, sb = b % 1024, swz = sb ^ (((sb >> 9) & 1) << 5); R = (st >> 1) * 16 + swz / 64; C = (st & 1) * 32 + (swz % 64) / 2; }
__host__ __device__ __forceinline__ int perm32(int rho) { const int n = rho >> 4, i = rho & 15; return 8 * (i >> 2) + 4 * n + (i & 3); }

struct Unit { int pm, pn, e, cn, rows; long boff; };
struct Gemm { const bf16_t* A; const bf16_t* Bt; int M, N, K; int b_ntot, b_hstep; };

struct StaticOrder {
    int nM, nN, nwg, G, c;
    __host__ __device__ void init(int M, int N, int G_, int c_) { nM = M / BM; nN = N / BM; nwg = nM * nN; G = G_; c = c_; }
    __host__ __device__ bool next(int i, Unit& u) const {
        const long L = (long)i * G + c; if (L >= nwg) return false;
        int wgid = (int)L; { const int q = nwg / NXCD, r = nwg % NXCD, xcd = wgid % NXCD, off = wgid / NXCD; wgid = (xcd < r ? xcd * (q + 1) : r * (q + 1) + (xcd - r) * q) + off; }
        const int nig = WGM * nN, gid = wgid / nig, fm = gid * WGM, gsz = (nM - fm) < WGM ? (nM - fm) : WGM;
        u.pm = fm + ((wgid % nig) % gsz); u.pn = (wgid % nig) / gsz; u.e = 0; u.cn = u.pn; u.rows = BM; u.boff = 0; return true;
    }
    __device__ __forceinline__ void a_ready(const Unit&) const {}
    __device__ __forceinline__ void done(const Unit&) const {}
};
struct GroupedOrder {
    const PG8_LAS int* TS; const PG8_LAS int* CN; int nN, G, v; long b_estride; int b_cnstep;
    __device__ __forceinline__ bool next(int i, Unit& u) const {
        const int U = i * G + v; const int total = __builtin_amdgcn_readfirstlane(TS[32] * nN); if (U >= total) return false;
        int e = 0;
#pragma unroll 1
        for (int j = 1; j < 32; ++j) e += (TS[j] * nN <= U) ? 1 : 0;
        const int t0 = TS[e], nt = TS[e + 1] - t0, loc = U - t0 * nN; const int pn = loc / nt, rt = loc - pn * nt; const int left = CN[e] - rt * BM;
        u.pm = __builtin_amdgcn_readfirstlane(e * 32 + rt); u.pn = __builtin_amdgcn_readfirstlane(e * nN + pn); u.e = __builtin_amdgcn_readfirstlane(e); u.cn = __builtin_amdgcn_readfirstlane(pn);
        u.rows = __builtin_amdgcn_readfirstlane(left < BM ? left : BM); u.boff = (long)u.e * b_estride + (long)u.cn * b_cnstep; return true;
    }
    __device__ __forceinline__ void a_ready(const Unit&) const {}
    __device__ __forceinline__ void done(const Unit&) const {}
};

__device__ __forceinline__ unsigned cvt_pk_bf16(float lo, float hi) { unsigned r; asm volatile("v_cvt_pk_bf16_f32 %0, %1, %2" : "=v"(r) : "v"(lo), "v"(hi)); return r; }

struct EpiBf16Plain {
    static constexpr bool PERM = true, AFTER_DRAIN = false;
    bf16_t* O; int ldc; float sc; const float* bias;
    __device__ __forceinline__ void operator()(const f32x4 (&acc)[2][2][4][2], const Unit& u, int wr, int wc, int fr, int fq) const {
        const int row0 = u.pm * BM + wr * 64 + fr, col0 = u.cn * BM + wc * 32 + 8 * fq;
        f32x4 bv[2][2];
#pragma unroll
        for (int bj = 0; bj < 2; ++bj)
#pragma unroll
            for (int n = 0; n < 2; ++n) bv[bj][n] = bias ? *(const f32x4*)(bias + (size_t)u.e * ldc + col0 + bj * HALF + 4 * n) : (f32x4){0.f, 0.f, 0.f, 0.f};
#pragma unroll
        for (int ai = 0; ai < 2; ++ai) { if (ai == 1 && u.rows <= HALF) break;
#pragma unroll
            for (int m = 0; m < 4; ++m) { bf16_t* rowp = O + (size_t)(row0 + ai * HALF + m * 16) * ldc + col0;
#pragma unroll
                for (int bj = 0; bj < 2; ++bj) { const f32x4 v0 = acc[ai][bj][m][0] * sc + bv[bj][0], v1 = acc[ai][bj][m][1] * sc + bv[bj][1];
                    u32x4 w; w.x = cvt_pk_bf16(v0[0], v0[1]); w.y = cvt_pk_bf16(v0[2], v0[3]); w.z = cvt_pk_bf16(v1[0], v1[1]); w.w = cvt_pk_bf16(v1[2], v1[3]);
                    *(u32x4*)(rowp + bj * HALF) = w; } } }
    }
};
struct EpiProj {
    static constexpr bool PERM = true, AFTER_DRAIN = false;
    bf16_t* O; const float* rope; float qscale;
    __device__ __forceinline__ void operator()(const f32x4 (&acc)[2][2][4][2], const Unit& u, int wr, int wc, int fr, int fq) const {
        const int row0 = u.pm * BM + wr * 64 + fr, col0 = u.cn * BM + wc * 32 + 8 * fq;
        const bool isq = (u.cn >= 6 && u.cn < 12), isk = (u.cn >= 12 && u.cn < 18);
        const bool rot = (isq || isk) && ((wc & 1) == 0);
        const float sc = isq ? qscale : 1.0f;
        const float sg = (fq == 0) ? -1.0f : 1.0f;
        const bool act = fq < 2;
#pragma unroll
        for (int ai = 0; ai < 2; ++ai)
#pragma unroll
            for (int m = 0; m < 4; ++m) { const int row = row0 + ai * HALF + m * 16; bf16_t* rowp = O + (size_t)row * 6144 + col0;
                f32x4 c0 = {1.f, 1.f, 1.f, 1.f}, c1 = c0, s0 = {0.f, 0.f, 0.f, 0.f}, s1 = s0;
                if (rot) { const float* rp = rope + (row & 2047) * 16; c0 = *(const f32x4*)rp; c1 = *(const f32x4*)(rp + 4); s0 = *(const f32x4*)(rp + 8); s1 = *(const f32x4*)(rp + 12); }
#pragma unroll
                for (int bj = 0; bj < 2; ++bj) { f32x4 v0 = acc[ai][bj][m][0], v1 = acc[ai][bj][m][1];
                    if (rot) { f32x4 o0, o1;
#pragma unroll
                        for (int i = 0; i < 4; ++i) { o0[i] = __shfl_xor(v0[i], 16); o1[i] = __shfl_xor(v1[i], 16); }
                        const f32x4 r0 = v0 * c0 + (o0 * s0) * sg, r1 = v1 * c1 + (o1 * s1) * sg;
                        v0 = act ? r0 : v0; v1 = act ? r1 : v1; }
                    v0 = v0 * sc; v1 = v1 * sc;
                    u32x4 w; w.x = cvt_pk_bf16(v0[0], v0[1]); w.y = cvt_pk_bf16(v0[2], v0[3]); w.z = cvt_pk_bf16(v1[0], v1[1]); w.w = cvt_pk_bf16(v1[2], v1[3]);
                    *(u32x4*)(rowp + bj * HALF) = w; } }
    }
};
struct EpiResF32 {
    static constexpr bool PERM = false, AFTER_DRAIN = false;
    const float* base; float* out; int ldc;
    __device__ __forceinline__ void operator()(const f32x4 (&acc)[2][2][4][2], const Unit& u, int wr, int wc, int fr, int fq) const {
        const int row0 = u.pm * BM + wr * 64 + fr, col0 = u.cn * BM + wc * 32 + 4 * fq;
#pragma unroll
        for (int ai = 0; ai < 2; ++ai)
#pragma unroll
            for (int m = 0; m < 4; ++m) { const size_t off = (size_t)(row0 + ai * HALF + m * 16) * ldc + col0;
#pragma unroll
                for (int bj = 0; bj < 2; ++bj)
#pragma unroll
                    for (int n = 0; n < 2; ++n) { const f32x4 b = *(const f32x4*)(base + off + bj * HALF + n * 16); *(f32x4*)(out + off + bj * HALF + n * 16) = acc[ai][bj][m][n] + b; } }
    }
};
__device__ __forceinline__ float swiglu1(float g, float up) {
    g = fminf(g, 7.0f); up = fminf(fmaxf(up, -7.0f), 7.0f);
    const float e = __builtin_amdgcn_exp2f(g * (-1.702f * 1.4426950408889634f));
    return (up + 1.0f) * g * __builtin_amdgcn_rcpf(1.0f + e);
}
__device__ __forceinline__ unsigned pk4_fp8(float a, float b, float c, float d) {
    a = fminf(fmaxf(a, -448.f), 448.f); b = fminf(fmaxf(b, -448.f), 448.f); c = fminf(fmaxf(c, -448.f), 448.f); d = fminf(fmaxf(d, -448.f), 448.f);
    int w = 0; w = __builtin_amdgcn_cvt_pk_fp8_f32(a, b, w, false); w = __builtin_amdgcn_cvt_pk_fp8_f32(c, d, w, true); return (unsigned)w; }
constexpr float FP8_W_SCALE = 64.f, FP8_X_SCALE = 16.f, FP8_ACT_SCALE = 4.f;
struct EpiFp8Y {
    static constexpr bool PERM = true, AFTER_DRAIN = false;
    unsigned char* O; float sc; const float* bias;
    __device__ __forceinline__ void operator()(const f32x4 (&acc)[2][2][4][2], const Unit& u, int wr, int wc, int fr, int fq) const {
        const int row0 = u.pm * BM + wr * 64 + fr, col0 = u.cn * BM + wc * 32 + 8 * fq;
        f32x4 bv[2][2];
#pragma unroll
        for (int bj = 0; bj < 2; ++bj)
#pragma unroll
            for (int n = 0; n < 2; ++n) bv[bj][n] = *(const f32x4*)(bias + (size_t)u.e * 2048 + col0 + bj * HALF + 4 * n);
#pragma unroll
        for (int ai = 0; ai < 2; ++ai) { if (ai == 1 && u.rows <= HALF) break;
#pragma unroll
            for (int m = 0; m < 4; ++m) { unsigned char* rowp = O + (size_t)(row0 + ai * HALF + m * 16) * 2048 + col0;
#pragma unroll
                for (int bj = 0; bj < 2; ++bj) { const f32x4 v0 = (acc[ai][bj][m][0] * sc + bv[bj][0]) * 16.f, v1 = (acc[ai][bj][m][1] * sc + bv[bj][1]) * 16.f;
                    typedef unsigned u32x2y __attribute__((ext_vector_type(2))); u32x2y w; w.x = pk4_fp8(v0[0], v0[1], v0[2], v0[3]); w.y = pk4_fp8(v1[0], v1[1], v1[2], v1[3]);
                    *(u32x2y*)(rowp + bj * HALF) = w; } } }
    }
};
struct EpiSwiGLU {
    static constexpr bool PERM = true, AFTER_DRAIN = false;
    unsigned char* O; const float* bias;
    __device__ __forceinline__ void operator()(const f32x4 (&acc)[2][2][4][2], const Unit& u, int wr, int wc, int fr, int fq) const {
        const int row0 = u.pm * BM + wr * 64 + fr, colj = u.cn * HALF + wc * 32 + 8 * fq;
        const float* bg = bias + (size_t)u.e * 4096 + colj; const float isc = 1.0f / (FP8_W_SCALE * FP8_X_SCALE);
        const f32x4 bg0 = *(const f32x4*)(bg), bg1 = *(const f32x4*)(bg + 4), bu0 = *(const f32x4*)(bg + 2048), bu1 = *(const f32x4*)(bg + 2048 + 4);
#pragma unroll
        for (int ai = 0; ai < 2; ++ai) { if (ai == 1 && u.rows <= HALF) break;
#pragma unroll
            for (int m = 0; m < 4; ++m) { unsigned char* rowp = O + (size_t)(row0 + ai * HALF + m * 16) * 2048 + colj;
                const f32x4 g0 = acc[ai][0][m][0] * isc + bg0, g1 = acc[ai][0][m][1] * isc + bg1, u0 = acc[ai][1][m][0] * isc + bu0, u1 = acc[ai][1][m][1] * isc + bu1;
                typedef unsigned u32x2e __attribute__((ext_vector_type(2))); u32x2e w;
                w.x = pk4_fp8(FP8_ACT_SCALE * swiglu1(g0[0], u0[0]), FP8_ACT_SCALE * swiglu1(g0[1], u0[1]), FP8_ACT_SCALE * swiglu1(g0[2], u0[2]), FP8_ACT_SCALE * swiglu1(g0[3], u0[3]));
                w.y = pk4_fp8(FP8_ACT_SCALE * swiglu1(g1[0], u1[0]), FP8_ACT_SCALE * swiglu1(g1[1], u1[1]), FP8_ACT_SCALE * swiglu1(g1[2], u1[2]), FP8_ACT_SCALE * swiglu1(g1[3], u1[3]));
                *(u32x2e*)rowp = w; } }
    }
};
typedef short v4i16p_t __attribute__((ext_vector_type(4)));
typedef int v2i_t __attribute__((ext_vector_type(2)));
__device__ __forceinline__ v2i_t trb(PG8_LAS const unsigned char* p) { return __builtin_bit_cast(v2i_t, __builtin_amdgcn_ds_read_tr16_b64_v4i16((PG8_LAS v4i16p_t*)p)); }
typedef int v8i_t __attribute__((ext_vector_type(8)));
typedef int v4i_t __attribute__((ext_vector_type(4)));
__device__ __forceinline__ v8i_t cat8(bf16x8 a, bf16x8 b) { const v4i_t x = __builtin_bit_cast(v4i_t, a), y = __builtin_bit_cast(v4i_t, b); return __builtin_shufflevector(x, y, 0, 1, 2, 3, 4, 5, 6, 7); }
__device__ __forceinline__ void mfma_fp8(f32x4& c, v8i_t a, v8i_t b, int sc) { asm volatile("v_mfma_scale_f32_16x16x128_f8f6f4 %0, %1, %2, %0, %3, %3 op_sel_hi:[0,0,0]" : "+v"(c) : "v"(a), "v"(b), "v"(sc)); }
struct NoSide { static constexpr bool ON = false, TWO = false; int njobs; };
struct SideConv {
    static constexpr bool ON = true, TWO = true;
    const float* W; unsigned char* OUT; int ntot; int c0, njobs; unsigned stage;
    __device__ __forceinline__ void addr(int j, int tid, const float*& s0, unsigned char*& d) const {
        const int c = c0 + j, cpk = ntot >> 11, kpg = c / cpk, half = c - kpg * cpk, e = kpg >> 10, kp = kpg & 1023;
        s0 = W + (size_t)e * 2048 * ntot + (size_t)(2 * kp) * ntot + half * 2048 + 4 * tid;
        d = OUT + ((size_t)e * 1024 + kp) * ntot * 2 + (size_t)(half * 2048 + 4 * tid) * 2;
    }
    __device__ __forceinline__ void issue(PG8_LAS unsigned char* lds0, int j, int tid, int wid) const {
        const float* s0; unsigned char* d; addr(j, tid, s0, d);
        __builtin_amdgcn_global_load_lds((const unsigned*)s0, (PG8_LAS unsigned*)(lds0 + stage + wid * 1024), 16, 0, 0);
        __builtin_amdgcn_global_load_lds((const unsigned*)(s0 + ntot), (PG8_LAS unsigned*)(lds0 + stage + 8192 + wid * 1024), 16, 0, 0);
    }
    __device__ __forceinline__ void read(v4i_t& t0, v4i_t& t1, int tid, unsigned ldsb) const {
        asm volatile("ds_read_b128 %0, %1" : "=&v"(t0) : "v"(ldsb + stage + 16u * (unsigned)tid) : "memory");
        asm volatile("ds_read_b128 %0, %1" : "=&v"(t1) : "v"(ldsb + stage + 8192u + 16u * (unsigned)tid) : "memory");
    }
    __device__ __forceinline__ void finish(v4i_t& t0, v4i_t& t1, int j, int tid) const {
        asm volatile("" : "+v"(t0), "+v"(t1));
        const float* s0; unsigned char* d; addr(j, tid, s0, d);
        const f32x4 r0 = __builtin_bit_cast(f32x4, t0) * 64.f, r1 = __builtin_bit_cast(f32x4, t1) * 64.f;
        int w0 = 0, w1 = 0; w0 = __builtin_amdgcn_cvt_pk_fp8_f32(r0[0], r1[0], w0, false); w0 = __builtin_amdgcn_cvt_pk_fp8_f32(r0[1], r1[1], w0, true);
        w1 = __builtin_amdgcn_cvt_pk_fp8_f32(r0[2], r1[2], w1, false); w1 = __builtin_amdgcn_cvt_pk_fp8_f32(r0[3], r1[3], w1, true);
        typedef int v2is __attribute__((ext_vector_type(2))); __builtin_nontemporal_store((v2is){w0, w1}, (v2is*)d);
    }
};
template <class Epi, class Sched, bool ALIGN_EPI = false, bool SP2 = false, bool FP8 = false, bool BPAIR = false, class Side = NoSide>
__device__ __forceinline__ void gemm_phase(PG8_LAS unsigned char* lds, const Gemm g, const Sched& S, const Epi& E, const Side SD = Side{}) {
    const int tid = threadIdx.x, wid = __builtin_amdgcn_readfirstlane(tid >> 6), lane = tid & 63, wr = wid >> 2, wc = wid & 3, fr = lane & 15, fq = lane >> 4;
    const int K = g.K, nt = K / BK;
    int fp8_scale1 = 0x7f7f7f7f; if constexpr (FP8) asm volatile("" : "+v"(fp8_scale1));
    unsigned voffA[2], voffB[2];
#pragma unroll
    for (int i = 0; i < 2; ++i) { int R, C; stage_rc(tid * 16 + i * 8192, R, C); const int Rb = Epi::PERM ? ((R & ~31) + perm32(R & 31)) : R;
        voffA[i] = (unsigned)(R * K + C) * 2u; voffB[i] = (unsigned)(Rb * K + C) * 2u;
        if constexpr (BPAIR) { const int b_ = tid * 16 + i * 8192, kp_ = b_ >> 8, sl_ = (b_ & 255) >> 4, pc_ = sl_ ^ (2 * ((kp_ & 3) | (((kp_ >> 3) & 1) << 2))); voffB[i] = (unsigned)(kp_ * g.b_ntot + 8 * pc_) * 2u; } }
    const size_t kstep = (size_t)(BK * 2);
    const size_t hstep = (size_t)HALF * K * 2;
    const size_t tstep = 2 * hstep;
    const size_t kstepB = BPAIR ? (size_t)64 * g.b_ntot * 2 : kstep, hstepB = BPAIR ? (size_t)g.b_hstep : hstep;
    const unsigned ldsw = (unsigned)wid * 1024u;
    const int aoff = lds_byte(wr * 64 + fr, fq * 8), boff = lds_byte(wc * 32 + fr, fq * 8);
    const int boffP = (8 * fq + ((lane & 15) >> 2)) * 256 + 16 * ((4 * wc + (lane & 3)) ^ (2 * (((lane & 15) >> 2) | ((fq & 1) << 2))));
#define PG8_SA(b, h) (((b) * 2 + (h)) * HTB)
#define PG8_SB(b, h) ((4 + (b) * 2 + (h)) * HTB)
#define PG8_STAGE(bufoff, gbase, voff) do { _Pragma("unroll") for (int _i = 0; _i < 2; ++_i) \
        __builtin_amdgcn_global_load_lds((const unsigned*)((const char*)(gbase) + (voff)[_i]), (PG8_LAS unsigned*)(lds + (bufoff) + ldsw + _i * 8192), 16, 0, 0); } while (0)
#define PG8_LDA(dst, b, h) do { _Pragma("unroll") for (int m = 0; m < 4; ++m) _Pragma("unroll") for (int k = 0; k < 2; ++k) dst[m][k] = *(const PG8_LAS bf16x8*)(lds + PG8_SA(b, h) + aoff + m * 2048 + k * 1024); } while (0)
#define PG8_TRA(dstv, addr, off) asm volatile("ds_read_b64_tr_b16 %0, %1 offset:%c2" : "=&v"(dstv) : "v"(addr), "i"(off) : "memory")
#define PG8_LDB(dst, b, h) do { if constexpr (BPAIR) { _Pragma("unroll") for (int n = 0; n < 2; ++n) { const unsigned a_ = ldsb32 + (unsigned)(PG8_SB(b, h) + boffP + 8 * n); \
            PG8_TRA(dst##r[n][0], a_, 0); PG8_TRA(dst##r[n][1], a_, 1024); PG8_TRA(dst##r[n][2], a_, 8192); PG8_TRA(dst##r[n][3], a_, 9216); } } \
        else { _Pragma("unroll") for (int n = 0; n < 2; ++n) _Pragma("unroll") for (int k = 0; k < 2; ++k) dst[n][k] = *(const PG8_LAS bf16x8*)(lds + PG8_SB(b, h) + boff + n * 2048 + k * 1024); } } while (0)
#define PG8_FIXB(dst) do { if constexpr (BPAIR) { _Pragma("unroll") for (int n = 0; n < 2; ++n) { \
            asm volatile("" : "+v"(dst##r[n][0]), "+v"(dst##r[n][1]), "+v"(dst##r[n][2]), "+v"(dst##r[n][3])); \
            dst[n][0] = __builtin_bit_cast(bf16x8, (v4i_t){dst##r[n][0][0], dst##r[n][0][1], dst##r[n][1][0], dst##r[n][1][1]}); dst[n][1] = __builtin_bit_cast(bf16x8, (v4i_t){dst##r[n][2][0], dst##r[n][2][1], dst##r[n][3][0], dst##r[n][3][1]}); } } } while (0)
#define PG8_MMA(ai, bj, At, Bt) do { __builtin_amdgcn_s_setprio(1); _Pragma("unroll") for (int m = 0; m < 4; ++m) _Pragma("unroll") for (int n = 0; n < 2; ++n) { \
        if constexpr (FP8) { mfma_fp8(acc[ai][bj][m][n], cat8(Bt[n][0], Bt[n][1]), cat8(At[m][0], At[m][1]), fp8_scale1); } \
        else { _Pragma("unroll") for (int k = 0; k < 2; ++k) acc[ai][bj][m][n] = __builtin_amdgcn_mfma_f32_16x16x32_bf16(Bt[n][k], At[m][k], acc[ai][bj][m][n], 0, 0, 0); } } \
        __builtin_amdgcn_s_setprio(0); } while (0)
#define PG8_WAIT_V(n) asm volatile("s_waitcnt vmcnt(" #n ")" ::: "memory")
#define PG8_WAIT_L(n) asm volatile("s_waitcnt lgkmcnt(" #n ")" ::: "memory")
#define PG8_BAR __builtin_amdgcn_s_barrier()
#define PG8_SCHED __builtin_amdgcn_sched_barrier(0)
    Unit cur, nxt; int ui = 0;
    if (!S.next(0, cur)) return;
    f32x4 acc[2][2][4][2];
#pragma unroll
    for (int a = 0; a < 2; ++a)
#pragma unroll
        for (int b = 0; b < 2; ++b)
#pragma unroll
            for (int m = 0; m < 4; ++m)
#pragma unroll
                for (int n = 0; n < 2; ++n) acc[a][b][m][n] = (f32x4){0.f, 0.f, 0.f, 0.f};
    bf16x8 At[4][2], B0[2][2], B1[2][2];
    int sj = 0; bool spend = false; v4i_t st0 = {0, 0, 0, 0}, st1 = st0; PG8_LAS unsigned char* const lds0 = lds;
    v2i_t B0r[2][4], B1r[2][4]; const unsigned ldsb32 = (unsigned)(size_t)lds;
    const char* cA = (const char*)g.A + (size_t)cur.pm * tstep; const char* cB = (const char*)g.Bt + (BPAIR ? (size_t)cur.boff : (size_t)cur.pn * tstep);
    S.a_ready(cur);
    if constexpr (SP2) {
        PG8_STAGE(PG8_SB(0, 0), cB, voffB); PG8_STAGE(PG8_SB(0, 1), cB + hstepB, voffB); PG8_STAGE(PG8_SA(0, 0), cA, voffA); PG8_STAGE(PG8_SA(0, 1), cA + hstep, voffA);
        if (wr == 1) PG8_BAR;
        PG8_WAIT_V(2); PG8_BAR;
        PG8_STAGE(PG8_SB(1, 0), cB + kstepB, voffB); PG8_STAGE(PG8_SA(1, 0), cA + kstep, voffA); PG8_STAGE(PG8_SB(1, 1), cB + hstepB + kstepB, voffB);
        PG8_WAIT_V(6); PG8_BAR;
    } else {
        PG8_STAGE(PG8_SB(0, 0), cB, voffB); PG8_STAGE(PG8_SA(0, 0), cA, voffA); PG8_STAGE(PG8_SB(0, 1), cB + hstepB, voffB); PG8_STAGE(PG8_SA(0, 1), cA + hstep, voffA);
        if (wr == 1) PG8_BAR;
        PG8_WAIT_V(4); PG8_BAR;
        PG8_STAGE(PG8_SB(1, 0), cB + kstepB, voffB); PG8_STAGE(PG8_SA(1, 0), cA + kstep, voffA); PG8_STAGE(PG8_SB(1, 1), cB + hstepB + kstepB, voffB);
        PG8_WAIT_V(6); PG8_BAR;
    }
    for (;;) {
        const bool has_next = S.next(ui + 1, nxt);
        const char* nA = has_next ? (const char*)g.A + (size_t)nxt.pm * tstep : cA; const char* nB = has_next ? (const char*)g.Bt + (BPAIR ? (size_t)nxt.boff : (size_t)nxt.pn * tstep) : cB;
        for (int t = 0; t < nt; t += 2) {
            const bool last = (t == nt - 2);
            const char* a1 = cA + (size_t)(t + 1) * kstep;
            const char* a2 = last ? nA : cA + (size_t)(t + 2) * kstep; const char* b2 = last ? nB : cB + (size_t)(t + 2) * kstepB;
            const char* a3 = a2 + kstep; const char* b3 = b2 + kstepB;
            if (last && has_next) S.a_ready(nxt);
            if constexpr (SP2) {
            PG8_LDB(B0, 0, 0); PG8_LDB(B1, 0, 1); PG8_SCHED; PG8_LDA(At, 0, 0); PG8_STAGE(PG8_SA(1, 1), a1 + hstep, voffA);
            PG8_WAIT_V(8);
            if constexpr (Side::ON) { if (spend) SD.read(st0, st1, tid, (unsigned)(size_t)lds); }
            PG8_WAIT_L(0); PG8_FIXB(B0); PG8_FIXB(B1);
            if constexpr (Side::ON) { if (spend) { SD.finish(st0, st1, sj - 1, tid); spend = false; } if (sj < SD.njobs) { SD.issue(lds0, sj, tid, wid); ++sj; spend = true; } }
            PG8_BAR; PG8_MMA(0, 0, At, B0); PG8_MMA(0, 1, At, B1); PG8_BAR; PG8_SCHED;
            PG8_LDA(At, 0, 1); PG8_STAGE(PG8_SB(0, 0), b2, voffB); PG8_STAGE(PG8_SB(0, 1), b2 + hstepB, voffB); PG8_STAGE(PG8_SA(0, 0), a2, voffA);
            PG8_WAIT_V(8); PG8_WAIT_L(0); PG8_BAR; if (!(FP8 && cur.rows <= HALF)) { PG8_MMA(1, 0, At, B0); PG8_MMA(1, 1, At, B1); } PG8_BAR; PG8_SCHED;
            PG8_LDB(B0, 1, 0); PG8_LDB(B1, 1, 1); PG8_SCHED; PG8_LDA(At, 1, 0); PG8_STAGE(PG8_SA(0, 1), a2 + hstep, voffA);
            PG8_WAIT_V(8);
            if constexpr (Side::ON) { if (Side::TWO && spend) SD.read(st0, st1, tid, (unsigned)(size_t)lds); }
            PG8_WAIT_L(0); PG8_FIXB(B0); PG8_FIXB(B1);
            if constexpr (Side::ON) { if (Side::TWO) { if (spend) { SD.finish(st0, st1, sj - 1, tid); spend = false; } if (sj < SD.njobs) { SD.issue(lds0, sj, tid, wid); ++sj; spend = true; } } }
            PG8_BAR; PG8_MMA(0, 0, At, B0); PG8_MMA(0, 1, At, B1); PG8_BAR; PG8_SCHED;
            PG8_LDA(At, 1, 1); PG8_STAGE(PG8_SB(1, 0), b3, voffB); PG8_STAGE(PG8_SB(1, 1), b3 + hstepB, voffB); PG8_STAGE(PG8_SA(1, 0), a3, voffA);
            PG8_WAIT_V(8); PG8_WAIT_L(0); PG8_BAR; if (!(FP8 && cur.rows <= HALF)) { PG8_MMA(1, 0, At, B0); PG8_MMA(1, 1, At, B1); } PG8_BAR; PG8_SCHED;
            } else {
            PG8_LDB(B0, 0, 0); PG8_SCHED; PG8_LDA(At, 0, 0); PG8_STAGE(PG8_SA(1, 1), a1 + hstep, voffA);
            PG8_WAIT_L(8); PG8_BAR; PG8_WAIT_L(0); PG8_MMA(0, 0, At, B0); PG8_BAR; PG8_SCHED;
            PG8_LDB(B1, 0, 1); PG8_STAGE(PG8_SB(0, 0), b2, voffB);
            PG8_BAR; PG8_WAIT_L(0); PG8_MMA(0, 1, At, B1); PG8_BAR;
            PG8_LDA(At, 0, 1); PG8_STAGE(PG8_SA(0, 0), a2, voffA);
            PG8_BAR; PG8_WAIT_L(0); PG8_MMA(1, 0, At, B0); PG8_BAR; PG8_SCHED;
            PG8_STAGE(PG8_SB(0, 1), b2 + hstepB, voffB);
            PG8_WAIT_V(6); PG8_BAR; PG8_MMA(1, 1, At, B1); PG8_BAR;
            PG8_LDB(B0, 1, 0); PG8_SCHED; PG8_LDA(At, 1, 0); PG8_STAGE(PG8_SA(0, 1), a2 + hstep, voffA);
            PG8_WAIT_L(8); PG8_BAR; PG8_WAIT_L(0); PG8_MMA(0, 0, At, B0); PG8_BAR; PG8_SCHED;
            PG8_LDB(B1, 1, 1); PG8_STAGE(PG8_SB(1, 0), b3, voffB);
            PG8_BAR; PG8_WAIT_L(0); PG8_MMA(0, 1, At, B1); PG8_BAR;
            PG8_LDA(At, 1, 1); PG8_STAGE(PG8_SA(1, 0), a3, voffA);
            PG8_BAR; PG8_WAIT_L(0); PG8_MMA(1, 0, At, B0); PG8_BAR; PG8_SCHED;
            PG8_STAGE(PG8_SB(1, 1), b3 + hstepB, voffB);
            PG8_WAIT_V(6); PG8_BAR; PG8_MMA(1, 1, At, B1); PG8_BAR;
            }
        }
        if constexpr (ALIGN_EPI) { if (wr == 0) PG8_BAR; }
        if constexpr (FP8) asm volatile("s_nop 15\n\ts_nop 15" ::: "memory");
        if constexpr (!Epi::AFTER_DRAIN) { int tz = threadIdx.x; asm volatile("" : "+v"(tz));
            const int wz = __builtin_amdgcn_readfirstlane(tz >> 6), lz = tz & 63; E(acc, cur, wz >> 2, wz & 3, lz & 15, lz >> 4); S.done(cur); }
        if (!has_next) break;
#pragma unroll
        for (int a = 0; a < 2; ++a)
#pragma unroll
            for (int b = 0; b < 2; ++b)
#pragma unroll
                for (int m = 0; m < 4; ++m)
#pragma unroll
                    for (int n = 0; n < 2; ++n) acc[a][b][m][n] = (f32x4){0.f, 0.f, 0.f, 0.f};
        cur = nxt; cA = nA; cB = nB; ++ui;
        if constexpr (ALIGN_EPI) { if (wr == 1) PG8_BAR; }
    }
    PG8_WAIT_V(0);
    if constexpr (!ALIGN_EPI) { if (wr == 0) PG8_BAR; }
    PG8_BAR;
    if constexpr (Side::ON) { if (spend) { SD.read(st0, st1, tid, (unsigned)(size_t)lds); PG8_WAIT_L(0); SD.finish(st0, st1, sj - 1, tid); spend = false; } }
    if constexpr (Epi::AFTER_DRAIN) { E.fused(acc, cur, wr, wc, fr, fq, lds, wid, lane); S.done(cur); }
#undef PG8_SA
#undef PG8_SB
#undef PG8_STAGE
#undef PG8_LDA
#undef PG8_LDB
#undef PG8_TRA
#undef PG8_FIXB
#undef PG8_MMA
#undef PG8_WAIT_V
#undef PG8_WAIT_L
#undef PG8_BAR
#undef PG8_SCHED
}
}
#define GAS __attribute__((address_space(1)))
#define LAS __attribute__((address_space(3)))
typedef unsigned short bf16;
typedef unsigned v4u __attribute__((ext_vector_type(4)));
typedef float f32x4 __attribute__((ext_vector_type(4)));
typedef short bf16x8 __attribute__((ext_vector_type(8)));
typedef GAS unsigned gu32;
typedef GAS unsigned long long gu64;
#define RLX_AGENT __ATOMIC_RELAXED, __HIP_MEMORY_SCOPE_AGENT
#define LDS_WAIT() asm volatile("s_waitcnt lgkmcnt(0)" ::: "memory")
#define VM_WAIT() asm volatile("s_waitcnt vmcnt(0)" ::: "memory")
__device__ __forceinline__ unsigned long long rt() { return __builtin_amdgcn_s_memrealtime(); }
__device__ __forceinline__ unsigned f2bf(float f) { unsigned u = __builtin_bit_cast(unsigned, f); return (u + 0x7fffu + ((u >> 16) & 1u)) >> 16; }
__device__ __forceinline__ unsigned pk2(float lo, float hi) { return f2bf(lo) | (f2bf(hi) << 16); }

#define XB_TMO      128
#define XB_XCNT(j)  (256  + 64 * (j))
#define XB_XSUB(j)  (1280 + 64 * (j))
#define XB_XGEN(j)  (2304 + 64 * (j))
#define XB_TOP      3328
#define XB_TOPGEN   3392
#define XCD_BAR_WORDS 3456
#define XB_SPIN_CAP (1u << 18)

__device__ __forceinline__ unsigned xb_ld(unsigned* p)              { return __hip_atomic_load(p, __ATOMIC_RELAXED, __HIP_MEMORY_SCOPE_AGENT); }
__device__ __forceinline__ unsigned xb_add(unsigned* p, unsigned v) { return __hip_atomic_fetch_add(p, v, __ATOMIC_RELAXED, __HIP_MEMORY_SCOPE_AGENT); }
__device__ __forceinline__ unsigned xb_xcc_id() { return (unsigned)__builtin_amdgcn_s_getreg((3 << 11) | 20) & 0xFu; }
#define XB_SPIN(cond, bar) do { unsigned _sp = 0; while (cond) { __builtin_amdgcn_s_sleep(1); \
    if ((++_sp & 255u) == 0u) { if (xb_ld(&(bar)[XB_TMO])) break; if (_sp > XB_SPIN_CAP) { atomicAdd(&(bar)[XB_TMO], 1u); break; } } } } while (0)

struct XcdBarrier {
    unsigned* bar; unsigned x;
    volatile LAS unsigned* st;
};

__device__ __forceinline__ XcdBarrier xcd_barrier_post(unsigned* bar, volatile LAS unsigned* st) {
    XcdBarrier b; b.bar = bar; b.x = xb_xcc_id(); b.st = st;
    if (threadIdx.x == 0) (void)xb_add(&bar[XB_XCNT(b.x)], 1u);
    return b;
}
__device__ __forceinline__ void xcd_barrier_complete(unsigned* bar, unsigned x, unsigned& nloc, unsigned& nx) {
    const unsigned G = gridDim.x * gridDim.y * gridDim.z;
    unsigned sum, cnt, mine, sp = 0u;
    for (;;) {
        sum = 0u; cnt = 0u; mine = 0u;
#pragma unroll
        for (unsigned j = 0; j < 16; ++j) { const unsigned c = xb_ld(&bar[XB_XCNT(j)]); sum += c; cnt += (c > 0u) ? 1u : 0u; mine = (j == x) ? c : mine; }
        if (sum == G) break;
        __builtin_amdgcn_s_sleep(1);
        if ((++sp & 255u) == 0u) { if (xb_ld(&bar[XB_TMO])) break; if (sp > XB_SPIN_CAP) { atomicAdd(&bar[XB_TMO], 1u); break; } }
    }
    nloc = mine > 0u ? mine : 1u; nx = cnt > 0u ? cnt : 1u;
}

__device__ __forceinline__ void xcd_barrier(const XcdBarrier& b) {
    asm volatile("s_waitcnt vmcnt(0)" ::: "memory");
    __syncthreads();
    if (threadIdx.x == 0) {
        unsigned* bar = b.bar;
        __builtin_amdgcn_s_waitcnt(0);
        unsigned nloc = b.st[0], nx = b.st[1];
        if (nloc == 0u) { xcd_barrier_complete(bar, b.x, nloc, nx); b.st[0] = nloc; b.st[1] = nx; }
        const unsigned old = xb_add(&bar[XB_XSUB(b.x)], 1u);
        const unsigned gen = old / nloc;
        if (old + 1u == (gen + 1u) * nloc) {
            __builtin_amdgcn_fence(__ATOMIC_RELEASE, "agent");
            asm volatile("s_waitcnt vmcnt(0)" ::: "memory");
            const unsigned og = xb_add(&bar[XB_TOP], 1u);
            const unsigned tg = og / nx;
            if (og + 1u == (tg + 1u) * nx) xb_add(&bar[XB_TOPGEN], 1u);
            else XB_SPIN(xb_ld(&bar[XB_TOPGEN]) == tg, bar);
            __builtin_amdgcn_fence(__ATOMIC_ACQUIRE, "agent");
            xb_add(&bar[XB_XGEN(b.x)], 1u);
            asm volatile("s_waitcnt vmcnt(0)" ::: "memory");
        } else {
            XB_SPIN(xb_ld(&bar[XB_XGEN(b.x)]) == gen, bar);
            __builtin_amdgcn_fence(__ATOMIC_ACQUIRE, "agent");
            asm volatile("s_waitcnt vmcnt(0)" ::: "memory");
        }
    }
    __syncthreads();
}

constexpr int NB = 4, SEQ = 2048, DM = 2048, NTOK = NB * SEQ, INC = 6144, CW = 512, AW = 1536, NH = 24, HD = 64, NE = 32, TOPK = 4, DE = 2048;
constexpr int QOFF = 1536, KOFF = 3072, VOFF = 4608;
constexpr int MAXSLOT = NE * NTOK;
constexpr float EPS = 1e-5f;
typedef unsigned u32x2v __attribute__((ext_vector_type(2)));
constexpr int NWAVES = 8;
#ifndef MK_N_LAUNCHES
#define MK_N_LAUNCHES 1
#endif
#ifndef PROBE_MASK
#define PROBE_MASK 0
#endif
#define REPS(k) (((PROBE_MASK >> (k)) & 1) ? 2 : 1)
constexpr int NPH = 10;

constexpr size_t MiB = 1u << 20;
constexpr size_t WS_CTL = 0, CTL_ZERO_BYTES = 1 * MiB;
constexpr size_t WS_ROPE = 1 * MiB;
constexpr size_t WS_TOKE = 2 * MiB, WS_TOKR = WS_TOKE + 128 * 1024, WS_TOKG = WS_TOKR + 128 * 1024;
constexpr size_t WS_LIST = 3 * MiB;
constexpr size_t WS_WIN = 8 * MiB;
constexpr size_t WS_WO = 32 * MiB;
constexpr size_t WS_XN = 40 * MiB;
constexpr size_t WS_PROJ = 72 * MiB;
constexpr size_t WS_YATT = 168 * MiB;
constexpr size_t WS_MIXED = 192 * MiB;
constexpr size_t WS_X1 = 224 * MiB;
constexpr size_t WS_XN2 = 288 * MiB;
constexpr size_t WS_XS = 320 * MiB;
constexpr size_t WS_ACT = 832 * MiB;
constexpr size_t WS_Y = 1344 * MiB;
constexpr size_t WS_WGU = 2368 * MiB;
constexpr size_t WS_WDN = 2624 * MiB;
constexpr size_t WS_END = 2752 * MiB;
constexpr int CW_TMO = 0, CW_CODE = 1;
constexpr int CW_BAR = 4096;
constexpr int CW_CNT = 8192;
constexpr int CW_ATTQ = 12288;
constexpr int CW_CONVQ = 12288 + 4096;
constexpr int CW_P1DONE = 12288 + 8192;
#ifndef ATT_ITEM
#define ATT_ITEM item2
#endif
#ifndef ATT_NOFALL
#define ATT_NOFALL 1
#endif
#ifndef ATT_JOIN
#define ATT_JOIN 0
#endif
#ifndef SIDE_CONV
#define SIDE_CONV 2
#endif
#ifndef SPLIT_P1
#define SPLIT_P1 0
#endif
#ifndef FUSED2
#define FUSED2 0
#endif
#ifndef FUSED_CONV
#define FUSED_CONV 0
#endif
#ifndef ATT_WAVES
#define ATT_WAVES 5
#endif
constexpr int RING_BYTES = 131072;
constexpr int LDSCTL_OFF = RING_BYTES;
constexpr int MISC_OFF = LDSCTL_OFF + 320;
constexpr int TAB_TS = LDSCTL_OFF + 1024;
constexpr int TAB_CN = LDSCTL_OFF + 1024 + 256;
constexpr int PART_OFF = RING_BYTES + 16384;
constexpr int LDS_BYTES = 163840;

__device__ __forceinline__ float wave_sum(float v) {
#pragma unroll
    for (int o = 1; o < 64; o <<= 1) v += __shfl_xor(v, o);
    return v;
}
__device__ __forceinline__ float bf_lo(unsigned w) { return __uint_as_float(w << 16); }
__device__ __forceinline__ float bf_hi(unsigned w) { return __uint_as_float(w & 0xffff0000u); }

__device__ __forceinline__ void p0_transpose_item(const float* W, int N, int K, bf16* WT, int k0, int n0, int out_row0, LAS float* scr, int lane) {
#pragma unroll 8
    for (int i = 0; i < 32; ++i) { const int kk = 2 * i + (lane >> 5); scr[kk * 33 + (lane & 31)] = __builtin_nontemporal_load(W + (size_t)(k0 + kk) * N + n0 + (lane & 31)); }
    LDS_WAIT(); asm volatile("" ::: "memory");
    const int c = lane & 7;
#pragma unroll
    for (int j = 0; j < 4; ++j) { const int n = (lane >> 3) + 8 * j; const LAS float* s = scr + (8 * c) * 33 + n;
        v4u o; o.x = pk2(s[0 * 33], s[1 * 33]); o.y = pk2(s[2 * 33], s[3 * 33]); o.z = pk2(s[4 * 33], s[5 * 33]); o.w = pk2(s[6 * 33], s[7 * 33]);
        *(GAS v4u*)(WT + (size_t)(out_row0 + n) * K + k0 + 8 * c) = o; }
    LDS_WAIT(); asm volatile("" ::: "memory");
}

__device__ __forceinline__ void p0_transpose_item_fp8(const float* W, int N, int K, unsigned char* WT, int k0, int n0, int out_row0, float scale, LAS float* scr, int lane) {
#pragma unroll 8
    for (int i = 0; i < 32; ++i) { const int kk = 2 * i + (lane >> 5); scr[kk * 33 + (lane & 31)] = W[(size_t)(k0 + kk) * N + n0 + (lane & 31)]; }
    LDS_WAIT(); asm volatile("" ::: "memory");
    const int c = lane & 3;
#pragma unroll
    for (int j = 0; j < 2; ++j) { const int n = (lane >> 2) + 16 * j; const LAS float* s = scr + (16 * c) * 33 + n;
        v4u o;
        o.x = pg8::pk4_fp8(scale * s[0 * 33], scale * s[1 * 33], scale * s[2 * 33], scale * s[3 * 33]);
        o.y = pg8::pk4_fp8(scale * s[4 * 33], scale * s[5 * 33], scale * s[6 * 33], scale * s[7 * 33]);
        o.z = pg8::pk4_fp8(scale * s[8 * 33], scale * s[9 * 33], scale * s[10 * 33], scale * s[11 * 33]);
        o.w = pg8::pk4_fp8(scale * s[12 * 33], scale * s[13 * 33], scale * s[14 * 33], scale * s[15 * 33]);
        *(GAS v4u*)(WT + (size_t)(out_row0 + n) * K + k0 + 16 * c) = o; }
    LDS_WAIT(); asm volatile("" ::: "memory");
}

__device__ __forceinline__ unsigned pk4_fp8_nc(float a, float b, float c, float d) { int w = 0; w = __builtin_amdgcn_cvt_pk_fp8_f32(a, b, w, false); w = __builtin_amdgcn_cvt_pk_fp8_f32(c, d, w, true); return (unsigned)w; }
struct ConvDesc { const float* src; unsigned char* dstb; int N, isdn; };
constexpr int CV_NG = 16, PER_E = 256 + 128, NCONV = 32 * PER_E;
__device__ __forceinline__ ConvDesc conv_decode(int it, const float* w_gu, const float* w_dn, unsigned char* WGU, unsigned char* WDN, int lane) {
    const int e = it / PER_E, r = it - e * PER_E; ConvDesc d;
    if (r < 256) { const int kp0 = 4 * r; d.N = 4096; d.isdn = 0; d.src = w_gu + (size_t)e * 2048 * 4096 + (size_t)(2 * kp0) * 4096 + 4 * lane; d.dstb = WGU + (size_t)e * 1024 * 8192 + (size_t)kp0 * 8192 + 8 * lane; }
    else { const int kp0 = 8 * (r - 256); d.N = 2048; d.isdn = 1; d.src = w_dn + (size_t)e * 2048 * 2048 + (size_t)(2 * kp0) * 2048 + 4 * lane; d.dstb = WDN + (size_t)e * 1024 * 4096 + (size_t)kp0 * 4096 + 8 * lane; }
    return d;
}
#define CV_LOAD(R, D, g) do { const int ro_ = (D).isdn ? 4 * ((g) >> 3) : 0, co_ = (D).isdn ? 256 * ((g) & 7) : 256 * (g); \
        _Pragma("unroll") for (int t_ = 0; t_ < 4; ++t_) _Pragma("unroll") for (int i_ = 0; i_ < 2; ++i_) R[2 * t_ + i_] = __builtin_nontemporal_load((const GAS f32x4*)((D).src + (size_t)(2 * (ro_ + t_) + i_) * (D).N + co_)); } while (0)
#define CV_PROC(R, D, g) do { const int ro_ = (D).isdn ? 4 * ((g) >> 3) : 0, co_ = (D).isdn ? 256 * ((g) & 7) : 256 * (g); \
        _Pragma("unroll") for (int t_ = 0; t_ < 4; ++t_) { u32x2v o_; \
            o_.x = pk4_fp8_nc(pg8::FP8_W_SCALE * R[2 * t_][0], pg8::FP8_W_SCALE * R[2 * t_ + 1][0], pg8::FP8_W_SCALE * R[2 * t_][1], pg8::FP8_W_SCALE * R[2 * t_ + 1][1]); \
            o_.y = pk4_fp8_nc(pg8::FP8_W_SCALE * R[2 * t_][2], pg8::FP8_W_SCALE * R[2 * t_ + 1][2], pg8::FP8_W_SCALE * R[2 * t_][3], pg8::FP8_W_SCALE * R[2 * t_ + 1][3]); \
            __builtin_nontemporal_store(o_, (GAS u32x2v*)((D).dstb + (size_t)(ro_ + t_) * (D).N * 2 + 2 * co_)); } } while (0)

namespace att {
typedef short s16x8 __attribute__((ext_vector_type(8)));
typedef short s16x4 __attribute__((ext_vector_type(4)));
typedef float f32x16 __attribute__((ext_vector_type(16)));
typedef unsigned u32x4 __attribute__((ext_vector_type(4)));
constexpr int VP = 144;
constexpr int WAVE_LDS = 32 * VP;
constexpr float C2 = 0.125f * 1.4426950408889634f;
constexpr int NITEMS = 16 * NB * NH * 4;
typedef short v4i16_t __attribute__((ext_vector_type(4)));
__device__ __forceinline__ s16x4 vtr(LAS const char* p) { return __builtin_bit_cast(s16x4, __builtin_amdgcn_ds_read_tr16_b64_v4i16((LAS v4i16_t*)p)); }

struct TileD { int abase, kp_off, kp_mul, W, mod4, sel; };
__device__ __forceinline__ TileD tile_desc(int u, int n1, int n2, int first1, int first2, int m0, int r4) {
    TileD d;
    if (u < n1) { d.abase = 4 * m0 - 128 + 32 * (first1 + u); d.kp_off = 0; d.kp_mul = 1; d.W = 128; d.mod4 = 0; d.sel = 0; }
    else if (u < n1 + n2) { d.abase = m0 - 128 + 32 * (first2 + u - n1); d.kp_off = r4; d.kp_mul = 4; d.W = 128; d.mod4 = 0; d.sel = 1; }
    else { d.abase = 32 * (u - n1 - n2); d.kp_off = r4; d.kp_mul = 4; d.W = 0x7fffffff; d.mod4 = 1; d.sel = 1; }
    return d;
}
#define ATT_LOADT(KF, VF, D) do { _Pragma("unroll") for (int j_ = 0; j_ < 4; ++j_) { const int pos_ = (D).kp_off + (D).kp_mul * ((D).abase + 8 * j_ + (lane >> 3)); \
        KF[j_] = *(const GAS u32x4*)(Kb + (size_t)pos_ * INC + 8 * (lane & 7)); VF[j_] = *(const GAS u32x4*)(Vb + (size_t)pos_ * INC + 8 * (lane & 7)); } } while (0)

template <int PMODE = 0>
__device__ __forceinline__ void item(int it, const bf16* PROJ, bf16* YATT, LAS char* vl, int lane) {
    const int bh = it >> 6, jj = it & 63; const int b = bh / NH, head = bh - b * NH, mb = 15 - (jj >> 2), r4 = jj & 3;
    const int m0 = mb * 32, q = lane & 31, h = lane >> 5;
    const int qpos = r4 + 4 * (m0 + q);
    const bf16* base = PROJ + (size_t)b * SEQ * INC;
    const bf16* Kb = base + KOFF + head * HD; const bf16* Vb = base + VOFF + head * HD;
    const int first1 = (mb == 0) ? 4 : 0, first2 = (mb < 4) ? 4 - mb : 0, n1 = 8 - first1, n2 = 5 - first2, ntile = n1 + n2 + mb + 1;
    u32x4 kA[4], vA[4], kB[4], vB[4];
    { const TileD d0 = tile_desc(0, n1, n2, first1, first2, m0, r4); ATT_LOADT(kA, vA, d0); }
    s16x8 qf[4];
    { const bf16* qp = base + (size_t)qpos * INC + QOFF + head * HD + 8 * h;
#pragma unroll
      for (int d0 = 0; d0 < 4; ++d0) qf[d0] = __builtin_bit_cast(s16x8, *(const GAS u32x4*)(qp + 16 * d0)); }
    f32x16 o0 = {}, o1 = {}; float mrun = -1e30f, lrun = 0.f;
    const int g = lane >> 4, qq = (lane & 15) >> 2, pp = lane & 3;
    LAS const char* vb = vl + (4 * h + qq) * VP + (16 * (g & 1) + 4 * pp) * 2;
    LAS char* kl = vl + WAVE_LDS;
    LAS u32x4* vd = (LAS u32x4*)(vl + (lane >> 3) * VP + (lane & 7) * 16);
    LAS u32x4* kd = (LAS u32x4*)(kl + (lane >> 3) * VP + (lane & 7) * 16);
    LAS const char* kfp = kl + (lane & 31) * VP + h * 16;
#pragma unroll 1
    for (int u = 0; u < ntile; ++u) {
        const TileD d = tile_desc(u, n1, n2, first1, first2, m0, r4);
        if (PMODE != 1) { const int un = (u + 1 < ntile) ? u + 1 : u; const TileD dn = tile_desc(un, n1, n2, first1, first2, m0, r4); ATT_LOADT(kB, vB, dn); }
#pragma unroll
        for (int j = 0; j < 4; ++j) { *(LAS u32x4*)((LAS char*)kd + 8 * j * VP) = kA[j]; *(LAS u32x4*)((LAS char*)vd + 8 * j * VP) = vA[j]; }
        if (PMODE != 2) {
        f32x16 s = {};
#pragma unroll
        for (int d0 = 0; d0 < 4; ++d0) s = __builtin_amdgcn_mfma_f32_32x32x16_bf16(*(const LAS s16x8*)(kfp + 32 * d0), qf[d0], s, 0, 0, 0);
        const int bq = d.sel ? (m0 + q) : qpos;
        const int t0 = bq - d.abase - 4 * h; const unsigned W = (unsigned)d.W; const int m4 = d.mod4 ? 3 : 0;
        float mx = -INFINITY;
#pragma unroll
        for (int r = 0; r < 16; ++r) { const int dd = t0 - ((r & 3) + 8 * (r >> 2));
            const bool ok = ((unsigned)dd <= W) && ((dd & m4) == 0);
            s[r] = ok ? s[r] : -INFINITY; mx = fmaxf(mx, s[r]); }
        mx = fmaxf(mx, __shfl_xor(mx, 32));
        const float mnew = fmaxf(mrun, mx), alpha = __builtin_amdgcn_exp2f(mrun - mnew); mrun = mnew;
        float ps = 0.f;
#pragma unroll
        for (int r = 0; r < 16; ++r) { s[r] = __builtin_amdgcn_exp2f(s[r] - mnew); ps += s[r]; }
        lrun = lrun * alpha + ps;
#pragma unroll
        for (int r = 0; r < 16; ++r) { o0[r] *= alpha; o1[r] *= alpha; }
        u32x4 p0, p1;
        p0.x = pk2(s[0], s[1]); p0.y = pk2(s[2], s[3]); p0.z = pk2(s[4], s[5]); p0.w = pk2(s[6], s[7]);
        p1.x = pk2(s[8], s[9]); p1.y = pk2(s[10], s[11]); p1.z = pk2(s[12], s[13]); p1.w = pk2(s[14], s[15]);
        const s16x8 pf0 = __builtin_bit_cast(s16x8, p0), pf1 = __builtin_bit_cast(s16x8, p1);
#pragma unroll
        for (int sstep = 0; sstep < 2; ++sstep) {
#pragma unroll
            for (int dh = 0; dh < 2; ++dh) {
                const s16x4 lo = vtr(vb + (16 * sstep) * VP + dh * 64), hi = vtr(vb + (16 * sstep + 8) * VP + dh * 64);
                const s16x8 vf = (s16x8){lo[0], lo[1], lo[2], lo[3], hi[0], hi[1], hi[2], hi[3]};
                if (dh == 0) o0 = __builtin_amdgcn_mfma_f32_32x32x16_bf16(vf, sstep ? pf1 : pf0, o0, 0, 0, 0);
                else         o1 = __builtin_amdgcn_mfma_f32_32x32x16_bf16(vf, sstep ? pf1 : pf0, o1, 0, 0, 0);
            }
        }
        }
        if (PMODE == 1) continue;
#pragma unroll
        for (int c = 0; c < 4; ++c) { kA[c] = kB[c]; vA[c] = vB[c]; }
    }
    const float inv = 1.0f / (lrun + __shfl_xor(lrun, 32));
    bf16* orow = YATT + (size_t)(b * SEQ + qpos) * AW + head * HD + 4 * h;
#pragma unroll
    for (int gq = 0; gq < 4; ++gq) {
        u32x2v a, c; a.x = pk2(o0[4 * gq] * inv, o0[4 * gq + 1] * inv); a.y = pk2(o0[4 * gq + 2] * inv, o0[4 * gq + 3] * inv);
        c.x = pk2(o1[4 * gq] * inv, o1[4 * gq + 1] * inv); c.y = pk2(o1[4 * gq + 2] * inv, o1[4 * gq + 3] * inv);
        *(u32x2v*)(orow + 8 * gq) = a; *(u32x2v*)(orow + 32 + 8 * gq) = c; }
}

__device__ __forceinline__ int krp(int key) { return (key & 0x16) | ((key >> 3) & 1) | ((key & 1) << 3); }
__device__ __forceinline__ void item2(int it, const bf16* PROJ, bf16* YATT, LAS char* wl, int lane) {
    const int bh = it >> 6, jj = it & 63; const int b = bh / NH, head = bh - b * NH, mb = 15 - (jj >> 2), r4 = jj & 3;
    const int m0 = mb * 32, q = lane & 31, h = lane >> 5;
    const int qpos = r4 + 4 * (m0 + q), bq2 = m0 + q;
    const bf16* base = PROJ + (size_t)b * SEQ * INC;
    const bf16* Kb = base + KOFF + head * HD; const bf16* Vb = base + VOFF + head * HD;
    const int first1 = (mb == 0) ? 4 : 0, first2 = (mb < 4) ? 4 - mb : 0, n1 = 8 - first1, n2 = 5 - first2, ntile = n1 + n2 + mb + 1, npair = (ntile + 1) >> 1;
    u32x4 k0[4], v0[4], k1[4], v1[4];
    { const TileD d0 = tile_desc(0, n1, n2, first1, first2, m0, r4); ATT_LOADT(k0, v0, d0); }
    { const TileD d1 = tile_desc(ntile > 1 ? 1 : 0, n1, n2, first1, first2, m0, r4); ATT_LOADT(k1, v1, d1); }
    s16x8 qf[4];
    { const bf16* qp = base + (size_t)qpos * INC + QOFF + head * HD + 8 * h;
#pragma unroll
      for (int d0 = 0; d0 < 4; ++d0) qf[d0] = __builtin_bit_cast(s16x8, *(const GAS u32x4*)(qp + 16 * d0)); }
    f32x16 o0 = {}, o1 = {}; float mrun = -1e30f, lrun = 0.f;
    const int g = lane >> 4, qq = (lane & 15) >> 2, pp = lane & 3;
    int kws[4];
#pragma unroll
    for (int j = 0; j < 4; ++j) { const int key = 8 * j + (lane >> 3); kws[j] = krp(key) * 128 + (((lane & 7) ^ (key & 7)) << 4); }
    const int vws = (lane >> 3) * 128 + (lane & 7) * 16;
    const int kfr = krp(q) * 128, kx = q & 7;
    const int vfr = (4 * h + qq) * 128 + (16 * (g & 1) + 4 * pp) * 2;
#define ATT2_MASK(S, D, T0) do { if ((D).mod4) { _Pragma("unroll") for (int r = 0; r < 16; ++r) { const int dd = (T0) - ((r & 3) + 8 * (r >> 2)); S[r] = (dd >= 0 && (dd & 3) == 0) ? S[r] : -INFINITY; mx = fmaxf(mx, S[r]); } } \
        else { const unsigned W_ = (unsigned)(D).W; _Pragma("unroll") for (int r = 0; r < 16; ++r) { const int dd = (T0) - ((r & 3) + 8 * (r >> 2)); S[r] = ((unsigned)dd <= W_) ? S[r] : -INFINITY; mx = fmaxf(mx, S[r]); } } } while (0)
#pragma unroll 1
    for (int p = 0; p < npair; ++p) {
        const bool nul1 = (2 * p + 1 >= ntile);
        const TileD dA = tile_desc(2 * p, n1, n2, first1, first2, m0, r4), dB = tile_desc(nul1 ? 2 * p : 2 * p + 1, n1, n2, first1, first2, m0, r4);
#pragma unroll
        for (int j = 0; j < 4; ++j) { *(LAS u32x4*)(wl + kws[j]) = k0[j]; *(LAS u32x4*)(wl + 4096 + vws + 1024 * j) = v0[j]; *(LAS u32x4*)(wl + 8192 + kws[j]) = k1[j]; *(LAS u32x4*)(wl + 12288 + vws + 1024 * j) = v1[j]; }
        { const int ua = (2 * p + 2 < ntile) ? 2 * p + 2 : ntile - 1, ub = (2 * p + 3 < ntile) ? 2 * p + 3 : ntile - 1;
          const TileD na = tile_desc(ua, n1, n2, first1, first2, m0, r4), nb = tile_desc(ub, n1, n2, first1, first2, m0, r4); ATT_LOADT(k0, v0, na); ATT_LOADT(k1, v1, nb); }
        f32x16 sA = {}, sB = {};
#pragma unroll
        for (int d0 = 0; d0 < 4; ++d0) { const int co = ((2 * d0 + h) ^ kx) << 4;
            sA = __builtin_amdgcn_mfma_f32_32x32x16_bf16(*(const LAS s16x8*)(wl + kfr + co), qf[d0], sA, 0, 0, 0);
            sB = __builtin_amdgcn_mfma_f32_32x32x16_bf16(*(const LAS s16x8*)(wl + 8192 + kfr + co), qf[d0], sB, 0, 0, 0); }
        const int t0A = (dA.sel ? bq2 : qpos) - dA.abase - 4 * h; const int t0B = nul1 ? -(1 << 20) : ((dB.sel ? bq2 : qpos) - dB.abase - 4 * h);
        float mx = -INFINITY;
        ATT2_MASK(sA, dA, t0A); ATT2_MASK(sB, dB, t0B);
        mx = fmaxf(mx, __shfl_xor(mx, 32));
        const float mnew = fmaxf(mrun, mx), alpha = __builtin_amdgcn_exp2f(mrun - mnew); mrun = mnew;
        float ps = 0.f;
#pragma unroll
        for (int r = 0; r < 16; ++r) { sA[r] = __builtin_amdgcn_exp2f(sA[r] - mnew); sB[r] = __builtin_amdgcn_exp2f(sB[r] - mnew); ps += sA[r] + sB[r]; }
        lrun = lrun * alpha + ps;
#pragma unroll
        for (int r = 0; r < 16; ++r) { o0[r] *= alpha; o1[r] *= alpha; }
        u32x4 pa0, pa1, pb0, pb1;
        pa0.x = pk2(sA[0], sA[1]); pa0.y = pk2(sA[2], sA[3]); pa0.z = pk2(sA[4], sA[5]); pa0.w = pk2(sA[6], sA[7]);
        pa1.x = pk2(sA[8], sA[9]); pa1.y = pk2(sA[10], sA[11]); pa1.z = pk2(sA[12], sA[13]); pa1.w = pk2(sA[14], sA[15]);
        pb0.x = pk2(sB[0], sB[1]); pb0.y = pk2(sB[2], sB[3]); pb0.z = pk2(sB[4], sB[5]); pb0.w = pk2(sB[6], sB[7]);
        pb1.x = pk2(sB[8], sB[9]); pb1.y = pk2(sB[10], sB[11]); pb1.z = pk2(sB[12], sB[13]); pb1.w = pk2(sB[14], sB[15]);
#pragma unroll
        for (int tt = 0; tt < 2; ++tt) { LAS const char* vb = wl + 4096 + 8192 * tt + vfr;
#pragma unroll
            for (int sstep = 0; sstep < 2; ++sstep) { const s16x8 pf = __builtin_bit_cast(s16x8, tt ? (sstep ? pb1 : pb0) : (sstep ? pa1 : pa0));
#pragma unroll
                for (int dh = 0; dh < 2; ++dh) {
                    const s16x4 lo = vtr(vb + (16 * sstep) * 128 + dh * 64), hi = vtr(vb + (16 * sstep + 8) * 128 + dh * 64);
                    const s16x8 vf = (s16x8){lo[0], lo[1], lo[2], lo[3], hi[0], hi[1], hi[2], hi[3]};
                    if (dh == 0) o0 = __builtin_amdgcn_mfma_f32_32x32x16_bf16(vf, pf, o0, 0, 0, 0);
                    else         o1 = __builtin_amdgcn_mfma_f32_32x32x16_bf16(vf, pf, o1, 0, 0, 0); } } }
    }
#undef ATT2_MASK
    const float inv = 1.0f / (lrun + __shfl_xor(lrun, 32));
    bf16* orow = YATT + (size_t)(b * SEQ + qpos) * AW + head * HD + 4 * h;
#pragma unroll
    for (int gq = 0; gq < 4; ++gq) {
        u32x2v a, c; a.x = pk2(o0[4 * gq] * inv, o0[4 * gq + 1] * inv); a.y = pk2(o0[4 * gq + 2] * inv, o0[4 * gq + 3] * inv);
        c.x = pk2(o1[4 * gq] * inv, o1[4 * gq + 1] * inv); c.y = pk2(o1[4 * gq + 2] * inv, o1[4 * gq + 3] * inv);
        *(u32x2v*)(orow + 8 * gq) = a; *(u32x2v*)(orow + 32 + 8 * gq) = c; }
}
}

struct Args { const float* in[15]; float* out; unsigned char* ws; int ph_lo, ph_hi; };
static_assert(sizeof(Args) == 15 * 8 + 8 + 8 + 8, "Args has no padding");

__global__ void __launch_bounds__(NWAVES * 64, 2) fwd(Args args) {
    extern __shared__ __attribute__((aligned(16))) unsigned char lds[];
    LAS unsigned char* L = (LAS unsigned char*)lds;
    volatile LAS unsigned* MISC = (volatile LAS unsigned*)(L + MISC_OFF);
    const int tid = threadIdx.x, lane = tid & 63, wave = __builtin_amdgcn_readfirstlane(tid >> 6);
    const int G = gridDim.x; const int bx = blockIdx.x; const int vcu = (G % 8 == 0) ? (bx % 8) * (G / 8) + bx / 8 : bx;
    unsigned char* ws = args.ws;
    gu32* ctl = (gu32*)(ws + WS_CTL);
    const float* x = args.in[0]; const float* mix_g = args.in[1]; const float* w_in = args.in[2]; const float* conv_w = args.in[3]; const float* conv_g = args.in[4];
    const float* attn_g = args.in[5]; const float* w_out = args.in[6]; const float* ffn_g = args.in[7]; const float* w_router = args.in[8]; const float* b_router = args.in[9];
    const float* w_gu = args.in[10]; const float* b_gu = args.in[11]; const float* w_dn = args.in[12]; const float* b_dn = args.in[13]; const float* fin_g = args.in[14];
    float* out = args.out;
    float* ROPE = (float*)(ws + WS_ROPE); unsigned char* GWF = ws + WS_ROPE + 256 * 1024;
    int* TOKE = (int*)(ws + WS_TOKE); int* TOKR = (int*)(ws + WS_TOKR); float* TOKG = (float*)(ws + WS_TOKG); int* LIST = (int*)(ws + WS_LIST);
    bf16* WIN = (bf16*)(ws + WS_WIN); bf16* WO = (bf16*)(ws + WS_WO); bf16* XN = (bf16*)(ws + WS_XN); bf16* PROJ = (bf16*)(ws + WS_PROJ); bf16* YATT = (bf16*)(ws + WS_YATT);
    bf16* MIXED = (bf16*)(ws + WS_MIXED); float* X1 = (float*)(ws + WS_X1); unsigned char* XN2 = ws + WS_XN2; unsigned char* XS = ws + WS_XS; unsigned char* ACT = ws + WS_ACT;
    bf16* YB = (bf16*)(ws + WS_Y); unsigned char* WGU = ws + WS_WGU; unsigned char* WDN = ws + WS_WDN;

    for (int u = tid; u < (LDS_BYTES - LDSCTL_OFF) / 4; u += NWAVES * 64) ((LAS unsigned*)(L + LDSCTL_OFF))[u] = 0u;
    __syncthreads();
    XcdBarrier bar; bar.bar = (unsigned*)(ctl + CW_BAR); bar.x = 0; bar.st = nullptr;
    if (MK_N_LAUNCHES == 1) bar = xcd_barrier_post((unsigned*)(ctl + CW_BAR), MISC + 8);
    const int lo = args.ph_lo, hi = args.ph_hi;
#define IN(k) (lo <= (k) && (k) < hi)
#define BOTH(k) (IN(k) && IN((k) + 1))
#define GRID_BAR() do { if (MK_N_LAUNCHES == 1) xcd_barrier(bar); } while (0)
    const int gw = vcu * NWAVES + wave, NGW = G * NWAVES;
    const bool side_on = (MK_N_LAUNCHES == 1) && (G == 256) && (SIDE_CONV != 0);

    if (IN(0)) for (int rep = 0; rep < REPS(0); ++rep) {
        LAS float* scr = (LAS float*)(L + wave * 16384);
        constexpr int I_IN = 32 * (INC / 32), I_O = 32 * (DM / 32);
        constexpr int NIT = I_IN + I_O;
        for (int it = gw; it < NIT; it += NGW) {
            int r = it;
            if (r < I_IN) { const int nblk = INC / 32, kb = r / nblk, nb = r % nblk; p0_transpose_item(w_in, INC, DM, WIN, 64 * kb, 32 * nb, 32 * nb, scr, lane); continue; } r -= I_IN;
            { const int nblk = DM / 32, kb = r / nblk, nb = r % nblk; p0_transpose_item(w_out, DM, DM, WO, 64 * kb, 32 * nb, 32 * nb, scr, lane); }
        }
        for (int i = gw * 64 + lane; i < SEQ * 8; i += NGW * 64) { const int pos = i >> 3, f = i & 7;
            const float inv_freq = exp2f(-(float)f * 0.125f * 18.931568569324174f);
            const float ang = (float)pos * inv_freq;
            const double a = (double)ang; const double k = rint(a * 0.15915494309189535); const float red = (float)(a - k * 6.283185307179586);
            ROPE[pos * 16 + f] = cosf(red); ROPE[pos * 16 + 8 + f] = sinf(red); }
        for (int i = gw * 64 + lane; i < 64 * 2 * 64; i += NGW * 64) { const int ln = i & 63, eb = (i >> 6) & 1, ks = i >> 7; const int e = 16 * eb + (ln & 15), k0 = 32 * ks + 8 * (ln >> 4);
            unsigned hi[4], lo[4];
#pragma unroll
            for (int j = 0; j < 4; ++j) { const float v0 = w_router[(size_t)(k0 + 2 * j) * NE + e] * ffn_g[k0 + 2 * j], v1 = w_router[(size_t)(k0 + 2 * j + 1) * NE + e] * ffn_g[k0 + 2 * j + 1];
                const unsigned h0 = f2bf(v0), h1 = f2bf(v1); hi[j] = h0 | (h1 << 16); lo[j] = pk2(v0 - __uint_as_float(h0 << 16), v1 - __uint_as_float(h1 << 16)); }
            v4u* dst = (v4u*)GWF + ((size_t)(ks * 2 + eb) * 2) * 64 + ln; dst[0] = (v4u){hi[0], hi[1], hi[2], hi[3]}; dst[64] = (v4u){lo[0], lo[1], lo[2], lo[3]}; }
        for (int m = gw; m < NTOK; m += NGW) {
            const GAS f32x4* xr = (const GAS f32x4*)(x + (size_t)m * DM) + lane; const GAS f32x4* gr = (const GAS f32x4*)mix_g + lane;
            f32x4 v[8]; float s = 0.f;
#pragma unroll
            for (int j = 0; j < 8; ++j) { v[j] = xr[64 * j]; s += (v[j].x * v[j].x + v[j].y * v[j].y) + (v[j].z * v[j].z + v[j].w * v[j].w); }
            const float rstd = 1.0f / sqrtf(wave_sum(s) * (1.0f / DM) + EPS);
            GAS u32x2v* o8 = (GAS u32x2v*)(XN + (size_t)m * DM) + lane;
#pragma unroll
            for (int j = 0; j < 8; ++j) { const f32x4 gg = gr[64 * j]; u32x2v o; o.x = pk2(v[j].x * rstd * gg.x, v[j].y * rstd * gg.y); o.y = pk2(v[j].z * rstd * gg.z, v[j].w * rstd * gg.w); o8[64 * j] = o; }
        }
        if (BOTH(0)) GRID_BAR();
    }

    const int ga = (side_on && (SIDE_CONV & 1)) ? 16 : 0, gb = (side_on && (SIDE_CONV & 2)) ? 32 : 0;
    const int cv_lo = ga < gb ? ga : gb, cv_hi = ga < gb ? gb : ga, cv_pn = ga < gb ? 256 : 128, cv_po = ga < gb ? 0 : 256;
    const int nconv_eff = (cv_hi - cv_lo) * cv_pn + (NE - cv_hi) * PER_E;
#define CV_MAP(ci) ((ci) < (cv_hi - cv_lo) * cv_pn ? (cv_lo + (ci) / cv_pn) * PER_E + cv_po + (ci) % cv_pn : (cv_hi + ((ci) - (cv_hi - cv_lo) * cv_pn) / PER_E) * PER_E + ((ci) - (cv_hi - cv_lo) * cv_pn) % PER_E)
#define RUN_P2(ATTW, QA, QC, TRIED0, STOPW, STOPN) do { \
        LAS char* vl = (LAS char*)(L + wave * 16384); \
        LAS unsigned char* T = L + wave * 16384; \
        int mode = (wave < (ATTW)) ? 0 : 1, tried = (TRIED0), aq = 0; const int xcc = (int)xb_xcc_id() & 7; \
        while (tried < 2) { \
            if (mode == 0) { \
                  \
                bool got = false; \
                while (aq < 8) { const int qx = (xcc + aq) & 7; int idx = 0; if (lane == 0) idx = (int)__hip_atomic_fetch_add(ctl + (QA) + 16 * qx, 1u, __ATOMIC_RELAXED, __HIP_MEMORY_SCOPE_AGENT); \
                    idx = __builtin_amdgcn_readfirstlane(idx); \
                    if (idx < 768) { const int it = 64 * (qx + 8 * (idx >> 6)) + (idx & 63); __builtin_amdgcn_s_setprio(3); att::ATT_ITEM(it, PROJ, YATT, vl, lane); __builtin_amdgcn_s_setprio(0); got = true; break; } \
                    ++aq; } \
                if (got) continue; \
            } else { \
                 \
                int it = 0; if (lane == 0) it = (int)__hip_atomic_fetch_add(ctl + (QC), 1u, __ATOMIC_RELAXED, __HIP_MEMORY_SCOPE_AGENT); \
                it = __builtin_amdgcn_readfirstlane(it); \
                if (it < nconv_eff) { \
                    ConvDesc cur = conv_decode(CV_MAP(it), w_gu, w_dn, WGU, WDN, lane); \
                    f32x4 ra[8], rb[8]; \
                    CV_LOAD(ra, cur, 0); \
                    bool stop = false; \
                    for (;;) { \
                        int nx = nconv_eff; if (!stop && lane == 0) nx = (int)__hip_atomic_fetch_add(ctl + (QC), 1u, __ATOMIC_RELAXED, __HIP_MEMORY_SCOPE_AGENT); \
                        unsigned sv = 0u; if ((STOPW) >= 0) sv = __hip_atomic_load(ctl + ((STOPW) >= 0 ? (STOPW) : 0), __ATOMIC_RELAXED, __HIP_MEMORY_SCOPE_AGENT); \
_Pragma("unroll 1") \
                        for (int g = 0; g < CV_NG - 2; g += 2) { CV_LOAD(rb, cur, g + 1); CV_PROC(ra, cur, g); CV_LOAD(ra, cur, g + 2); CV_PROC(rb, cur, g + 1); } \
                        CV_LOAD(rb, cur, CV_NG - 1); CV_PROC(ra, cur, CV_NG - 2); \
                        nx = __builtin_amdgcn_readfirstlane(nx); const bool more = nx < nconv_eff; \
                        const ConvDesc nd = conv_decode(CV_MAP(more ? nx : it), w_gu, w_dn, WGU, WDN, lane); \
                        CV_LOAD(ra, nd, 0);                                   \
                        CV_PROC(rb, cur, CV_NG - 1); \
                        if ((STOPW) >= 0) stop = (unsigned)__builtin_amdgcn_readfirstlane((int)sv) >= (unsigned)(STOPN); \
                        if (!more) break; \
                        cur = nd; it = nx; \
                    } \
                } \
            } \
            if (mode == 0 && (ATTW) < 8 && (ATTW) > 0 && ATT_NOFALL && wave < (ATTW) - ATT_JOIN) break;     \
            mode ^= 1; ++tried; \
        } \
    } while (0)
    if (IN(1)) {
        const bool split = (MK_N_LAUNCHES == 1) && (G == 256) && (SPLIT_P1 != 0);
        const bool conv_wg = split && (((bx >> 3) & 1) == 1);
        if (!conv_wg) {
            pg8::Gemm g{XN, WIN, NTOK, INC, DM}; pg8::StaticOrder S; S.init(NTOK, INC, split ? 128 : G, split ? (((bx >> 4) << 3) | (bx & 7)) : bx);
            pg8::EpiProj E{PROJ, ROPE, att::C2};
            if (side_on && (SIDE_CONV & 1)) { pg8::SideConv SD{w_gu, WGU, 4096, 128 * bx, 96, (unsigned)PART_OFF}; pg8::gemm_phase<pg8::EpiProj, pg8::StaticOrder, true, true, false, false, pg8::SideConv>(L, g, S, E, SD); }
            else pg8::gemm_phase<pg8::EpiProj, pg8::StaticOrder, true, true>(L, g, S, E);
            __syncthreads();
            if (tid == 0) __hip_atomic_fetch_add(ctl + CW_P1DONE, 1u, __ATOMIC_RELAXED, __HIP_MEMORY_SCOPE_AGENT);
        } else {
            RUN_P2(0, CW_ATTQ, CW_CONVQ, 1, CW_P1DONE, 128);
        }
        if (BOTH(1)) GRID_BAR();
    }

    if (IN(2)) {
        RUN_P2(ATT_WAVES, CW_ATTQ, CW_CONVQ, 0, -1, 0);
        if (BOTH(2)) GRID_BAR();
        if ((PROBE_MASK >> 10) & 1) { RUN_P2(0, CW_ATTQ, CW_CONVQ + 64, 0, -1, 0); GRID_BAR(); }
        if ((PROBE_MASK >> 12) & 1) {
            unsigned char* SCR = ws + (size_t)2048 * MiB;
            for (int itp = gw; itp < 2 * NE * 1024; itp += NGW) {
                const int isdn = itp >= NE * 1024; const int r = isdn ? itp - NE * 1024 : itp; const int e = r >> 10, kp = r & 1023; const int N = isdn ? 2048 : 4096;
                const float* s0 = (isdn ? w_dn + (size_t)e * 2048 * 2048 : w_gu + (size_t)e * 2048 * 4096) + (size_t)(2 * kp) * N + 4 * lane; const float* s1 = s0 + N;
                unsigned char* d = SCR + (isdn ? (size_t)NE * 1024 * 8192 + ((size_t)e * 1024 + kp) * 4096 : ((size_t)e * 1024 + kp) * 8192) + 8 * lane;
                for (int i0 = 0; i0 < N / 256; i0 += 8) {
                    f32x4 a[8], c[8];
#pragma unroll
                    for (int i = 0; i < 8; ++i) { a[i] = *(const GAS f32x4*)(s0 + 256 * (i0 + i)); c[i] = *(const GAS f32x4*)(s1 + 256 * (i0 + i)); }
#pragma unroll
                    for (int i = 0; i < 8; ++i) { u32x2v o; o.x = pk4_fp8_nc(64.f * a[i][0], 64.f * c[i][0], 64.f * a[i][1], 64.f * c[i][1]); o.y = pk4_fp8_nc(64.f * a[i][2], 64.f * c[i][2], 64.f * a[i][3], 64.f * c[i][3]);
                        *(GAS u32x2v*)(d + 512 * (i0 + i)) = o; }
                }
            }
            GRID_BAR();
        }
        if ((PROBE_MASK >> 14) & 1) { RUN_P2(ATT_WAVES, CW_ATTQ + 2048, CW_CONVQ + 192, 0, -1, 0); GRID_BAR(); }
        if ((PROBE_MASK >> 13) & 1) { RUN_P2(4, CW_ATTQ, CW_CONVQ + 128, 1, -1, 0); GRID_BAR(); }
        if ((PROBE_MASK >> 15) & 1) { for (;;) { int it = 0; if (lane == 0) it = (int)__hip_atomic_fetch_add(ctl + CW_ATTQ + 256 + 64, 1u, __ATOMIC_RELAXED, __HIP_MEMORY_SCOPE_AGENT); it = __builtin_amdgcn_readfirstlane(it); if (it >= att::NITEMS) break;
            att::item<1>(it, PROJ, (bf16*)(ws + (size_t)3000 * MiB), (LAS char*)(L + wave * 16384), lane); } GRID_BAR(); }
        if ((PROBE_MASK >> 16) & 1) { for (;;) { int it = 0; if (lane == 0) it = (int)__hip_atomic_fetch_add(ctl + CW_ATTQ + 256 + 128, 1u, __ATOMIC_RELAXED, __HIP_MEMORY_SCOPE_AGENT); it = __builtin_amdgcn_readfirstlane(it); if (it >= att::NITEMS) break;
            att::item<2>(it, PROJ, (bf16*)(ws + (size_t)3000 * MiB), (LAS char*)(L + wave * 16384), lane); } GRID_BAR(); }
        if ((PROBE_MASK >> 11) & 1) { RUN_P2(8, CW_ATTQ + 1024, CW_CONVQ, 0, -1, 0); GRID_BAR(); }
    }

    if (IN(3)) for (int rep = 0; rep < REPS(3); ++rep) {
        for (int m = gw; m < NTOK; m += NGW) {
            const int spos = m & (SEQ - 1);
            const bf16* ya = YATT + (size_t)m * AW + 8 * lane;
            v4u a[3];
#pragma unroll
            for (int j = 0; j < 3; ++j) a[j] = *(const v4u*)(ya + 512 * j);
            const bf16* pr = PROJ + (size_t)m * INC + 8 * lane;
            float u[3][8];
#pragma unroll
            for (int d = 0; d < 3; ++d) {
                const int back = 2 - d;
                if (spos >= back) { const v4u cx = *(const v4u*)(pr - (size_t)back * INC); const v4u cc = *(const v4u*)(pr - (size_t)back * INC + 2 * CW);
                    u[d][0] = bf_lo(cx.x) * bf_lo(cc.x); u[d][1] = bf_hi(cx.x) * bf_hi(cc.x); u[d][2] = bf_lo(cx.y) * bf_lo(cc.y); u[d][3] = bf_hi(cx.y) * bf_hi(cc.y);
                    u[d][4] = bf_lo(cx.z) * bf_lo(cc.z); u[d][5] = bf_hi(cx.z) * bf_hi(cc.z); u[d][6] = bf_lo(cx.w) * bf_lo(cc.w); u[d][7] = bf_hi(cx.w) * bf_hi(cc.w); }
                else {
#pragma unroll
                    for (int j = 0; j < 8; ++j) u[d][j] = 0.f; }
            }
            const v4u cb = *(const v4u*)(pr + CW);
            float bb[8] = {bf_lo(cb.x), bf_hi(cb.x), bf_lo(cb.y), bf_hi(cb.y), bf_lo(cb.z), bf_hi(cb.z), bf_lo(cb.w), bf_hi(cb.w)};
            float y[8]; float s = 0.f;
#pragma unroll
            for (int j = 0; j < 8; ++j) { const int c = 8 * lane + j; const float acc = conv_w[c] * u[0][j] + conv_w[CW + c] * u[1][j] + conv_w[2 * CW + c] * u[2][j]; y[j] = bb[j] * acc; s += y[j] * y[j]; }
            const float rc = 1.0f / sqrtf(wave_sum(s) * (1.0f / CW) + EPS);
            { v4u o; const float* gq = conv_g + 8 * lane;
              o.x = pk2(y[0] * rc * gq[0], y[1] * rc * gq[1]); o.y = pk2(y[2] * rc * gq[2], y[3] * rc * gq[3]); o.z = pk2(y[4] * rc * gq[4], y[5] * rc * gq[5]); o.w = pk2(y[6] * rc * gq[6], y[7] * rc * gq[7]);
              *(v4u*)(MIXED + (size_t)m * DM + 8 * lane) = o; }
            float s2 = 0.f;
#pragma unroll
            for (int j = 0; j < 3; ++j) {
                const float f0 = bf_lo(a[j].x), f1 = bf_hi(a[j].x), f2 = bf_lo(a[j].y), f3 = bf_hi(a[j].y), f4 = bf_lo(a[j].z), f5 = bf_hi(a[j].z), f6 = bf_lo(a[j].w), f7 = bf_hi(a[j].w);
                s2 += (f0 * f0 + f1 * f1) + (f2 * f2 + f3 * f3) + (f4 * f4 + f5 * f5) + (f6 * f6 + f7 * f7); }
            const float ra = 1.0f / sqrtf(wave_sum(s2) * (1.0f / AW) + EPS);
#pragma unroll
            for (int j = 0; j < 3; ++j) { const float* gq = attn_g + 512 * j + 8 * lane; v4u o;
                o.x = pk2(bf_lo(a[j].x) * ra * gq[0], bf_hi(a[j].x) * ra * gq[1]); o.y = pk2(bf_lo(a[j].y) * ra * gq[2], bf_hi(a[j].y) * ra * gq[3]);
                o.z = pk2(bf_lo(a[j].z) * ra * gq[4], bf_hi(a[j].z) * ra * gq[5]); o.w = pk2(bf_lo(a[j].w) * ra * gq[6], bf_hi(a[j].w) * ra * gq[7]);
                *(v4u*)(MIXED + (size_t)m * DM + CW + 512 * j + 8 * lane) = o; }
        }
        if (BOTH(3)) GRID_BAR();
    }

    if (IN(4)) for (int rep = 0; rep < REPS(4); ++rep) {
        pg8::Gemm g{MIXED, WO, NTOK, DM, DM}; pg8::StaticOrder S; S.init(NTOK, DM, G, (int)blockIdx.x);
        pg8::EpiResF32 E{x, X1, DM};
        if (side_on && (SIDE_CONV & 1)) { pg8::SideConv SD{w_gu, WGU, 4096, 128 * bx + 96, 32, (unsigned)PART_OFF}; pg8::gemm_phase<pg8::EpiResF32, pg8::StaticOrder, false, true, false, false, pg8::SideConv>(L, g, S, E, SD); }
        else pg8::gemm_phase<pg8::EpiResF32, pg8::StaticOrder, false, true>(L, g, S, E);
        if (BOTH(4)) GRID_BAR();
    }

    if (IN(5)) for (int rep = 0; rep < REPS(5); ++rep) {
        const int cwc = CW_CNT + 1024 * rep; int* TOKE_ = TOKE + rep * (1 << 20); int* TOKR_ = TOKR + rep * (1 << 20); float* TOKG_ = TOKG + rep * (1 << 20); unsigned char* XS_ = XS + (size_t)rep * ((size_t)2752 * MiB - WS_XS);
        LAS float* X1L = (LAS float*)L; constexpr int XP = 2052;
        LAS float* PART = (LAS float*)(L + PART_OFF);
        const int e_ = lane & 31, kbase = 256 * wave + 128 * (lane >> 5);
        LAS int* LC = (LAS int*)(L + LDSCTL_OFF + 2048); LAS int* LB = (LAS int*)(L + LDSCTL_OFF + 2304);
        LAS int* AE = (LAS int*)(L + LDSCTL_OFF + 4096); LAS int* ALR = AE + 128; LAS float* AG = (LAS float*)(AE + 256); LAS float* RS = (LAS float*)(AE + 384);
        for (int blk = vcu; blk < NTOK / 32; blk += G) {
        if (tid < 32) LC[tid] = 0;
        __syncthreads();
        const int grp0 = 2 * blk;
#define P5_DMA(step) do { _Pragma("unroll") for (int r = 0; r < 2; ++r) _Pragma("unroll") for (int c = 0; c < 8; ++c) \
            __builtin_amdgcn_global_load_lds((const unsigned*)(X1 + (size_t)((grp0 + (step)) * 16 + 2 * wave + r) * DM + c * 256 + lane * 4), (LAS unsigned*)(L + (2 * wave + r) * (XP * 4) + c * 1024), 16, 0, 0); \
            asm volatile("s_waitcnt vmcnt(0)" ::: "memory"); __syncthreads(); } while (0)
        for (int step = 0; step < 2; ++step) {
            if (step) __syncthreads();
            P5_DMA(step);
            {
                typedef short s16x8b __attribute__((ext_vector_type(8)));
                f32x4 acc0 = {0.f, 0.f, 0.f, 0.f}, acc1 = acc0;
                const int tcol = lane & 15, kq = lane >> 4;
#pragma unroll
                for (int s8 = 0; s8 < 8; ++s8) { const int ks = 8 * wave + s8;
                    const LAS f32x4* xp = (const LAS f32x4*)(X1L + tcol * XP + 32 * ks + 8 * kq); const f32x4 xa = xp[0], xb = xp[1];
                    unsigned xh[4], xl[4];
                    { const unsigned h0 = f2bf(xa.x), h1 = f2bf(xa.y), h2 = f2bf(xa.z), h3 = f2bf(xa.w), h4 = f2bf(xb.x), h5 = f2bf(xb.y), h6 = f2bf(xb.z), h7 = f2bf(xb.w);
                      xh[0] = h0 | (h1 << 16); xh[1] = h2 | (h3 << 16); xh[2] = h4 | (h5 << 16); xh[3] = h6 | (h7 << 16);
                      xl[0] = pk2(xa.x - __uint_as_float(h0 << 16), xa.y - __uint_as_float(h1 << 16)); xl[1] = pk2(xa.z - __uint_as_float(h2 << 16), xa.w - __uint_as_float(h3 << 16));
                      xl[2] = pk2(xb.x - __uint_as_float(h4 << 16), xb.y - __uint_as_float(h5 << 16)); xl[3] = pk2(xb.z - __uint_as_float(h6 << 16), xb.w - __uint_as_float(h7 << 16)); }
                    const s16x8b bxh = __builtin_bit_cast(s16x8b, (v4u){xh[0], xh[1], xh[2], xh[3]}), bxl = __builtin_bit_cast(s16x8b, (v4u){xl[0], xl[1], xl[2], xl[3]});
                    const v4u* wf = (const v4u*)GWF + (size_t)(ks * 4) * 64 + lane;
                    const s16x8b w0h = __builtin_bit_cast(s16x8b, wf[0]), w0l = __builtin_bit_cast(s16x8b, wf[64]), w1h = __builtin_bit_cast(s16x8b, wf[128]), w1l = __builtin_bit_cast(s16x8b, wf[192]);
                    acc0 = __builtin_amdgcn_mfma_f32_16x16x32_bf16(w0h, bxh, acc0, 0, 0, 0); acc0 = __builtin_amdgcn_mfma_f32_16x16x32_bf16(w0l, bxh, acc0, 0, 0, 0); acc0 = __builtin_amdgcn_mfma_f32_16x16x32_bf16(w0h, bxl, acc0, 0, 0, 0);
                    acc1 = __builtin_amdgcn_mfma_f32_16x16x32_bf16(w1h, bxh, acc1, 0, 0, 0); acc1 = __builtin_amdgcn_mfma_f32_16x16x32_bf16(w1l, bxh, acc1, 0, 0, 0); acc1 = __builtin_amdgcn_mfma_f32_16x16x32_bf16(w1h, bxl, acc1, 0, 0, 0); }
                *(LAS f32x4*)(PART + (wave * 16 + tcol) * 32 + 4 * kq) = acc0; *(LAS f32x4*)(PART + (wave * 16 + tcol) * 32 + 16 + 4 * kq) = acc1;
            }
            __syncthreads();
            {
                float tvv[2][4]; int tii[2][4];
#pragma unroll
                for (int r = 0; r < 2; ++r) { const int tl = 2 * wave + r;
                    const LAS f32x4* hp = (const LAS f32x4*)(X1L + tl * XP + 32 * lane); float ss = 0.f;
#pragma unroll
                    for (int j = 0; j < 8; ++j) { const f32x4 a = hp[j]; ss += (a.x * a.x + a.y * a.y) + (a.z * a.z + a.w * a.w); }
                    const float rstd = 1.0f / sqrtf(wave_sum(ss) * (1.0f / DM) + EPS); if (lane == 0) RS[step * 16 + tl] = rstd;
                    float lg = -INFINITY;
                    if (lane < 32) { float s = 0.f;
#pragma unroll
                        for (int w = 0; w < 8; ++w) s += PART[(w * 16 + tl) * 32 + lane]; lg = s * rstd + b_router[lane]; }
                    int rank = 0; const int lgb = __float_as_int(lg);
#pragma unroll
                    for (int j = 0; j < 32; ++j) { const float vj = __int_as_float(__builtin_amdgcn_readlane(lgb, j)); rank += (vj > lg || (vj == lg && j < lane)) ? 1 : 0; }
#pragma unroll
                    for (int k = 0; k < 4; ++k) { const unsigned long long mk = __builtin_amdgcn_ballot_w64(lane < 32 && rank == k); const int idx = (int)__builtin_ctzll(mk);
                        tii[r][k] = idx; tvv[r][k] = __int_as_float(__builtin_amdgcn_readlane(lgb, idx)); } }
                if (lane < 8) { const int r = lane >> 2, k = lane & 3;
                    const float t0 = r ? tvv[1][0] : tvv[0][0], t1 = r ? tvv[1][1] : tvv[0][1], t2 = r ? tvv[1][2] : tvv[0][2], t3 = r ? tvv[1][3] : tvv[0][3];
                    const float e1 = __expf(t1 - t0), e2 = __expf(t2 - t0), e3 = __expf(t3 - t0); const float den = 1.0f / (1.0f + e1 + e2 + e3);
                    const int i0 = r ? tii[1][0] : tii[0][0], i1 = r ? tii[1][1] : tii[0][1], i2 = r ? tii[1][2] : tii[0][2], i3 = r ? tii[1][3] : tii[0][3];
                    const int ee = k == 0 ? i0 : k == 1 ? i1 : k == 2 ? i2 : i3; const float gg = (k == 0 ? 1.0f : k == 1 ? e1 : k == 2 ? e2 : e3) * den;
                    const int ai = (step * 16 + 2 * wave + r) * 4 + k;
                    AE[ai] = ee; ALR[ai] = __hip_atomic_fetch_add(LC + ee, 1, __ATOMIC_RELAXED, __HIP_MEMORY_SCOPE_WORKGROUP); AG[ai] = gg; }
            }
        }
        __syncthreads();
        if (tid < 32) { const int c = LC[tid]; LB[tid] = c ? (int)__hip_atomic_fetch_add(ctl + cwc + 16 * tid, (unsigned)c, __ATOMIC_RELAXED, __HIP_MEMORY_SCOPE_AGENT) : 0; }
        __syncthreads();
        for (int pp = 0; pp < 2; ++pp) { const int step = 1 - pp;
            if (pp) { __syncthreads(); P5_DMA(step); }
#pragma unroll
            for (int r = 0; r < 2; ++r) { const int tl = 2 * wave + r; const float sc = 16.f * RS[step * 16 + tl]; const int tok = (grp0 + step) * 16 + tl;
                const LAS f32x4* hp = (const LAS f32x4*)(X1L + tl * XP + 32 * lane); const f32x4* gp = (const f32x4*)(ffn_g + 32 * lane); v4u w0, w1;
                { const f32x4 a = hp[0] * gp[0] * sc, c = hp[1] * gp[1] * sc, d = hp[2] * gp[2] * sc, f = hp[3] * gp[3] * sc;
                  w0.x = pg8::pk4_fp8(a.x, a.y, a.z, a.w); w0.y = pg8::pk4_fp8(c.x, c.y, c.z, c.w); w0.z = pg8::pk4_fp8(d.x, d.y, d.z, d.w); w0.w = pg8::pk4_fp8(f.x, f.y, f.z, f.w); }
                { const f32x4 a = hp[4] * gp[4] * sc, c = hp[5] * gp[5] * sc, d = hp[6] * gp[6] * sc, f = hp[7] * gp[7] * sc;
                  w1.x = pg8::pk4_fp8(a.x, a.y, a.z, a.w); w1.y = pg8::pk4_fp8(c.x, c.y, c.z, c.w); w1.z = pg8::pk4_fp8(d.x, d.y, d.z, d.w); w1.w = pg8::pk4_fp8(f.x, f.y, f.z, f.w); }
#pragma unroll
                for (int k = 0; k < 4; ++k) { const int ai = (step * 16 + tl) * 4 + k; const int ee = AE[ai], rank = LB[ee] + ALR[ai];
                    GAS v4u* dst = (GAS v4u*)(XS_ + ((size_t)ee * NTOK + rank) * DM + 32 * lane); dst[0] = w0; dst[1] = w1;
                    if (lane == 0) { TOKE_[tok * 4 + k] = ee; TOKR_[tok * 4 + k] = rank; TOKG_[tok * 4 + k] = AG[ai]; } } }
        }
        __syncthreads();
        }
#undef P5_DMA
        if (BOTH(5)) GRID_BAR();
    }

    LAS int* TS = (LAS int*)(L + TAB_TS); LAS int* CN = (LAS int*)(L + TAB_CN);
    if (hi > 6) {
        if (tid == 0) { int acc = 0; for (int e = 0; e < NE; ++e) { const int c = (int)__hip_atomic_load(ctl + CW_CNT + 16 * e, __ATOMIC_RELAXED, __HIP_MEMORY_SCOPE_AGENT); CN[e] = c; TS[e] = acc; acc += (c + 255) >> 8; } TS[NE] = acc; }
        __syncthreads();
    }


    if (IN(7)) for (int rep = 0; rep < REPS(7); ++rep) {
        {
        pg8::GroupedOrder S{(const PG8_LAS int*)TS, (const PG8_LAS int*)CN, 16, G, vcu, (long)1024 * 4096 * 2, 128 * 2};
        pg8::EpiSwiGLU E{ACT, b_gu};
        pg8::Gemm g{(const pg8::bf16_t*)XS, (const pg8::bf16_t*)WGU, MAXSLOT, NE * 4096, DM / 2, 4096, 2048 * 2};
        if (side_on && (SIDE_CONV & 2)) { pg8::SideConv SD{w_dn, WDN, 2048, 128 * bx, 128, (unsigned)PART_OFF}; pg8::gemm_phase<pg8::EpiSwiGLU, pg8::GroupedOrder, true, true, true, true, pg8::SideConv>(L, g, S, E, SD); }
        else pg8::gemm_phase<pg8::EpiSwiGLU, pg8::GroupedOrder, true, true, true, true>(L, g, S, E); }
        if (BOTH(7)) GRID_BAR();
    }

    if (IN(8)) for (int rep = 0; rep < REPS(8); ++rep) {
        {
        pg8::GroupedOrder S{(const PG8_LAS int*)TS, (const PG8_LAS int*)CN, 8, G, vcu, (long)1024 * 2048 * 2, 256 * 2};
        pg8::EpiFp8Y E{(unsigned char*)YB, 1.0f / (pg8::FP8_W_SCALE * pg8::FP8_ACT_SCALE), b_dn};
        pg8::Gemm g{(const pg8::bf16_t*)ACT, (const pg8::bf16_t*)WDN, MAXSLOT, NE * 2048, DE / 2, 2048, 128 * 2};
        pg8::gemm_phase<pg8::EpiFp8Y, pg8::GroupedOrder, true, true, true, true>(L, g, S, E); }
        if (BOTH(8)) GRID_BAR();
    }

    if (IN(9)) for (int rep = 0; rep < REPS(9); ++rep) {
        unsigned poison = __hip_atomic_load(ctl + CW_BAR + XB_TMO, RLX_AGENT) != 0u;
        for (int m = gw; m < NTOK; m += NGW) {
            const GAS f32x4* xr = (const GAS f32x4*)(X1 + (size_t)m * DM) + lane;
            f32x4 v[8];
#pragma unroll
            for (int j = 0; j < 8; ++j) v[j] = __builtin_nontemporal_load(xr + 64 * j);
            const int4 te = *(const int4*)(TOKE + m * 4), tr = *(const int4*)(TOKR + m * 4); const f32x4 tg = *(const f32x4*)(TOKG + m * 4);
            const int ee[4] = {te.x, te.y, te.z, te.w}, rr[4] = {tr.x, tr.y, tr.z, tr.w};
            unsigned yy[4][8];
#pragma unroll
            for (int k = 0; k < TOPK; ++k) { const GAS unsigned* yr = (const GAS unsigned*)((const unsigned char*)YB + ((size_t)ee[k] * NTOK + rr[k]) * DM) + lane;
#pragma unroll
                for (int j = 0; j < 8; ++j) yy[k][j] = __builtin_nontemporal_load(yr + 64 * j); }
#pragma unroll
            for (int k = 0; k < TOPK; ++k) { const float gt = tg[k] * (1.0f / 16.0f);
#pragma unroll
                for (int j = 0; j < 8; ++j) { typedef float f32x2y __attribute__((ext_vector_type(2))); const f32x2y lo = __builtin_amdgcn_cvt_pk_f32_fp8((int)yy[k][j], false), hi = __builtin_amdgcn_cvt_pk_f32_fp8((int)yy[k][j], true);
                    v[j].x += gt * lo.x; v[j].y += gt * lo.y; v[j].z += gt * hi.x; v[j].w += gt * hi.y; } }
            float s = 0.f;
#pragma unroll
            for (int j = 0; j < 8; ++j) s += (v[j].x * v[j].x + v[j].y * v[j].y) + (v[j].z * v[j].z + v[j].w * v[j].w);
            float rstd = 1.0f / sqrtf(wave_sum(s) * (1.0f / DM) + EPS);
            if (poison) rstd = __builtin_nanf("");
            GAS f32x4* orow = (GAS f32x4*)(out + (size_t)m * DM) + lane; const GAS f32x4* gr = (const GAS f32x4*)fin_g + lane;
#pragma unroll
            for (int j = 0; j < 8; ++j) { const f32x4 gg = gr[64 * j]; f32x4 o; o.x = v[j].x * rstd * gg.x; o.y = v[j].y * rstd * gg.y; o.z = v[j].z * rstd * gg.z; o.w = v[j].w * rstd * gg.w; __builtin_nontemporal_store(o, orow + 64 * j); }
        }
    }
#undef IN
#undef BOTH
#undef GRID_BAR
}

extern "C" void kernel_launch(void* const* d_in, const int* in_sizes, int n_in, void* d_out, int out_size, void* d_ws, size_t ws_size, hipStream_t stream) {
    static int grid = 0;
    if (grid == 0) {
        if (n_in != 15 || in_sizes[0] != NTOK * DM || out_size != NTOK * DM || ws_size < WS_END) { fprintf(stderr, "kernel_launch: unexpected shapes / workspace (n_in %d, ws %zu)\n", n_in, ws_size); grid = -1; return; }
        int dev = 0, cus = 0, per_cu = 0;
        if (hipGetDevice(&dev) != hipSuccess || hipDeviceGetAttribute(&cus, hipDeviceAttributeMultiprocessorCount, dev) != hipSuccess) { grid = -1; return; }
        if (hipFuncSetAttribute((const void*)fwd, hipFuncAttributeMaxDynamicSharedMemorySize, LDS_BYTES) != hipSuccess) { fprintf(stderr, "kernel_launch: hipFuncSetAttribute failed\n"); grid = -1; return; }
        if (hipOccupancyMaxActiveBlocksPerMultiprocessor(&per_cu, (const void*)fwd, NWAVES * 64, LDS_BYTES) != hipSuccess || per_cu < 1) fprintf(stderr, "kernel_launch: occupancy query says %d\n", per_cu);
        (void)hipGetLastError();
        grid = cus;
    }
    if (grid < 0) return;
    if (hipMemsetAsync((char*)d_ws + WS_CTL, 0, CTL_ZERO_BYTES, stream) != hipSuccess) return;
    Args a{};
    for (int i = 0; i < 15; ++i) a.in[i] = (const float*)d_in[i];
    a.out = (float*)d_out; a.ws = (unsigned char*)d_ws;
    if (MK_N_LAUNCHES == 1) { a.ph_lo = 0; a.ph_hi = NPH; hipLaunchKernelGGL(fwd, dim3(grid), dim3(NWAVES * 64), LDS_BYTES, stream, a); }
    else { for (int p = 0; p < NPH; ++p) { a.ph_lo = p; a.ph_hi = p + 1; hipLaunchKernelGGL(fwd, dim3(grid), dim3(NWAVES * 64), LDS_BYTES, stream, a); } }
    const hipError_t le = hipPeekAtLastError();
    if (le != hipSuccess) fprintf(stderr, "kernel_launch: launch failed: %s\n", hipGetErrorName(le));
}
```

```cpp
#include <hip/hip_runtime.h>
#include <cstdio>
#include <cstdint>
namespace pg8 {
#define PG8_LAS __attribute__((address_space(3)))
typedef unsigned short bf16_t;
typedef short bf16x8 __attribute__((ext_vector_type(8)));
typedef float f32x4 __attribute__((ext_vector_type(4)));
typedef unsigned u32x4 __attribute__((ext_vector_type(4)));
constexpr int BM = 256, BK = 64, HALF = 128, HTB = HALF * BK * 2  , STAGE_BYTES = 8 * HTB, NXCD = 8, WGM = 8;

__host__ __device__ __forceinline__ int lds_byte(int r, int c) { const int st = (r >> 4) * 2 + (c >> 5), rr = r & 15, cc = c & 31, ob = rr * 64 + cc * 2; return st * 1024 + (ob ^ (((ob >> 9) & 1) << 5)); }
__host__ __device__ __forceinline__ void stage_rc(int b, int& R, int& C) { const int st = b / 1024, sb = b % 1024, swz = sb ^ (((sb >> 9) & 1) << 5); R = (st >> 1) * 16 + swz / 64; C = (st & 1) * 32 + (swz % 64) / 2; }
__host__ __device__ __forceinline__ int perm32(int rho) { const int n = rho >> 4, i = rho & 15; return 8 * (i >> 2) + 4 * n + (i & 3); }

struct Unit { int pm, pn, e, cn, rows; long boff; };
struct Gemm { const bf16_t* A; const bf16_t* Bt; int M, N, K; int b_ntot, b_hstep; };

struct StaticOrder {
    int nM, nN, nwg, G, c;
    __host__ __device__ void init(int M, int N, int G_, int c_) { nM = M / BM; nN = N / BM; nwg = nM * nN; G = G_; c = c_; }
    __host__ __device__ bool next(int i, Unit& u) const {
        const long L = (long)i * G + c; if (L >= nwg) return false;
        int wgid = (int)L; { const int q = nwg / NXCD, r = nwg % NXCD, xcd = wgid % NXCD, off = wgid / NXCD; wgid = (xcd < r ? xcd * (q + 1) : r * (q + 1) + (xcd - r) * q) + off; }
        const int nig = WGM * nN, gid = wgid / nig, fm = gid * WGM, gsz = (nM - fm) < WGM ? (nM - fm) : WGM;
        u.pm = fm + ((wgid % nig) % gsz); u.pn = (wgid % nig) / gsz; u.e = 0; u.cn = u.pn; u.rows = BM; u.boff = 0; return true;
    }
    __device__ __forceinline__ void a_ready(const Unit&) const {}
    __device__ __forceinline__ void done(const Unit&) const {}
};
struct GroupedOrder {
    const PG8_LAS int* TS; const PG8_LAS int* CN; int nN, G, v; long b_estride; int b_cnstep;
    __device__ __forceinline__ bool next(int i, Unit& u) const {
        const int U = i * G + v; const int total = __builtin_amdgcn_readfirstlane(TS[32] * nN); if (U >= total) return false;
        int e = 0;
#pragma unroll 1
        for (int j = 1; j < 32; ++j) e += (TS[j] * nN <= U) ? 1 : 0;
        const int t0 = TS[e], nt = TS[e + 1] - t0, loc = U - t0 * nN; const int pn = loc / nt, rt = loc - pn * nt; const int left = CN[e] - rt * BM;
        u.pm = __builtin_amdgcn_readfirstlane(e * 32 + rt); u.pn = __builtin_amdgcn_readfirstlane(e * nN + pn); u.e = __builtin_amdgcn_readfirstlane(e); u.cn = __builtin_amdgcn_readfirstlane(pn);
        u.rows = __builtin_amdgcn_readfirstlane(left < BM ? left : BM); u.boff = (long)u.e * b_estride + (long)u.cn * b_cnstep; return true;
    }
    __device__ __forceinline__ void a_ready(const Unit&) const {}
    __device__ __forceinline__ void done(const Unit&) const {}
};

__device__ __forceinline__ unsigned cvt_pk_bf16(float lo, float hi) { unsigned r; asm volatile("v_cvt_pk_bf16_f32 %0, %1, %2" : "=v"(r) : "v"(lo), "v"(hi)); return r; }

struct EpiBf16Plain {
    static constexpr bool PERM = true, AFTER_DRAIN = false;
    bf16_t* O; int ldc; float sc; const float* bias;
    __device__ __forceinline__ void operator()(const f32x4 (&acc)[2][2][4][2], const Unit& u, int wr, int wc, int fr, int fq) const {
        const int row0 = u.pm * BM + wr * 64 + fr, col0 = u.cn * BM + wc * 32 + 8 * fq;
        f32x4 bv[2][2];
#pragma unroll
        for (int bj = 0; bj < 2; ++bj)
#pragma unroll
            for (int n = 0; n < 2; ++n) bv[bj][n] = bias ? *(const f32x4*)(bias + (size_t)u.e * ldc + col0 + bj * HALF + 4 * n) : (f32x4){0.f, 0.f, 0.f, 0.f};
#pragma unroll
        for (int ai = 0; ai < 2; ++ai) { if (ai == 1 && u.rows <= HALF) break;
#pragma unroll
            for (int m = 0; m < 4; ++m) { bf16_t* rowp = O + (size_t)(row0 + ai * HALF + m * 16) * ldc + col0;
#pragma unroll
                for (int bj = 0; bj < 2; ++bj) { const f32x4 v0 = acc[ai][bj][m][0] * sc + bv[bj][0], v1 = acc[ai][bj][m][1] * sc + bv[bj][1];
                    u32x4 w; w.x = cvt_pk_bf16(v0[0], v0[1]); w.y = cvt_pk_bf16(v0[2], v0[3]); w.z = cvt_pk_bf16(v1[0], v1[1]); w.w = cvt_pk_bf16(v1[2], v1[3]);
                    *(u32x4*)(rowp + bj * HALF) = w; } } }
    }
};
struct EpiProj {
    static constexpr bool PERM = true, AFTER_DRAIN = false;
    bf16_t* O; const float* rope; float qscale;
    __device__ __forceinline__ void operator()(const f32x4 (&acc)[2][2][4][2], const Unit& u, int wr, int wc, int fr, int fq) const {
        const int row0 = u.pm * BM + wr * 64 + fr, col0 = u.cn * BM + wc * 32 + 8 * fq;
        const bool isq = (u.cn >= 6 && u.cn < 12), isk = (u.cn >= 12 && u.cn < 18);
        const bool rot = (isq || isk) && ((wc & 1) == 0);
        const float sc = isq ? qscale : 1.0f;
        const float sg = (fq == 0) ? -1.0f : 1.0f;
        const bool act = fq < 2;
#pragma unroll
        for (int ai = 0; ai < 2; ++ai)
#pragma unroll
            for (int m = 0; m < 4; ++m) { const int row = row0 + ai * HALF + m * 16; bf16_t* rowp = O + (size_t)row * 6144 + col0;
                f32x4 c0 = {1.f, 1.f, 1.f, 1.f}, c1 = c0, s0 = {0.f, 0.f, 0.f, 0.f}, s1 = s0;
                if (rot) { const float* rp = rope + (row & 2047) * 16; c0 = *(const f32x4*)rp; c1 = *(const f32x4*)(rp + 4); s0 = *(const f32x4*)(rp + 8); s1 = *(const f32x4*)(rp + 12); }
#pragma unroll
                for (int bj = 0; bj < 2; ++bj) { f32x4 v0 = acc[ai][bj][m][0], v1 = acc[ai][bj][m][1];
                    if (rot) { f32x4 o0, o1;
#pragma unroll
                        for (int i = 0; i < 4; ++i) { o0[i] = __shfl_xor(v0[i], 16); o1[i] = __shfl_xor(v1[i], 16); }
                        const f32x4 r0 = v0 * c0 + (o0 * s0) * sg, r1 = v1 * c1 + (o1 * s1) * sg;
                        v0 = act ? r0 : v0; v1 = act ? r1 : v1; }
                    v0 = v0 * sc; v1 = v1 * sc;
                    u32x4 w; w.x = cvt_pk_bf16(v0[0], v0[1]); w.y = cvt_pk_bf16(v0[2], v0[3]); w.z = cvt_pk_bf16(v1[0], v1[1]); w.w = cvt_pk_bf16(v1[2], v1[3]);
                    *(u32x4*)(rowp + bj * HALF) = w; } }
    }
};
struct EpiResF32 {
    static constexpr bool PERM = false, AFTER_DRAIN = false;
    const float* base; float* out; int ldc;
    __device__ __forceinline__ void operator()(const f32x4 (&acc)[2][2][4][2], const Unit& u, int wr, int wc, int fr, int fq) const {
        const int row0 = u.pm * BM + wr * 64 + fr, col0 = u.cn * BM + wc * 32 + 4 * fq;
#pragma unroll
        for (int ai = 0; ai < 2; ++ai)
#pragma unroll
            for (int m = 0; m < 4; ++m) { const size_t off = (size_t)(row0 + ai * HALF + m * 16) * ldc + col0;
#pragma unroll
                for (int bj = 0; bj < 2; ++bj)
#pragma unroll
                    for (int n = 0; n < 2; ++n) { const f32x4 b = *(const f32x4*)(base + off + bj * HALF + n * 16); *(f32x4*)(out + off + bj * HALF + n * 16) = acc[ai][bj][m][n] + b; } }
    }
};
__device__ __forceinline__ float swiglu1(float g, float up) {
    g = fminf(g, 7.0f); up = fminf(fmaxf(up, -7.0f), 7.0f);
    const float e = __builtin_amdgcn_exp2f(g * (-1.702f * 1.4426950408889634f));
    return (up + 1.0f) * g * __builtin_amdgcn_rcpf(1.0f + e);
}
__device__ __forceinline__ unsigned pk4_fp8(float a, float b, float c, float d) {
    a = fminf(fmaxf(a, -448.f), 448.f); b = fminf(fmaxf(b, -448.f), 448.f); c = fminf(fmaxf(c, -448.f), 448.f); d = fminf(fmaxf(d, -448.f), 448.f);
    int w = 0; w = __builtin_amdgcn_cvt_pk_fp8_f32(a, b, w, false); w = __builtin_amdgcn_cvt_pk_fp8_f32(c, d, w, true); return (unsigned)w; }
constexpr float FP8_W_SCALE = 64.f, FP8_X_SCALE = 16.f, FP8_ACT_SCALE = 4.f;
struct EpiFp8Y {
    static constexpr bool PERM = true, AFTER_DRAIN = false;
    unsigned char* O; float sc; const float* bias;
    __device__ __forceinline__ void operator()(const f32x4 (&acc)[2][2][4][2], const Unit& u, int wr, int wc, int fr, int fq) const {
        const int row0 = u.pm * BM + wr * 64 + fr, col0 = u.cn * BM + wc * 32 + 8 * fq;
        f32x4 bv[2][2];
#pragma unroll
        for (int bj = 0; bj < 2; ++bj)
#pragma unroll
            for (int n = 0; n < 2; ++n) bv[bj][n] = *(const f32x4*)(bias + (size_t)u.e * 2048 + col0 + bj * HALF + 4 * n);
#pragma unroll
        for (int ai = 0; ai < 2; ++ai) { if (ai == 1 && u.rows <= HALF) break;
#pragma unroll
            for (int m = 0; m < 4; ++m) { unsigned char* rowp = O + (size_t)(row0 + ai * HALF + m * 16) * 2048 + col0;
#pragma unroll
                for (int bj = 0; bj < 2; ++bj) { const f32x4 v0 = (acc[ai][bj][m][0] * sc + bv[bj][0]) * 16.f, v1 = (acc[ai][bj][m][1] * sc + bv[bj][1]) * 16.f;
                    typedef unsigned u32x2y __attribute__((ext_vector_type(2))); u32x2y w; w.x = pk4_fp8(v0[0], v0[1], v0[2], v0[3]); w.y = pk4_fp8(v1[0], v1[1], v1[2], v1[3]);
                    *(u32x2y*)(rowp + bj * HALF) = w; } } }
    }
};
struct EpiSwiGLU {
    static constexpr bool PERM = true, AFTER_DRAIN = false;
    unsigned char* O; const float* bias;
    __device__ __forceinline__ void operator()(const f32x4 (&acc)[2][2][4][2], const Unit& u, int wr, int wc, int fr, int fq) const {
        const int row0 = u.pm * BM + wr * 64 + fr, colj = u.cn * HALF + wc * 32 + 8 * fq;
        const float* bg = bias + (size_t)u.e * 4096 + colj; const float isc = 1.0f / (FP8_W_SCALE * FP8_X_SCALE);
        const f32x4 bg0 = *(const f32x4*)(bg), bg1 = *(const f32x4*)(bg + 4), bu0 = *(const f32x4*)(bg + 2048), bu1 = *(const f32x4*)(bg + 2048 + 4);
#pragma unroll
        for (int ai = 0; ai < 2; ++ai) { if (ai == 1 && u.rows <= HALF) break;
#pragma unroll
            for (int m = 0; m < 4; ++m) { unsigned char* rowp = O + (size_t)(row0 + ai * HALF + m * 16) * 2048 + colj;
                const f32x4 g0 = acc[ai][0][m][0] * isc + bg0, g1 = acc[ai][0][m][1] * isc + bg1, u0 = acc[ai][1][m][0] * isc + bu0, u1 = acc[ai][1][m][1] * isc + bu1;
                typedef unsigned u32x2e __attribute__((ext_vector_type(2))); u32x2e w;
                w.x = pk4_fp8(FP8_ACT_SCALE * swiglu1(g0[0], u0[0]), FP8_ACT_SCALE * swiglu1(g0[1], u0[1]), FP8_ACT_SCALE * swiglu1(g0[2], u0[2]), FP8_ACT_SCALE * swiglu1(g0[3], u0[3]));
                w.y = pk4_fp8(FP8_ACT_SCALE * swiglu1(g1[0], u1[0]), FP8_ACT_SCALE * swiglu1(g1[1], u1[1]), FP8_ACT_SCALE * swiglu1(g1[2], u1[2]), FP8_ACT_SCALE * swiglu1(g1[3], u1[3]));
                *(u32x2e*)rowp = w; } }
    }
};
typedef short v4i16p_t __attribute__((ext_vector_type(4)));
typedef int v2i_t __attribute__((ext_vector_type(2)));
__device__ __forceinline__ v2i_t trb(PG8_LAS const unsigned char* p) { return __builtin_bit_cast(v2i_t, __builtin_amdgcn_ds_read_tr16_b64_v4i16((PG8_LAS v4i16p_t*)p)); }
typedef int v8i_t __attribute__((ext_vector_type(8)));
typedef int v4i_t __attribute__((ext_vector_type(4)));
__device__ __forceinline__ v8i_t cat8(bf16x8 a, bf16x8 b) { const v4i_t x = __builtin_bit_cast(v4i_t, a), y = __builtin_bit_cast(v4i_t, b); return __builtin_shufflevector(x, y, 0, 1, 2, 3, 4, 5, 6, 7); }
__device__ __forceinline__ void mfma_fp8(f32x4& c, v8i_t a, v8i_t b, int sc) { asm volatile("v_mfma_scale_f32_16x16x128_f8f6f4 %0, %1, %2, %0, %3, %3 op_sel_hi:[0,0,0]" : "+v"(c) : "v"(a), "v"(b), "v"(sc)); }
struct NoSide { static constexpr bool ON = false, TWO = false; int njobs; };
struct SideConv {
    static constexpr bool ON = true, TWO = true;
    const float* W; unsigned char* OUT; int ntot; int c0, njobs; unsigned stage;
    __device__ __forceinline__ void addr(int j, int tid, const float*& s0, unsigned char*& d) const {
        const int c = c0 + j, cpk = ntot >> 11, kpg = c / cpk, half = c - kpg * cpk, e = kpg >> 10, kp = kpg & 1023;
        s0 = W + (size_t)e * 2048 * ntot + (size_t)(2 * kp) * ntot + half * 2048 + 4 * tid;
        d = OUT + ((size_t)e * 1024 + kp) * ntot * 2 + (size_t)(half * 2048 + 4 * tid) * 2;
    }
    __device__ __forceinline__ void issue(PG8_LAS unsigned char* lds0, int j, int tid, int wid) const {
        const float* s0; unsigned char* d; addr(j, tid, s0, d);
        __builtin_amdgcn_global_load_lds((const unsigned*)s0, (PG8_LAS unsigned*)(lds0 + stage + wid * 1024), 16, 0, 2);
        __builtin_amdgcn_global_load_lds((const unsigned*)(s0 + ntot), (PG8_LAS unsigned*)(lds0 + stage + 8192 + wid * 1024), 16, 0, 2);
    }
    __device__ __forceinline__ void read(v4i_t& t0, v4i_t& t1, int tid, unsigned ldsb) const {
        asm volatile("ds_read_b128 %0, %1" : "=&v"(t0) : "v"(ldsb + stage + 16u * (unsigned)tid) : "memory");
        asm volatile("ds_read_b128 %0, %1" : "=&v"(t1) : "v"(ldsb + stage + 8192u + 16u * (unsigned)tid) : "memory");
    }
    __device__ __forceinline__ void finish(v4i_t& t0, v4i_t& t1, int j, int tid) const {
        asm volatile("" : "+v"(t0), "+v"(t1));
        const float* s0; unsigned char* d; addr(j, tid, s0, d);
        const f32x4 r0 = __builtin_bit_cast(f32x4, t0) * 64.f, r1 = __builtin_bit_cast(f32x4, t1) * 64.f;
        int w0 = 0, w1 = 0; w0 = __builtin_amdgcn_cvt_pk_fp8_f32(r0[0], r1[0], w0, false); w0 = __builtin_amdgcn_cvt_pk_fp8_f32(r0[1], r1[1], w0, true);
        w1 = __builtin_amdgcn_cvt_pk_fp8_f32(r0[2], r1[2], w1, false); w1 = __builtin_amdgcn_cvt_pk_fp8_f32(r0[3], r1[3], w1, true);
        typedef int v2is __attribute__((ext_vector_type(2))); __builtin_nontemporal_store((v2is){w0, w1}, (v2is*)d);
    }
};
template <class Epi, class Sched, bool ALIGN_EPI = false, bool SP2 = false, bool FP8 = false, bool BPAIR = false, class Side = NoSide>
__device__ __forceinline__ void gemm_phase(PG8_LAS unsigned char* lds, const Gemm g, const Sched& S, const Epi& E, const Side SD = Side{}) {
    const int tid = threadIdx.x, wid = __builtin_amdgcn_readfirstlane(tid >> 6), lane = tid & 63, wr = wid >> 2, wc = wid & 3, fr = lane & 15, fq = lane >> 4;
    const int K = g.K, nt = K / BK;
    int fp8_scale1 = 0x7f7f7f7f; if constexpr (FP8) asm volatile("" : "+v"(fp8_scale1));
    unsigned voffA[2], voffB[2];
#pragma unroll
    for (int i = 0; i < 2; ++i) { int R, C; stage_rc(tid * 16 + i * 8192, R, C); const int Rb = Epi::PERM ? ((R & ~31) + perm32(R & 31)) : R;
        voffA[i] = (unsigned)(R * K + C) * 2u; voffB[i] = (unsigned)(Rb * K + C) * 2u;
        if constexpr (BPAIR) { const int b_ = tid * 16 + i * 8192, kp_ = b_ >> 8, sl_ = (b_ & 255) >> 4, pc_ = sl_ ^ (2 * ((kp_ & 3) | (((kp_ >> 3) & 1) << 2))); voffB[i] = (unsigned)(kp_ * g.b_ntot + 8 * pc_) * 2u; } }
    const size_t kstep = (size_t)(BK * 2);
    const size_t hstep = (size_t)HALF * K * 2;
    const size_t tstep = 2 * hstep;
    const size_t kstepB = BPAIR ? (size_t)64 * g.b_ntot * 2 : kstep, hstepB = BPAIR ? (size_t)g.b_hstep : hstep;
    const unsigned ldsw = (unsigned)wid * 1024u;
    const int aoff = lds_byte(wr * 64 + fr, fq * 8), boff = lds_byte(wc * 32 + fr, fq * 8);
    const int boffP = (8 * fq + ((lane & 15) >> 2)) * 256 + 16 * ((4 * wc + (lane & 3)) ^ (2 * (((lane & 15) >> 2) | ((fq & 1) << 2))));
#define PG8_SA(b, h) (((b) * 2 + (h)) * HTB)
#define PG8_SB(b, h) ((4 + (b) * 2 + (h)) * HTB)
#define PG8_STAGE(bufoff, gbase, voff) do { _Pragma("unroll") for (int _i = 0; _i < 2; ++_i) \
        __builtin_amdgcn_global_load_lds((const unsigned*)((const char*)(gbase) + (voff)[_i]), (PG8_LAS unsigned*)(lds + (bufoff) + ldsw + _i * 8192), 16, 0, 0); } while (0)
#define PG8_LDA(dst, b, h) do { _Pragma("unroll") for (int m = 0; m < 4; ++m) _Pragma("unroll") for (int k = 0; k < 2; ++k) dst[m][k] = *(const PG8_LAS bf16x8*)(lds + PG8_SA(b, h) + aoff + m * 2048 + k * 1024); } while (0)
#define PG8_TRA(dstv, addr, off) asm volatile("ds_read_b64_tr_b16 %0, %1 offset:%c2" : "=&v"(dstv) : "v"(addr), "i"(off) : "memory")
#define PG8_LDB(dst, b, h) do { if constexpr (BPAIR) { _Pragma("unroll") for (int n = 0; n < 2; ++n) { const unsigned a_ = ldsb32 + (unsigned)(PG8_SB(b, h) + boffP + 8 * n); \
            PG8_TRA(dst##r[n][0], a_, 0); PG8_TRA(dst##r[n][1], a_, 1024); PG8_TRA(dst##r[n][2], a_, 8192); PG8_TRA(dst##r[n][3], a_, 9216); } } \
        else { _Pragma("unroll") for (int n = 0; n < 2; ++n) _Pragma("unroll") for (int k = 0; k < 2; ++k) dst[n][k] = *(const PG8_LAS bf16x8*)(lds + PG8_SB(b, h) + boff + n * 2048 + k * 1024); } } while (0)
#define PG8_FIXB(dst) do { if constexpr (BPAIR) { _Pragma("unroll") for (int n = 0; n < 2; ++n) { \
            asm volatile("" : "+v"(dst##r[n][0]), "+v"(dst##r[n][1]), "+v"(dst##r[n][2]), "+v"(dst##r[n][3])); \
            dst[n][0] = __builtin_bit_cast(bf16x8, (v4i_t){dst##r[n][0][0], dst##r[n][0][1], dst##r[n][1][0], dst##r[n][1][1]}); dst[n][1] = __builtin_bit_cast(bf16x8, (v4i_t){dst##r[n][2][0], dst##r[n][2][1], dst##r[n][3][0], dst##r[n][3][1]}); } } } while (0)
#define PG8_MMA(ai, bj, At, Bt) do { __builtin_amdgcn_s_setprio(1); _Pragma("unroll") for (int m = 0; m < 4; ++m) _Pragma("unroll") for (int n = 0; n < 2; ++n) { \
        if constexpr (FP8) { mfma_fp8(acc[ai][bj][m][n], cat8(Bt[n][0], Bt[n][1]), cat8(At[m][0], At[m][1]), fp8_scale1); } \
        else { _Pragma("unroll") for (int k = 0; k < 2; ++k) acc[ai][bj][m][n] = __builtin_amdgcn_mfma_f32_16x16x32_bf16(Bt[n][k], At[m][k], acc[ai][bj][m][n], 0, 0, 0); } } \
        __builtin_amdgcn_s_setprio(0); } while (0)
#define PG8_WAIT_V(n) asm volatile("s_waitcnt vmcnt(" #n ")" ::: "memory")
#define PG8_WAIT_L(n) asm volatile("s_waitcnt lgkmcnt(" #n ")" ::: "memory")
#define PG8_BAR __builtin_amdgcn_s_barrier()
#define PG8_SCHED __builtin_amdgcn_sched_barrier(0)
    Unit cur, nxt; int ui = 0;
    if (!S.next(0, cur)) return;
    f32x4 acc[2][2][4][2];
#pragma unroll
    for (int a = 0; a < 2; ++a)
#pragma unroll
        for (int b = 0; b < 2; ++b)
#pragma unroll
            for (int m = 0; m < 4; ++m)
#pragma unroll
                for (int n = 0; n < 2; ++n) acc[a][b][m][n] = (f32x4){0.f, 0.f, 0.f, 0.f};
    bf16x8 At[4][2], B0[2][2], B1[2][2];
    int sj = 0; bool spend = false; v4i_t st0 = {0, 0, 0, 0}, st1 = st0; PG8_LAS unsigned char* const lds0 = lds;
    v2i_t B0r[2][4], B1r[2][4]; const unsigned ldsb32 = (unsigned)(size_t)lds;
    const char* cA = (const char*)g.A + (size_t)cur.pm * tstep; const char* cB = (const char*)g.Bt + (BPAIR ? (size_t)cur.boff : (size_t)cur.pn * tstep);
    S.a_ready(cur);
    if constexpr (SP2) {
        PG8_STAGE(PG8_SB(0, 0), cB, voffB); PG8_STAGE(PG8_SB(0, 1), cB + hstepB, voffB); PG8_STAGE(PG8_SA(0, 0), cA, voffA); PG8_STAGE(PG8_SA(0, 1), cA + hstep, voffA);
        if (wr == 1) PG8_BAR;
        PG8_WAIT_V(2); PG8_BAR;
        PG8_STAGE(PG8_SB(1, 0), cB + kstepB, voffB); PG8_STAGE(PG8_SA(1, 0), cA + kstep, voffA); PG8_STAGE(PG8_SB(1, 1), cB + hstepB + kstepB, voffB);
        PG8_WAIT_V(6); PG8_BAR;
    } else {
        PG8_STAGE(PG8_SB(0, 0), cB, voffB); PG8_STAGE(PG8_SA(0, 0), cA, voffA); PG8_STAGE(PG8_SB(0, 1), cB + hstepB, voffB); PG8_STAGE(PG8_SA(0, 1), cA + hstep, voffA);
        if (wr == 1) PG8_BAR;
        PG8_WAIT_V(4); PG8_BAR;
        PG8_STAGE(PG8_SB(1, 0), cB + kstepB, voffB); PG8_STAGE(PG8_SA(1, 0), cA + kstep, voffA); PG8_STAGE(PG8_SB(1, 1), cB + hstepB + kstepB, voffB);
        PG8_WAIT_V(6); PG8_BAR;
    }
    for (;;) {
        const bool has_next = S.next(ui + 1, nxt);
        const char* nA = has_next ? (const char*)g.A + (size_t)nxt.pm * tstep : cA; const char* nB = has_next ? (const char*)g.Bt + (BPAIR ? (size_t)nxt.boff : (size_t)nxt.pn * tstep) : cB;
        for (int t = 0; t < nt; t += 2) {
            const bool last = (t == nt - 2);
            const char* a1 = cA + (size_t)(t + 1) * kstep;
            const char* a2 = last ? nA : cA + (size_t)(t + 2) * kstep; const char* b2 = last ? nB : cB + (size_t)(t + 2) * kstepB;
            const char* a3 = a2 + kstep; const char* b3 = b2 + kstepB;
            if (last && has_next) S.a_ready(nxt);
            if constexpr (SP2) {
            PG8_LDB(B0, 0, 0); PG8_LDB(B1, 0, 1); PG8_SCHED; PG8_LDA(At, 0, 0); PG8_STAGE(PG8_SA(1, 1), a1 + hstep, voffA);
            PG8_WAIT_V(8);
            if constexpr (Side::ON) { if (spend) SD.read(st0, st1, tid, (unsigned)(size_t)lds); }
            PG8_WAIT_L(0); PG8_FIXB(B0); PG8_FIXB(B1);
            if constexpr (Side::ON) { if (spend) { SD.finish(st0, st1, sj - 1, tid); spend = false; } if (sj < SD.njobs) { SD.issue(lds0, sj, tid, wid); ++sj; spend = true; } }
            PG8_BAR; PG8_MMA(0, 0, At, B0); PG8_MMA(0, 1, At, B1); PG8_BAR; PG8_SCHED;
            PG8_LDA(At, 0, 1); PG8_STAGE(PG8_SB(0, 0), b2, voffB); PG8_STAGE(PG8_SB(0, 1), b2 + hstepB, voffB); PG8_STAGE(PG8_SA(0, 0), a2, voffA);
            PG8_WAIT_V(8); PG8_WAIT_L(0); PG8_BAR; if (!(FP8 && cur.rows <= HALF)) { PG8_MMA(1, 0, At, B0); PG8_MMA(1, 1, At, B1); } PG8_BAR; PG8_SCHED;
            PG8_LDB(B0, 1, 0); PG8_LDB(B1, 1, 1); PG8_SCHED; PG8_LDA(At, 1, 0); PG8_STAGE(PG8_SA(0, 1), a2 + hstep, voffA);
            PG8_WAIT_V(8);
            if constexpr (Side::ON) { if (Side::TWO && spend) SD.read(st0, st1, tid, (unsigned)(size_t)lds); }
            PG8_WAIT_L(0); PG8_FIXB(B0); PG8_FIXB(B1);
            if constexpr (Side::ON) { if (Side::TWO) { if (spend) { SD.finish(st0, st1, sj - 1, tid); spend = false; } if (sj < SD.njobs) { SD.issue(lds0, sj, tid, wid); ++sj; spend = true; } } }
            PG8_BAR; PG8_MMA(0, 0, At, B0); PG8_MMA(0, 1, At, B1); PG8_BAR; PG8_SCHED;
            PG8_LDA(At, 1, 1); PG8_STAGE(PG8_SB(1, 0), b3, voffB); PG8_STAGE(PG8_SB(1, 1), b3 + hstepB, voffB); PG8_STAGE(PG8_SA(1, 0), a3, voffA);
            PG8_WAIT_V(8); PG8_WAIT_L(0); PG8_BAR; if (!(FP8 && cur.rows <= HALF)) { PG8_MMA(1, 0, At, B0); PG8_MMA(1, 1, At, B1); } PG8_BAR; PG8_SCHED;
            } else {
            PG8_LDB(B0, 0, 0); PG8_SCHED; PG8_LDA(At, 0, 0); PG8_STAGE(PG8_SA(1, 1), a1 + hstep, voffA);
            PG8_WAIT_L(8); PG8_BAR; PG8_WAIT_L(0); PG8_MMA(0, 0, At, B0); PG8_BAR; PG8_SCHED;
            PG8_LDB(B1, 0, 1); PG8_STAGE(PG8_SB(0, 0), b2, voffB);
            PG8_BAR; PG8_WAIT_L(0); PG8_MMA(0, 1, At, B1); PG8_BAR;
            PG8_LDA(At, 0, 1); PG8_STAGE(PG8_SA(0, 0), a2, voffA);
            PG8_BAR; PG8_WAIT_L(0); PG8_MMA(1, 0, At, B0); PG8_BAR; PG8_SCHED;
            PG8_STAGE(PG8_SB(0, 1), b2 + hstepB, voffB);
            PG8_WAIT_V(6); PG8_BAR; PG8_MMA(1, 1, At, B1); PG8_BAR;
            PG8_LDB(B0, 1, 0); PG8_SCHED; PG8_LDA(At, 1, 0); PG8_STAGE(PG8_SA(0, 1), a2 + hstep, voffA);
            PG8_WAIT_L(8); PG8_BAR; PG8_WAIT_L(0); PG8_MMA(0, 0, At, B0); PG8_BAR; PG8_SCHED;
            PG8_LDB(B1, 1, 1); PG8_STAGE(PG8_SB(1, 0), b3, voffB);
            PG8_BAR; PG8_WAIT_L(0); PG8_MMA(0, 1, At, B1); PG8_BAR;
            PG8_LDA(At, 1, 1); PG8_STAGE(PG8_SA(1, 0), a3, voffA);
            PG8_BAR; PG8_WAIT_L(0); PG8_MMA(1, 0, At, B0); PG8_BAR; PG8_SCHED;
            PG8_STAGE(PG8_SB(1, 1), b3 + hstepB, voffB);
            PG8_WAIT_V(6); PG8_BAR; PG8_MMA(1, 1, At, B1); PG8_BAR;
            }
        }
        if constexpr (ALIGN_EPI) { if (wr == 0) PG8_BAR; }
        if constexpr (FP8) asm volatile("s_nop 15\n\ts_nop 15" ::: "memory");
        if constexpr (!Epi::AFTER_DRAIN) { int tz = threadIdx.x; asm volatile("" : "+v"(tz));
            const int wz = __builtin_amdgcn_readfirstlane(tz >> 6), lz = tz & 63; E(acc, cur, wz >> 2, wz & 3, lz & 15, lz >> 4); S.done(cur); }
        if (!has_next) break;
#pragma unroll
        for (int a = 0; a < 2; ++a)
#pragma unroll
            for (int b = 0; b < 2; ++b)
#pragma unroll
                for (int m = 0; m < 4; ++m)
#pragma unroll
                    for (int n = 0; n < 2; ++n) acc[a][b][m][n] = (f32x4){0.f, 0.f, 0.f, 0.f};
        cur = nxt; cA = nA; cB = nB; ++ui;
        if constexpr (ALIGN_EPI) { if (wr == 1) PG8_BAR; }
    }
    PG8_WAIT_V(0);
    if constexpr (!ALIGN_EPI) { if (wr == 0) PG8_BAR; }
    PG8_BAR;
    if constexpr (Side::ON) { if (spend) { SD.read(st0, st1, tid, (unsigned)(size_t)lds); PG8_WAIT_L(0); SD.finish(st0, st1, sj - 1, tid); spend = false; } }
    if constexpr (Epi::AFTER_DRAIN) { E.fused(acc, cur, wr, wc, fr, fq, lds, wid, lane); S.done(cur); }
#undef PG8_SA
#undef PG8_SB
#undef PG8_STAGE
#undef PG8_LDA
#undef PG8_LDB
#undef PG8_TRA
#undef PG8_FIXB
#undef PG8_MMA
#undef PG8_WAIT_V
#undef PG8_WAIT_L
#undef PG8_BAR
#undef PG8_SCHED
}
}
#define GAS __attribute__((address_space(1)))
#define LAS __attribute__((address_space(3)))
typedef unsigned short bf16;
typedef unsigned v4u __attribute__((ext_vector_type(4)));
typedef float f32x4 __attribute__((ext_vector_type(4)));
typedef short bf16x8 __attribute__((ext_vector_type(8)));
typedef GAS unsigned gu32;
typedef GAS unsigned long long gu64;
#define RLX_AGENT __ATOMIC_RELAXED, __HIP_MEMORY_SCOPE_AGENT
#define LDS_WAIT() asm volatile("s_waitcnt lgkmcnt(0)" ::: "memory")
#define VM_WAIT() asm volatile("s_waitcnt vmcnt(0)" ::: "memory")
__device__ __forceinline__ unsigned long long rt() { return __builtin_amdgcn_s_memrealtime(); }
__device__ __forceinline__ unsigned f2bf(float f) { unsigned u = __builtin_bit_cast(unsigned, f); return (u + 0x7fffu + ((u >> 16) & 1u)) >> 16; }
__device__ __forceinline__ unsigned pk2(float lo, float hi) { return f2bf(lo) | (f2bf(hi) << 16); }

#define XB_TMO      128
#define XB_XCNT(j)  (256  + 64 * (j))
#define XB_XSUB(j)  (1280 + 64 * (j))
#define XB_XGEN(j)  (2304 + 64 * (j))
#define XB_TOP      3328
#define XB_TOPGEN   3392
#define XCD_BAR_WORDS 3456
#define XB_SPIN_CAP (1u << 18)

__device__ __forceinline__ unsigned xb_ld(unsigned* p)              { return __hip_atomic_load(p, __ATOMIC_RELAXED, __HIP_MEMORY_SCOPE_AGENT); }
__device__ __forceinline__ unsigned xb_add(unsigned* p, unsigned v) { return __hip_atomic_fetch_add(p, v, __ATOMIC_RELAXED, __HIP_MEMORY_SCOPE_AGENT); }
__device__ __forceinline__ unsigned xb_xcc_id() { return (unsigned)__builtin_amdgcn_s_getreg((3 << 11) | 20) & 0xFu; }
#define XB_SPIN(cond, bar) do { unsigned _sp = 0; while (cond) { __builtin_amdgcn_s_sleep(1); \
    if ((++_sp & 255u) == 0u) { if (xb_ld(&(bar)[XB_TMO])) break; if (_sp > XB_SPIN_CAP) { atomicAdd(&(bar)[XB_TMO], 1u); break; } } } } while (0)

struct XcdBarrier {
    unsigned* bar; unsigned x;
    volatile LAS unsigned* st;
};

__device__ __forceinline__ XcdBarrier xcd_barrier_post(unsigned* bar, volatile LAS unsigned* st) {
    XcdBarrier b; b.bar = bar; b.x = xb_xcc_id(); b.st = st;
    if (threadIdx.x == 0) (void)xb_add(&bar[XB_XCNT(b.x)], 1u);
    return b;
}
__device__ __forceinline__ void xcd_barrier_complete(unsigned* bar, unsigned x, unsigned& nloc, unsigned& nx) {
    const unsigned G = gridDim.x * gridDim.y * gridDim.z;
    unsigned sum, cnt, mine, sp = 0u;
    for (;;) {
        sum = 0u; cnt = 0u; mine = 0u;
#pragma unroll
        for (unsigned j = 0; j < 16; ++j) { const unsigned c = xb_ld(&bar[XB_XCNT(j)]); sum += c; cnt += (c > 0u) ? 1u : 0u; mine = (j == x) ? c : mine; }
        if (sum == G) break;
        __builtin_amdgcn_s_sleep(1);
        if ((++sp & 255u) == 0u) { if (xb_ld(&bar[XB_TMO])) break; if (sp > XB_SPIN_CAP) { atomicAdd(&bar[XB_TMO], 1u); break; } }
    }
    nloc = mine > 0u ? mine : 1u; nx = cnt > 0u ? cnt : 1u;
}

__device__ __forceinline__ void xcd_barrier(const XcdBarrier& b) {
    asm volatile("s_waitcnt vmcnt(0)" ::: "memory");
    __syncthreads();
    if (threadIdx.x == 0) {
        unsigned* bar = b.bar;
        __builtin_amdgcn_s_waitcnt(0);
        unsigned nloc = b.st[0], nx = b.st[1];
        if (nloc == 0u) { xcd_barrier_complete(bar, b.x, nloc, nx); b.st[0] = nloc; b.st[1] = nx; }
        const unsigned old = xb_add(&bar[XB_XSUB(b.x)], 1u);
        const unsigned gen = old / nloc;
        if (old + 1u == (gen + 1u) * nloc) {
            __builtin_amdgcn_fence(__ATOMIC_RELEASE, "agent");
            asm volatile("s_waitcnt vmcnt(0)" ::: "memory");
            const unsigned og = xb_add(&bar[XB_TOP], 1u);
            const unsigned tg = og / nx;
            if (og + 1u == (tg + 1u) * nx) xb_add(&bar[XB_TOPGEN], 1u);
            else XB_SPIN(xb_ld(&bar[XB_TOPGEN]) == tg, bar);
            __builtin_amdgcn_fence(__ATOMIC_ACQUIRE, "agent");
            xb_add(&bar[XB_XGEN(b.x)], 1u);
            asm volatile("s_waitcnt vmcnt(0)" ::: "memory");
        } else {
            XB_SPIN(xb_ld(&bar[XB_XGEN(b.x)]) == gen, bar);
            __builtin_amdgcn_fence(__ATOMIC_ACQUIRE, "agent");
            asm volatile("s_waitcnt vmcnt(0)" ::: "memory");
        }
    }
    __syncthreads();
}

constexpr int NB = 4, SEQ = 2048, DM = 2048, NTOK = NB * SEQ, INC = 6144, CW = 512, AW = 1536, NH = 24, HD = 64, NE = 32, TOPK = 4, DE = 2048;
constexpr int QOFF = 1536, KOFF = 3072, VOFF = 4608;
constexpr int MAXSLOT = NE * NTOK;
constexpr float EPS = 1e-5f;
typedef unsigned u32x2v __attribute__((ext_vector_type(2)));
constexpr int NWAVES = 8;
#ifndef MK_N_LAUNCHES
#define MK_N_LAUNCHES 1
#endif
#ifndef PROBE_MASK
#define PROBE_MASK 0
#endif
#define REPS(k) (((PROBE_MASK >> (k)) & 1) ? 2 : 1)
constexpr int NPH = 10;

constexpr size_t MiB = 1u << 20;
constexpr size_t WS_CTL = 0, CTL_ZERO_BYTES = 1 * MiB;
constexpr size_t WS_ROPE = 1 * MiB;
constexpr size_t WS_TOKE = 2 * MiB, WS_TOKR = WS_TOKE + 128 * 1024, WS_TOKG = WS_TOKR + 128 * 1024;
constexpr size_t WS_LIST = 3 * MiB;
constexpr size_t WS_WIN = 8 * MiB;
constexpr size_t WS_WO = 32 * MiB;
constexpr size_t WS_XN = 40 * MiB;
constexpr size_t WS_PROJ = 72 * MiB;
constexpr size_t WS_YATT = 168 * MiB;
constexpr size_t WS_MIXED = 192 * MiB;
constexpr size_t WS_X1 = 224 * MiB;
constexpr size_t WS_XN2 = 288 * MiB;
constexpr size_t WS_XS = 320 * MiB;
constexpr size_t WS_ACT = 832 * MiB;
constexpr size_t WS_Y = 1344 * MiB;
constexpr size_t WS_WGU = 2368 * MiB;
constexpr size_t WS_WDN = 2624 * MiB;
constexpr size_t WS_END = 2752 * MiB;
constexpr int CW_TMO = 0, CW_CODE = 1;
constexpr int CW_BAR = 4096;
constexpr int CW_CNT = 8192;
constexpr int CW_ATTQ = 12288;
constexpr int CW_CONVQ = 12288 + 4096;
constexpr int CW_P1DONE = 12288 + 8192;
#ifndef ATT_ITEM
#define ATT_ITEM item2
#endif
#ifndef ATT_NOFALL
#define ATT_NOFALL 1
#endif
#ifndef ATT_JOIN
#define ATT_JOIN 0
#endif
#ifndef SIDE_CONV
#define SIDE_CONV 2
#endif
#ifndef SPLIT_P1
#define SPLIT_P1 0
#endif
#ifndef FUSED2
#define FUSED2 0
#endif
#ifndef FUSED_CONV
#define FUSED_CONV 0
#endif
#ifndef ATT_WAVES
#define ATT_WAVES 5
#endif
constexpr int RING_BYTES = 131072;
constexpr int LDSCTL_OFF = RING_BYTES;
constexpr int MISC_OFF = LDSCTL_OFF + 320;
constexpr int TAB_TS = LDSCTL_OFF + 1024;
constexpr int TAB_CN = LDSCTL_OFF + 1024 + 256;
constexpr int PART_OFF = RING_BYTES + 16384;
constexpr int LDS_BYTES = 163840;

__device__ __forceinline__ float wave_sum(float v) {
#pragma unroll
    for (int o = 1; o < 64; o <<= 1) v += __shfl_xor(v, o);
    return v;
}
__device__ __forceinline__ float bf_lo(unsigned w) { return __uint_as_float(w << 16); }
__device__ __forceinline__ float bf_hi(unsigned w) { return __uint_as_float(w & 0xffff0000u); }

__device__ __forceinline__ void p0_transpose_item(const float* W, int N, int K, bf16* WT, int k0, int n0, int out_row0, LAS float* scr, int lane) {
#pragma unroll 8
    for (int i = 0; i < 32; ++i) { const int kk = 2 * i + (lane >> 5); scr[kk * 33 + (lane & 31)] = __builtin_nontemporal_load(W + (size_t)(k0 + kk) * N + n0 + (lane & 31)); }
    LDS_WAIT(); asm volatile("" ::: "memory");
    const int c = lane & 7;
#pragma unroll
    for (int j = 0; j < 4; ++j) { const int n = (lane >> 3) + 8 * j; const LAS float* s = scr + (8 * c) * 33 + n;
        v4u o; o.x = pk2(s[0 * 33], s[1 * 33]); o.y = pk2(s[2 * 33], s[3 * 33]); o.z = pk2(s[4 * 33], s[5 * 33]); o.w = pk2(s[6 * 33], s[7 * 33]);
        *(GAS v4u*)(WT + (size_t)(out_row0 + n) * K + k0 + 8 * c) = o; }
    LDS_WAIT(); asm volatile("" ::: "memory");
}

__device__ __forceinline__ void p0_transpose_item_fp8(const float* W, int N, int K, unsigned char* WT, int k0, int n0, int out_row0, float scale, LAS float* scr, int lane) {
#pragma unroll 8
    for (int i = 0; i < 32; ++i) { const int kk = 2 * i + (lane >> 5); scr[kk * 33 + (lane & 31)] = W[(size_t)(k0 + kk) * N + n0 + (lane & 31)]; }
    LDS_WAIT(); asm volatile("" ::: "memory");
    const int c = lane & 3;
#pragma unroll
    for (int j = 0; j < 2; ++j) { const int n = (lane >> 2) + 16 * j; const LAS float* s = scr + (16 * c) * 33 + n;
        v4u o;
        o.x = pg8::pk4_fp8(scale * s[0 * 33], scale * s[1 * 33], scale * s[2 * 33], scale * s[3 * 33]);
        o.y = pg8::pk4_fp8(scale * s[4 * 33], scale * s[5 * 33], scale * s[6 * 33], scale * s[7 * 33]);
        o.z = pg8::pk4_fp8(scale * s[8 * 33], scale * s[9 * 33], scale * s[10 * 33], scale * s[11 * 33]);
        o.w = pg8::pk4_fp8(scale * s[12 * 33], scale * s[13 * 33], scale * s[14 * 33], scale * s[15 * 33]);
        *(GAS v4u*)(WT + (size_t)(out_row0 + n) * K + k0 + 16 * c) = o; }
    LDS_WAIT(); asm volatile("" ::: "memory");
}

__device__ __forceinline__ unsigned pk4_fp8_nc(float a, float b, float c, float d) { int w = 0; w = __builtin_amdgcn_cvt_pk_fp8_f32(a, b, w, false); w = __builtin_amdgcn_cvt_pk_fp8_f32(c, d, w, true); return (unsigned)w; }
struct ConvDesc { const float* src; unsigned char* dstb; int N, isdn; };
constexpr int CV_NG = 16, PER_E = 256 + 128, NCONV = 32 * PER_E;
__device__ __forceinline__ ConvDesc conv_decode(int it, const float* w_gu, const float* w_dn, unsigned char* WGU, unsigned char* WDN, int lane) {
    const int e = it / PER_E, r = it - e * PER_E; ConvDesc d;
    if (r < 256) { const int kp0 = 4 * r; d.N = 4096; d.isdn = 0; d.src = w_gu + (size_t)e * 2048 * 4096 + (size_t)(2 * kp0) * 4096 + 4 * lane; d.dstb = WGU + (size_t)e * 1024 * 8192 + (size_t)kp0 * 8192 + 8 * lane; }
    else { const int kp0 = 8 * (r - 256); d.N = 2048; d.isdn = 1; d.src = w_dn + (size_t)e * 2048 * 2048 + (size_t)(2 * kp0) * 2048 + 4 * lane; d.dstb = WDN + (size_t)e * 1024 * 4096 + (size_t)kp0 * 4096 + 8 * lane; }
    return d;
}
#define CV_LOAD(R, D, g) do { const int ro_ = (D).isdn ? 4 * ((g) >> 3) : 0, co_ = (D).isdn ? 256 * ((g) & 7) : 256 * (g); \
        _Pragma("unroll") for (int t_ = 0; t_ < 4; ++t_) _Pragma("unroll") for (int i_ = 0; i_ < 2; ++i_) R[2 * t_ + i_] = __builtin_nontemporal_load((const GAS f32x4*)((D).src + (size_t)(2 * (ro_ + t_) + i_) * (D).N + co_)); } while (0)
#define CV_PROC(R, D, g) do { const int ro_ = (D).isdn ? 4 * ((g) >> 3) : 0, co_ = (D).isdn ? 256 * ((g) & 7) : 256 * (g); \
        _Pragma("unroll") for (int t_ = 0; t_ < 4; ++t_) { u32x2v o_; \
            o_.x = pk4_fp8_nc(pg8::FP8_W_SCALE * R[2 * t_][0], pg8::FP8_W_SCALE * R[2 * t_ + 1][0], pg8::FP8_W_SCALE * R[2 * t_][1], pg8::FP8_W_SCALE * R[2 * t_ + 1][1]); \
            o_.y = pk4_fp8_nc(pg8::FP8_W_SCALE * R[2 * t_][2], pg8::FP8_W_SCALE * R[2 * t_ + 1][2], pg8::FP8_W_SCALE * R[2 * t_][3], pg8::FP8_W_SCALE * R[2 * t_ + 1][3]); \
            __builtin_nontemporal_store(o_, (GAS u32x2v*)((D).dstb + (size_t)(ro_ + t_) * (D).N * 2 + 2 * co_)); } } while (0)

namespace att {
typedef short s16x8 __attribute__((ext_vector_type(8)));
typedef short s16x4 __attribute__((ext_vector_type(4)));
typedef float f32x16 __attribute__((ext_vector_type(16)));
typedef unsigned u32x4 __attribute__((ext_vector_type(4)));
constexpr int VP = 144;
constexpr int WAVE_LDS = 32 * VP;
constexpr float C2 = 0.125f * 1.4426950408889634f;
constexpr int NITEMS = 16 * NB * NH * 4;
typedef short v4i16_t __attribute__((ext_vector_type(4)));
__device__ __forceinline__ s16x4 vtr(LAS const char* p) { return __builtin_bit_cast(s16x4, __builtin_amdgcn_ds_read_tr16_b64_v4i16((LAS v4i16_t*)p)); }

struct TileD { int abase, kp_off, kp_mul, W, mod4, sel; };
__device__ __forceinline__ TileD tile_desc(int u, int n1, int n2, int first1, int first2, int m0, int r4) {
    TileD d;
    if (u < n1) { d.abase = 4 * m0 - 128 + 32 * (first1 + u); d.kp_off = 0; d.kp_mul = 1; d.W = 128; d.mod4 = 0; d.sel = 0; }
    else if (u < n1 + n2) { d.abase = m0 - 128 + 32 * (first2 + u - n1); d.kp_off = r4; d.kp_mul = 4; d.W = 128; d.mod4 = 0; d.sel = 1; }
    else { d.abase = 32 * (u - n1 - n2); d.kp_off = r4; d.kp_mul = 4; d.W = 0x7fffffff; d.mod4 = 1; d.sel = 1; }
    return d;
}
#define ATT_LOADT(KF, VF, D) do { _Pragma("unroll") for (int j_ = 0; j_ < 4; ++j_) { const int pos_ = (D).kp_off + (D).kp_mul * ((D).abase + 8 * j_ + (lane >> 3)); \
        KF[j_] = *(const GAS u32x4*)(Kb + (size_t)pos_ * INC + 8 * (lane & 7)); VF[j_] = *(const GAS u32x4*)(Vb + (size_t)pos_ * INC + 8 * (lane & 7)); } } while (0)

template <int PMODE = 0>
__device__ __forceinline__ void item(int it, const bf16* PROJ, bf16* YATT, LAS char* vl, int lane) {
    const int bh = it >> 6, jj = it & 63; const int b = bh / NH, head = bh - b * NH, mb = 15 - (jj >> 2), r4 = jj & 3;
    const int m0 = mb * 32, q = lane & 31, h = lane >> 5;
    const int qpos = r4 + 4 * (m0 + q);
    const bf16* base = PROJ + (size_t)b * SEQ * INC;
    const bf16* Kb = base + KOFF + head * HD; const bf16* Vb = base + VOFF + head * HD;
    const int first1 = (mb == 0) ? 4 : 0, first2 = (mb < 4) ? 4 - mb : 0, n1 = 8 - first1, n2 = 5 - first2, ntile = n1 + n2 + mb + 1;
    u32x4 kA[4], vA[4], kB[4], vB[4];
    { const TileD d0 = tile_desc(0, n1, n2, first1, first2, m0, r4); ATT_LOADT(kA, vA, d0); }
    s16x8 qf[4];
    { const bf16* qp = base + (size_t)qpos * INC + QOFF + head * HD + 8 * h;
#pragma unroll
      for (int d0 = 0; d0 < 4; ++d0) qf[d0] = __builtin_bit_cast(s16x8, *(const GAS u32x4*)(qp + 16 * d0)); }
    f32x16 o0 = {}, o1 = {}; float mrun = -1e30f, lrun = 0.f;
    const int g = lane >> 4, qq = (lane & 15) >> 2, pp = lane & 3;
    LAS const char* vb = vl + (4 * h + qq) * VP + (16 * (g & 1) + 4 * pp) * 2;
    LAS char* kl = vl + WAVE_LDS;
    LAS u32x4* vd = (LAS u32x4*)(vl + (lane >> 3) * VP + (lane & 7) * 16);
    LAS u32x4* kd = (LAS u32x4*)(kl + (lane >> 3) * VP + (lane & 7) * 16);
    LAS const char* kfp = kl + (lane & 31) * VP + h * 16;
#pragma unroll 1
    for (int u = 0; u < ntile; ++u) {
        const TileD d = tile_desc(u, n1, n2, first1, first2, m0, r4);
        if (PMODE != 1) { const int un = (u + 1 < ntile) ? u + 1 : u; const TileD dn = tile_desc(un, n1, n2, first1, first2, m0, r4); ATT_LOADT(kB, vB, dn); }
#pragma unroll
        for (int j = 0; j < 4; ++j) { *(LAS u32x4*)((LAS char*)kd + 8 * j * VP) = kA[j]; *(LAS u32x4*)((LAS char*)vd + 8 * j * VP) = vA[j]; }
        if (PMODE != 2) {
        f32x16 s = {};
#pragma unroll
        for (int d0 = 0; d0 < 4; ++d0) s = __builtin_amdgcn_mfma_f32_32x32x16_bf16(*(const LAS s16x8*)(kfp + 32 * d0), qf[d0], s, 0, 0, 0);
        const int bq = d.sel ? (m0 + q) : qpos;
        const int t0 = bq - d.abase - 4 * h; const unsigned W = (unsigned)d.W; const int m4 = d.mod4 ? 3 : 0;
        float mx = -INFINITY;
#pragma unroll
        for (int r = 0; r < 16; ++r) { const int dd = t0 - ((r & 3) + 8 * (r >> 2));
            const bool ok = ((unsigned)dd <= W) && ((dd & m4) == 0);
            s[r] = ok ? s[r] : -INFINITY; mx = fmaxf(mx, s[r]); }
        mx = fmaxf(mx, __shfl_xor(mx, 32));
        const float mnew = fmaxf(mrun, mx), alpha = __builtin_amdgcn_exp2f(mrun - mnew); mrun = mnew;
        float ps = 0.f;
#pragma unroll
        for (int r = 0; r < 16; ++r) { s[r] = __builtin_amdgcn_exp2f(s[r] - mnew); ps += s[r]; }
        lrun = lrun * alpha + ps;
#pragma unroll
        for (int r = 0; r < 16; ++r) { o0[r] *= alpha; o1[r] *= alpha; }
        u32x4 p0, p1;
        p0.x = pk2(s[0], s[1]); p0.y = pk2(s[2], s[3]); p0.z = pk2(s[4], s[5]); p0.w = pk2(s[6], s[7]);
        p1.x = pk2(s[8], s[9]); p1.y = pk2(s[10], s[11]); p1.z = pk2(s[12], s[13]); p1.w = pk2(s[14], s[15]);
        const s16x8 pf0 = __builtin_bit_cast(s16x8, p0), pf1 = __builtin_bit_cast(s16x8, p1);
#pragma unroll
        for (int sstep = 0; sstep < 2; ++sstep) {
#pragma unroll
            for (int dh = 0; dh < 2; ++dh) {
                const s16x4 lo = vtr(vb + (16 * sstep) * VP + dh * 64), hi = vtr(vb + (16 * sstep + 8) * VP + dh * 64);
                const s16x8 vf = (s16x8){lo[0], lo[1], lo[2], lo[3], hi[0], hi[1], hi[2], hi[3]};
                if (dh == 0) o0 = __builtin_amdgcn_mfma_f32_32x32x16_bf16(vf, sstep ? pf1 : pf0, o0, 0, 0, 0);
                else         o1 = __builtin_amdgcn_mfma_f32_32x32x16_bf16(vf, sstep ? pf1 : pf0, o1, 0, 0, 0);
            }
        }
        }
        if (PMODE == 1) continue;
#pragma unroll
        for (int c = 0; c < 4; ++c) { kA[c] = kB[c]; vA[c] = vB[c]; }
    }
    const float inv = 1.0f / (lrun + __shfl_xor(lrun, 32));
    bf16* orow = YATT + (size_t)(b * SEQ + qpos) * AW + head * HD + 4 * h;
#pragma unroll
    for (int gq = 0; gq < 4; ++gq) {
        u32x2v a, c; a.x = pk2(o0[4 * gq] * inv, o0[4 * gq + 1] * inv); a.y = pk2(o0[4 * gq + 2] * inv, o0[4 * gq + 3] * inv);
        c.x = pk2(o1[4 * gq] * inv, o1[4 * gq + 1] * inv); c.y = pk2(o1[4 * gq + 2] * inv, o1[4 * gq + 3] * inv);
        *(u32x2v*)(orow + 8 * gq) = a; *(u32x2v*)(orow + 32 + 8 * gq) = c; }
}

__device__ __forceinline__ int krp(int key) { return (key & 0x16) | ((key >> 3) & 1) | ((key & 1) << 3); }
__device__ __forceinline__ void item2(int it, const bf16* PROJ, bf16* YATT, LAS char* wl, int lane) {
    const int bh = it >> 6, jj = it & 63; const int b = bh / NH, head = bh - b * NH, mb = 15 - (jj >> 2), r4 = jj & 3;
    const int m0 = mb * 32, q = lane & 31, h = lane >> 5;
    const int qpos = r4 + 4 * (m0 + q), bq2 = m0 + q;
    const bf16* base = PROJ + (size_t)b * SEQ * INC;
    const bf16* Kb = base + KOFF + head * HD; const bf16* Vb = base + VOFF + head * HD;
    const int first1 = (mb == 0) ? 4 : 0, first2 = (mb < 4) ? 4 - mb : 0, n1 = 8 - first1, n2 = 5 - first2, ntile = n1 + n2 + mb + 1, npair = (ntile + 1) >> 1;
    u32x4 k0[4], v0[4], k1[4], v1[4];
    { const TileD d0 = tile_desc(0, n1, n2, first1, first2, m0, r4); ATT_LOADT(k0, v0, d0); }
    { const TileD d1 = tile_desc(ntile > 1 ? 1 : 0, n1, n2, first1, first2, m0, r4); ATT_LOADT(k1, v1, d1); }
    s16x8 qf[4];
    { const bf16* qp = base + (size_t)qpos * INC + QOFF + head * HD + 8 * h;
#pragma unroll
      for (int d0 = 0; d0 < 4; ++d0) qf[d0] = __builtin_bit_cast(s16x8, *(const GAS u32x4*)(qp + 16 * d0)); }
    f32x16 o0 = {}, o1 = {}; float mrun = -1e30f, lrun = 0.f;
    const int g = lane >> 4, qq = (lane & 15) >> 2, pp = lane & 3;
    int kws[4];
#pragma unroll
    for (int j = 0; j < 4; ++j) { const int key = 8 * j + (lane >> 3); kws[j] = krp(key) * 128 + (((lane & 7) ^ (key & 7)) << 4); }
    const int vws = (lane >> 3) * 128 + (lane & 7) * 16;
    const int kfr = krp(q) * 128, kx = q & 7;
    const int vfr = (4 * h + qq) * 128 + (16 * (g & 1) + 4 * pp) * 2;
#define ATT2_MASK(S, D, T0) do { if ((D).mod4) { _Pragma("unroll") for (int r = 0; r < 16; ++r) { const int dd = (T0) - ((r & 3) + 8 * (r >> 2)); S[r] = (dd >= 0 && (dd & 3) == 0) ? S[r] : -INFINITY; mx = fmaxf(mx, S[r]); } } \
        else { const unsigned W_ = (unsigned)(D).W; _Pragma("unroll") for (int r = 0; r < 16; ++r) { const int dd = (T0) - ((r & 3) + 8 * (r >> 2)); S[r] = ((unsigned)dd <= W_) ? S[r] : -INFINITY; mx = fmaxf(mx, S[r]); } } } while (0)
#pragma unroll 1
    for (int p = 0; p < npair; ++p) {
        const bool nul1 = (2 * p + 1 >= ntile);
        const TileD dA = tile_desc(2 * p, n1, n2, first1, first2, m0, r4), dB = tile_desc(nul1 ? 2 * p : 2 * p + 1, n1, n2, first1, first2, m0, r4);
#pragma unroll
        for (int j = 0; j < 4; ++j) { *(LAS u32x4*)(wl + kws[j]) = k0[j]; *(LAS u32x4*)(wl + 4096 + vws + 1024 * j) = v0[j]; *(LAS u32x4*)(wl + 8192 + kws[j]) = k1[j]; *(LAS u32x4*)(wl + 12288 + vws + 1024 * j) = v1[j]; }
        { const int ua = (2 * p + 2 < ntile) ? 2 * p + 2 : ntile - 1, ub = (2 * p + 3 < ntile) ? 2 * p + 3 : ntile - 1;
          const TileD na = tile_desc(ua, n1, n2, first1, first2, m0, r4), nb = tile_desc(ub, n1, n2, first1, first2, m0, r4); ATT_LOADT(k0, v0, na); ATT_LOADT(k1, v1, nb); }
        f32x16 sA = {}, sB = {};
#pragma unroll
        for (int d0 = 0; d0 < 4; ++d0) { const int co = ((2 * d0 + h) ^ kx) << 4;
            sA = __builtin_amdgcn_mfma_f32_32x32x16_bf16(*(const LAS s16x8*)(wl + kfr + co), qf[d0], sA, 0, 0, 0);
            sB = __builtin_amdgcn_mfma_f32_32x32x16_bf16(*(const LAS s16x8*)(wl + 8192 + kfr + co), qf[d0], sB, 0, 0, 0); }
        const int t0A = (dA.sel ? bq2 : qpos) - dA.abase - 4 * h; const int t0B = nul1 ? -(1 << 20) : ((dB.sel ? bq2 : qpos) - dB.abase - 4 * h);
        float mx = -INFINITY;
        ATT2_MASK(sA, dA, t0A); ATT2_MASK(sB, dB, t0B);
        mx = fmaxf(mx, __shfl_xor(mx, 32));
        const float mnew = fmaxf(mrun, mx), alpha = __builtin_amdgcn_exp2f(mrun - mnew); mrun = mnew;
        float ps = 0.f;
#pragma unroll
        for (int r = 0; r < 16; ++r) { sA[r] = __builtin_amdgcn_exp2f(sA[r] - mnew); sB[r] = __builtin_amdgcn_exp2f(sB[r] - mnew); ps += sA[r] + sB[r]; }
        lrun = lrun * alpha + ps;
#pragma unroll
        for (int r = 0; r < 16; ++r) { o0[r] *= alpha; o1[r] *= alpha; }
        u32x4 pa0, pa1, pb0, pb1;
        pa0.x = pk2(sA[0], sA[1]); pa0.y = pk2(sA[2], sA[3]); pa0.z = pk2(sA[4], sA[5]); pa0.w = pk2(sA[6], sA[7]);
        pa1.x = pk2(sA[8], sA[9]); pa1.y = pk2(sA[10], sA[11]); pa1.z = pk2(sA[12], sA[13]); pa1.w = pk2(sA[14], sA[15]);
        pb0.x = pk2(sB[0], sB[1]); pb0.y = pk2(sB[2], sB[3]); pb0.z = pk2(sB[4], sB[5]); pb0.w = pk2(sB[6], sB[7]);
        pb1.x = pk2(sB[8], sB[9]); pb1.y = pk2(sB[10], sB[11]); pb1.z = pk2(sB[12], sB[13]); pb1.w = pk2(sB[14], sB[15]);
#pragma unroll
        for (int tt = 0; tt < 2; ++tt) { LAS const char* vb = wl + 4096 + 8192 * tt + vfr;
#pragma unroll
            for (int sstep = 0; sstep < 2; ++sstep) { const s16x8 pf = __builtin_bit_cast(s16x8, tt ? (sstep ? pb1 : pb0) : (sstep ? pa1 : pa0));
#pragma unroll
                for (int dh = 0; dh < 2; ++dh) {
                    const s16x4 lo = vtr(vb + (16 * sstep) * 128 + dh * 64), hi = vtr(vb + (16 * sstep + 8) * 128 + dh * 64);
                    const s16x8 vf = (s16x8){lo[0], lo[1], lo[2], lo[3], hi[0], hi[1], hi[2], hi[3]};
                    if (dh == 0) o0 = __builtin_amdgcn_mfma_f32_32x32x16_bf16(vf, pf, o0, 0, 0, 0);
                    else         o1 = __builtin_amdgcn_mfma_f32_32x32x16_bf16(vf, pf, o1, 0, 0, 0); } } }
    }
#undef ATT2_MASK
    const float inv = 1.0f / (lrun + __shfl_xor(lrun, 32));
    bf16* orow = YATT + (size_t)(b * SEQ + qpos) * AW + head * HD + 4 * h;
#pragma unroll
    for (int gq = 0; gq < 4; ++gq) {
        u32x2v a, c; a.x = pk2(o0[4 * gq] * inv, o0[4 * gq + 1] * inv); a.y = pk2(o0[4 * gq + 2] * inv, o0[4 * gq + 3] * inv);
        c.x = pk2(o1[4 * gq] * inv, o1[4 * gq + 1] * inv); c.y = pk2(o1[4 * gq + 2] * inv, o1[4 * gq + 3] * inv);
        *(u32x2v*)(orow + 8 * gq) = a; *(u32x2v*)(orow + 32 + 8 * gq) = c; }
}
}

struct Args { const float* in[15]; float* out; unsigned char* ws; int ph_lo, ph_hi; };
static_assert(sizeof(Args) == 15 * 8 + 8 + 8 + 8, "Args has no padding");

__global__ void __launch_bounds__(NWAVES * 64, 2) fwd(Args args) {
    extern __shared__ __attribute__((aligned(16))) unsigned char lds[];
    LAS unsigned char* L = (LAS unsigned char*)lds;
    volatile LAS unsigned* MISC = (volatile LAS unsigned*)(L + MISC_OFF);
    const int tid = threadIdx.x, lane = tid & 63, wave = __builtin_amdgcn_readfirstlane(tid >> 6);
    const int G = gridDim.x; const int bx = blockIdx.x; const int vcu = (G % 8 == 0) ? (bx % 8) * (G / 8) + bx / 8 : bx;
    unsigned char* ws = args.ws;
    gu32* ctl = (gu32*)(ws + WS_CTL);
    const float* x = args.in[0]; const float* mix_g = args.in[1]; const float* w_in = args.in[2]; const float* conv_w = args.in[3]; const float* conv_g = args.in[4];
    const float* attn_g = args.in[5]; const float* w_out = args.in[6]; const float* ffn_g = args.in[7]; const float* w_router = args.in[8]; const float* b_router = args.in[9];
    const float* w_gu = args.in[10]; const float* b_gu = args.in[11]; const float* w_dn = args.in[12]; const float* b_dn = args.in[13]; const float* fin_g = args.in[14];
    float* out = args.out;
    float* ROPE = (float*)(ws + WS_ROPE); unsigned char* GWF = ws + WS_ROPE + 256 * 1024;
    int* TOKE = (int*)(ws + WS_TOKE); int* TOKR = (int*)(ws + WS_TOKR); float* TOKG = (float*)(ws + WS_TOKG); int* LIST = (int*)(ws + WS_LIST);
    bf16* WIN = (bf16*)(ws + WS_WIN); bf16* WO = (bf16*)(ws + WS_WO); bf16* XN = (bf16*)(ws + WS_XN); bf16* PROJ = (bf16*)(ws + WS_PROJ); bf16* YATT = (bf16*)(ws + WS_YATT);
    bf16* MIXED = (bf16*)(ws + WS_MIXED); float* X1 = (float*)(ws + WS_X1); unsigned char* XN2 = ws + WS_XN2; unsigned char* XS = ws + WS_XS; unsigned char* ACT = ws + WS_ACT;
    bf16* YB = (bf16*)(ws + WS_Y); unsigned char* WGU = ws + WS_WGU; unsigned char* WDN = ws + WS_WDN;

    for (int u = tid; u < (LDS_BYTES - LDSCTL_OFF) / 4; u += NWAVES * 64) ((LAS unsigned*)(L + LDSCTL_OFF))[u] = 0u;
    __syncthreads();
    XcdBarrier bar; bar.bar = (unsigned*)(ctl + CW_BAR); bar.x = 0; bar.st = nullptr;
    if (MK_N_LAUNCHES == 1) bar = xcd_barrier_post((unsigned*)(ctl + CW_BAR), MISC + 8);
    const int lo = args.ph_lo, hi = args.ph_hi;
#define IN(k) (lo <= (k) && (k) < hi)
#define BOTH(k) (IN(k) && IN((k) + 1))
#define GRID_BAR() do { if (MK_N_LAUNCHES == 1) xcd_barrier(bar); } while (0)
    const int gw = vcu * NWAVES + wave, NGW = G * NWAVES;
    const bool side_on = (MK_N_LAUNCHES == 1) && (G == 256) && (SIDE_CONV != 0);

    if (IN(0)) for (int rep = 0; rep < REPS(0); ++rep) {
        LAS float* scr = (LAS float*)(L + wave * 16384);
        constexpr int I_IN = 32 * (INC / 32), I_O = 32 * (DM / 32);
        constexpr int NIT = I_IN + I_O;
        for (int it = gw; it < NIT; it += NGW) {
            int r = it;
            if (r < I_IN) { const int nblk = INC / 32, kb = r / nblk, nb = r % nblk; p0_transpose_item(w_in, INC, DM, WIN, 64 * kb, 32 * nb, 32 * nb, scr, lane); continue; } r -= I_IN;
            { const int nblk = DM / 32, kb = r / nblk, nb = r % nblk; p0_transpose_item(w_out, DM, DM, WO, 64 * kb, 32 * nb, 32 * nb, scr, lane); }
        }
        for (int i = gw * 64 + lane; i < SEQ * 8; i += NGW * 64) { const int pos = i >> 3, f = i & 7;
            const float inv_freq = exp2f(-(float)f * 0.125f * 18.931568569324174f);
            const float ang = (float)pos * inv_freq;
            const double a = (double)ang; const double k = rint(a * 0.15915494309189535); const float red = (float)(a - k * 6.283185307179586);
            ROPE[pos * 16 + f] = cosf(red); ROPE[pos * 16 + 8 + f] = sinf(red); }
        for (int i = gw * 64 + lane; i < 64 * 2 * 64; i += NGW * 64) { const int ln = i & 63, eb = (i >> 6) & 1, ks = i >> 7; const int e = 16 * eb + (ln & 15), k0 = 32 * ks + 8 * (ln >> 4);
            unsigned hi[4], lo[4];
#pragma unroll
            for (int j = 0; j < 4; ++j) { const float v0 = w_router[(size_t)(k0 + 2 * j) * NE + e] * ffn_g[k0 + 2 * j], v1 = w_router[(size_t)(k0 + 2 * j + 1) * NE + e] * ffn_g[k0 + 2 * j + 1];
                const unsigned h0 = f2bf(v0), h1 = f2bf(v1); hi[j] = h0 | (h1 << 16); lo[j] = pk2(v0 - __uint_as_float(h0 << 16), v1 - __uint_as_float(h1 << 16)); }
            v4u* dst = (v4u*)GWF + ((size_t)(ks * 2 + eb) * 2) * 64 + ln; dst[0] = (v4u){hi[0], hi[1], hi[2], hi[3]}; dst[64] = (v4u){lo[0], lo[1], lo[2], lo[3]}; }
        for (int m = gw; m < NTOK; m += NGW) {
            const GAS f32x4* xr = (const GAS f32x4*)(x + (size_t)m * DM) + lane; const GAS f32x4* gr = (const GAS f32x4*)mix_g + lane;
            f32x4 v[8]; float s = 0.f;
#pragma unroll
            for (int j = 0; j < 8; ++j) { v[j] = xr[64 * j]; s += (v[j].x * v[j].x + v[j].y * v[j].y) + (v[j].z * v[j].z + v[j].w * v[j].w); }
            const float rstd = 1.0f / sqrtf(wave_sum(s) * (1.0f / DM) + EPS);
            GAS u32x2v* o8 = (GAS u32x2v*)(XN + (size_t)m * DM) + lane;
#pragma unroll
            for (int j = 0; j < 8; ++j) { const f32x4 gg = gr[64 * j]; u32x2v o; o.x = pk2(v[j].x * rstd * gg.x, v[j].y * rstd * gg.y); o.y = pk2(v[j].z * rstd * gg.z, v[j].w * rstd * gg.w); o8[64 * j] = o; }
        }
        if (BOTH(0)) GRID_BAR();
    }

    const int ga = (side_on && (SIDE_CONV & 1)) ? 16 : 0, gb = (side_on && (SIDE_CONV & 2)) ? 32 : 0;
    const int cv_lo = ga < gb ? ga : gb, cv_hi = ga < gb ? gb : ga, cv_pn = ga < gb ? 256 : 128, cv_po = ga < gb ? 0 : 256;
    const int nconv_eff = (cv_hi - cv_lo) * cv_pn + (NE - cv_hi) * PER_E;
#define CV_MAP(ci) ((ci) < (cv_hi - cv_lo) * cv_pn ? (cv_lo + (ci) / cv_pn) * PER_E + cv_po + (ci) % cv_pn : (cv_hi + ((ci) - (cv_hi - cv_lo) * cv_pn) / PER_E) * PER_E + ((ci) - (cv_hi - cv_lo) * cv_pn) % PER_E)
#define RUN_P2(ATTW, QA, QC, TRIED0, STOPW, STOPN) do { \
        LAS char* vl = (LAS char*)(L + wave * 16384); \
        LAS unsigned char* T = L + wave * 16384; \
        int mode = (wave < (ATTW)) ? 0 : 1, tried = (TRIED0), aq = 0; const int xcc = (int)xb_xcc_id() & 7; \
        while (tried < 2) { \
            if (mode == 0) { \
                  \
                bool got = false; \
                while (aq < 8) { const int qx = (xcc + aq) & 7; int idx = 0; if (lane == 0) idx = (int)__hip_atomic_fetch_add(ctl + (QA) + 16 * qx, 1u, __ATOMIC_RELAXED, __HIP_MEMORY_SCOPE_AGENT); \
                    idx = __builtin_amdgcn_readfirstlane(idx); \
                    if (idx < 768) { const int it = 64 * (qx + 8 * (idx >> 6)) + (idx & 63); __builtin_amdgcn_s_setprio(3); att::ATT_ITEM(it, PROJ, YATT, vl, lane); __builtin_amdgcn_s_setprio(0); got = true; break; } \
                    ++aq; } \
                if (got) continue; \
            } else { \
                 \
                int it = 0; if (lane == 0) it = (int)__hip_atomic_fetch_add(ctl + (QC), 1u, __ATOMIC_RELAXED, __HIP_MEMORY_SCOPE_AGENT); \
                it = __builtin_amdgcn_readfirstlane(it); \
                if (it < nconv_eff) { \
                    ConvDesc cur = conv_decode(CV_MAP(it), w_gu, w_dn, WGU, WDN, lane); \
                    f32x4 ra[8], rb[8]; \
                    CV_LOAD(ra, cur, 0); \
                    bool stop = false; \
                    for (;;) { \
                        int nx = nconv_eff; if (!stop && lane == 0) nx = (int)__hip_atomic_fetch_add(ctl + (QC), 1u, __ATOMIC_RELAXED, __HIP_MEMORY_SCOPE_AGENT); \
                        unsigned sv = 0u; if ((STOPW) >= 0) sv = __hip_atomic_load(ctl + ((STOPW) >= 0 ? (STOPW) : 0), __ATOMIC_RELAXED, __HIP_MEMORY_SCOPE_AGENT); \
_Pragma("unroll 1") \
                        for (int g = 0; g < CV_NG - 2; g += 2) { CV_LOAD(rb, cur, g + 1); CV_PROC(ra, cur, g); CV_LOAD(ra, cur, g + 2); CV_PROC(rb, cur, g + 1); } \
                        CV_LOAD(rb, cur, CV_NG - 1); CV_PROC(ra, cur, CV_NG - 2); \
                        nx = __builtin_amdgcn_readfirstlane(nx); const bool more = nx < nconv_eff; \
                        const ConvDesc nd = conv_decode(CV_MAP(more ? nx : it), w_gu, w_dn, WGU, WDN, lane); \
                        CV_LOAD(ra, nd, 0);                                   \
                        CV_PROC(rb, cur, CV_NG - 1); \
                        if ((STOPW) >= 0) stop = (unsigned)__builtin_amdgcn_readfirstlane((int)sv) >= (unsigned)(STOPN); \
                        if (!more) break; \
                        cur = nd; it = nx; \
                    } \
                } \
            } \
            if (mode == 0 && (ATTW) < 8 && (ATTW) > 0 && ATT_NOFALL && wave < (ATTW) - ATT_JOIN) break;     \
            mode ^= 1; ++tried; \
        } \
    } while (0)
    if (IN(1)) {
        const bool split = (MK_N_LAUNCHES == 1) && (G == 256) && (SPLIT_P1 != 0);
        const bool conv_wg = split && (((bx >> 3) & 1) == 1);
        if (!conv_wg) {
            pg8::Gemm g{XN, WIN, NTOK, INC, DM}; pg8::StaticOrder S; S.init(NTOK, INC, split ? 128 : G, split ? (((bx >> 4) << 3) | (bx & 7)) : bx);
            pg8::EpiProj E{PROJ, ROPE, att::C2};
            if (side_on && (SIDE_CONV & 1)) { pg8::SideConv SD{w_gu, WGU, 4096, 128 * bx, 96, (unsigned)PART_OFF}; pg8::gemm_phase<pg8::EpiProj, pg8::StaticOrder, true, true, false, false, pg8::SideConv>(L, g, S, E, SD); }
            else pg8::gemm_phase<pg8::EpiProj, pg8::StaticOrder, true, true>(L, g, S, E);
            __syncthreads();
            if (tid == 0) __hip_atomic_fetch_add(ctl + CW_P1DONE, 1u, __ATOMIC_RELAXED, __HIP_MEMORY_SCOPE_AGENT);
        } else {
            RUN_P2(0, CW_ATTQ, CW_CONVQ, 1, CW_P1DONE, 128);
        }
        if (BOTH(1)) GRID_BAR();
    }

    if (IN(2)) {
        RUN_P2(ATT_WAVES, CW_ATTQ, CW_CONVQ, 0, -1, 0);
        if (BOTH(2)) GRID_BAR();
        if ((PROBE_MASK >> 10) & 1) { RUN_P2(0, CW_ATTQ, CW_CONVQ + 64, 0, -1, 0); GRID_BAR(); }
        if ((PROBE_MASK >> 12) & 1) {
            unsigned char* SCR = ws + (size_t)2048 * MiB;
            for (int itp = gw; itp < 2 * NE * 1024; itp += NGW) {
                const int isdn = itp >= NE * 1024; const int r = isdn ? itp - NE * 1024 : itp; const int e = r >> 10, kp = r & 1023; const int N = isdn ? 2048 : 4096;
                const float* s0 = (isdn ? w_dn + (size_t)e * 2048 * 2048 : w_gu + (size_t)e * 2048 * 4096) + (size_t)(2 * kp) * N + 4 * lane; const float* s1 = s0 + N;
                unsigned char* d = SCR + (isdn ? (size_t)NE * 1024 * 8192 + ((size_t)e * 1024 + kp) * 4096 : ((size_t)e * 1024 + kp) * 8192) + 8 * lane;
                for (int i0 = 0; i0 < N / 256; i0 += 8) {
                    f32x4 a[8], c[8];
#pragma unroll
                    for (int i = 0; i < 8; ++i) { a[i] = *(const GAS f32x4*)(s0 + 256 * (i0 + i)); c[i] = *(const GAS f32x4*)(s1 + 256 * (i0 + i)); }
#pragma unroll
                    for (int i = 0; i < 8; ++i) { u32x2v o; o.x = pk4_fp8_nc(64.f * a[i][0], 64.f * c[i][0], 64.f * a[i][1], 64.f * c[i][1]); o.y = pk4_fp8_nc(64.f * a[i][2], 64.f * c[i][2], 64.f * a[i][3], 64.f * c[i][3]);
                        *(GAS u32x2v*)(d + 512 * (i0 + i)) = o; }
                }
            }
            GRID_BAR();
        }
        if ((PROBE_MASK >> 14) & 1) { RUN_P2(ATT_WAVES, CW_ATTQ + 2048, CW_CONVQ + 192, 0, -1, 0); GRID_BAR(); }
        if ((PROBE_MASK >> 13) & 1) { RUN_P2(4, CW_ATTQ, CW_CONVQ + 128, 1, -1, 0); GRID_BAR(); }
        if ((PROBE_MASK >> 15) & 1) { for (;;) { int it = 0; if (lane == 0) it = (int)__hip_atomic_fetch_add(ctl + CW_ATTQ + 256 + 64, 1u, __ATOMIC_RELAXED, __HIP_MEMORY_SCOPE_AGENT); it = __builtin_amdgcn_readfirstlane(it); if (it >= att::NITEMS) break;
            att::item<1>(it, PROJ, (bf16*)(ws + (size_t)3000 * MiB), (LAS char*)(L + wave * 16384), lane); } GRID_BAR(); }
        if ((PROBE_MASK >> 16) & 1) { for (;;) { int it = 0; if (lane == 0) it = (int)__hip_atomic_fetch_add(ctl + CW_ATTQ + 256 + 128, 1u, __ATOMIC_RELAXED, __HIP_MEMORY_SCOPE_AGENT); it = __builtin_amdgcn_readfirstlane(it); if (it >= att::NITEMS) break;
            att::item<2>(it, PROJ, (bf16*)(ws + (size_t)3000 * MiB), (LAS char*)(L + wave * 16384), lane); } GRID_BAR(); }
        if ((PROBE_MASK >> 11) & 1) { RUN_P2(8, CW_ATTQ + 1024, CW_CONVQ, 0, -1, 0); GRID_BAR(); }
    }

    if (IN(3)) for (int rep = 0; rep < REPS(3); ++rep) {
        for (int m = gw; m < NTOK; m += NGW) {
            const int spos = m & (SEQ - 1);
            const bf16* ya = YATT + (size_t)m * AW + 8 * lane;
            v4u a[3];
#pragma unroll
            for (int j = 0; j < 3; ++j) a[j] = *(const v4u*)(ya + 512 * j);
            const bf16* pr = PROJ + (size_t)m * INC + 8 * lane;
            float u[3][8];
#pragma unroll
            for (int d = 0; d < 3; ++d) {
                const int back = 2 - d;
                if (spos >= back) { const v4u cx = *(const v4u*)(pr - (size_t)back * INC); const v4u cc = *(const v4u*)(pr - (size_t)back * INC + 2 * CW);
                    u[d][0] = bf_lo(cx.x) * bf_lo(cc.x); u[d][1] = bf_hi(cx.x) * bf_hi(cc.x); u[d][2] = bf_lo(cx.y) * bf_lo(cc.y); u[d][3] = bf_hi(cx.y) * bf_hi(cc.y);
                    u[d][4] = bf_lo(cx.z) * bf_lo(cc.z); u[d][5] = bf_hi(cx.z) * bf_hi(cc.z); u[d][6] = bf_lo(cx.w) * bf_lo(cc.w); u[d][7] = bf_hi(cx.w) * bf_hi(cc.w); }
                else {
#pragma unroll
                    for (int j = 0; j < 8; ++j) u[d][j] = 0.f; }
            }
            const v4u cb = *(const v4u*)(pr + CW);
            float bb[8] = {bf_lo(cb.x), bf_hi(cb.x), bf_lo(cb.y), bf_hi(cb.y), bf_lo(cb.z), bf_hi(cb.z), bf_lo(cb.w), bf_hi(cb.w)};
            float y[8]; float s = 0.f;
#pragma unroll
            for (int j = 0; j < 8; ++j) { const int c = 8 * lane + j; const float acc = conv_w[c] * u[0][j] + conv_w[CW + c] * u[1][j] + conv_w[2 * CW + c] * u[2][j]; y[j] = bb[j] * acc; s += y[j] * y[j]; }
            const float rc = 1.0f / sqrtf(wave_sum(s) * (1.0f / CW) + EPS);
            { v4u o; const float* gq = conv_g + 8 * lane;
              o.x = pk2(y[0] * rc * gq[0], y[1] * rc * gq[1]); o.y = pk2(y[2] * rc * gq[2], y[3] * rc * gq[3]); o.z = pk2(y[4] * rc * gq[4], y[5] * rc * gq[5]); o.w = pk2(y[6] * rc * gq[6], y[7] * rc * gq[7]);
              *(v4u*)(MIXED + (size_t)m * DM + 8 * lane) = o; }
            float s2 = 0.f;
#pragma unroll
            for (int j = 0; j < 3; ++j) {
                const float f0 = bf_lo(a[j].x), f1 = bf_hi(a[j].x), f2 = bf_lo(a[j].y), f3 = bf_hi(a[j].y), f4 = bf_lo(a[j].z), f5 = bf_hi(a[j].z), f6 = bf_lo(a[j].w), f7 = bf_hi(a[j].w);
                s2 += (f0 * f0 + f1 * f1) + (f2 * f2 + f3 * f3) + (f4 * f4 + f5 * f5) + (f6 * f6 + f7 * f7); }
            const float ra = 1.0f / sqrtf(wave_sum(s2) * (1.0f / AW) + EPS);
#pragma unroll
            for (int j = 0; j < 3; ++j) { const float* gq = attn_g + 512 * j + 8 * lane; v4u o;
                o.x = pk2(bf_lo(a[j].x) * ra * gq[0], bf_hi(a[j].x) * ra * gq[1]); o.y = pk2(bf_lo(a[j].y) * ra * gq[2], bf_hi(a[j].y) * ra * gq[3]);
                o.z = pk2(bf_lo(a[j].z) * ra * gq[4], bf_hi(a[j].z) * ra * gq[5]); o.w = pk2(bf_lo(a[j].w) * ra * gq[6], bf_hi(a[j].w) * ra * gq[7]);
                *(v4u*)(MIXED + (size_t)m * DM + CW + 512 * j + 8 * lane) = o; }
        }
        if (BOTH(3)) GRID_BAR();
    }

    if (IN(4)) for (int rep = 0; rep < REPS(4); ++rep) {
        pg8::Gemm g{MIXED, WO, NTOK, DM, DM}; pg8::StaticOrder S; S.init(NTOK, DM, G, (int)blockIdx.x);
        pg8::EpiResF32 E{x, X1, DM};
        if (side_on && (SIDE_CONV & 1)) { pg8::SideConv SD{w_gu, WGU, 4096, 128 * bx + 96, 32, (unsigned)PART_OFF}; pg8::gemm_phase<pg8::EpiResF32, pg8::StaticOrder, false, true, false, false, pg8::SideConv>(L, g, S, E, SD); }
        else pg8::gemm_phase<pg8::EpiResF32, pg8::StaticOrder, false, true>(L, g, S, E);
        if (BOTH(4)) GRID_BAR();
    }

    if (IN(5)) for (int rep = 0; rep < REPS(5); ++rep) {
        const int cwc = CW_CNT + 1024 * rep; int* TOKE_ = TOKE + rep * (1 << 20); int* TOKR_ = TOKR + rep * (1 << 20); float* TOKG_ = TOKG + rep * (1 << 20); unsigned char* XS_ = XS + (size_t)rep * ((size_t)2752 * MiB - WS_XS);
        LAS float* X1L = (LAS float*)L; constexpr int XP = 2052;
        LAS float* PART = (LAS float*)(L + PART_OFF);
        const int e_ = lane & 31, kbase = 256 * wave + 128 * (lane >> 5);
        LAS int* LC = (LAS int*)(L + LDSCTL_OFF + 2048); LAS int* LB = (LAS int*)(L + LDSCTL_OFF + 2304);
        LAS int* AE = (LAS int*)(L + LDSCTL_OFF + 4096); LAS int* ALR = AE + 128; LAS float* AG = (LAS float*)(AE + 256); LAS float* RS = (LAS float*)(AE + 384);
        for (int blk = vcu; blk < NTOK / 32; blk += G) {
        if (tid < 32) LC[tid] = 0;
        __syncthreads();
        const int grp0 = 2 * blk;
#define P5_DMA(step) do { _Pragma("unroll") for (int r = 0; r < 2; ++r) _Pragma("unroll") for (int c = 0; c < 8; ++c) \
            __builtin_amdgcn_global_load_lds((const unsigned*)(X1 + (size_t)((grp0 + (step)) * 16 + 2 * wave + r) * DM + c * 256 + lane * 4), (LAS unsigned*)(L + (2 * wave + r) * (XP * 4) + c * 1024), 16, 0, 0); \
            asm volatile("s_waitcnt vmcnt(0)" ::: "memory"); __syncthreads(); } while (0)
        for (int step = 0; step < 2; ++step) {
            if (step) __syncthreads();
            P5_DMA(step);
            {
                typedef short s16x8b __attribute__((ext_vector_type(8)));
                f32x4 acc0 = {0.f, 0.f, 0.f, 0.f}, acc1 = acc0;
                const int tcol = lane & 15, kq = lane >> 4;
#pragma unroll
                for (int s8 = 0; s8 < 8; ++s8) { const int ks = 8 * wave + s8;
                    const LAS f32x4* xp = (const LAS f32x4*)(X1L + tcol * XP + 32 * ks + 8 * kq); const f32x4 xa = xp[0], xb = xp[1];
                    unsigned xh[4], xl[4];
                    { const unsigned h0 = f2bf(xa.x), h1 = f2bf(xa.y), h2 = f2bf(xa.z), h3 = f2bf(xa.w), h4 = f2bf(xb.x), h5 = f2bf(xb.y), h6 = f2bf(xb.z), h7 = f2bf(xb.w);
                      xh[0] = h0 | (h1 << 16); xh[1] = h2 | (h3 << 16); xh[2] = h4 | (h5 << 16); xh[3] = h6 | (h7 << 16);
                      xl[0] = pk2(xa.x - __uint_as_float(h0 << 16), xa.y - __uint_as_float(h1 << 16)); xl[1] = pk2(xa.z - __uint_as_float(h2 << 16), xa.w - __uint_as_float(h3 << 16));
                      xl[2] = pk2(xb.x - __uint_as_float(h4 << 16), xb.y - __uint_as_float(h5 << 16)); xl[3] = pk2(xb.z - __uint_as_float(h6 << 16), xb.w - __uint_as_float(h7 << 16)); }
                    const s16x8b bxh = __builtin_bit_cast(s16x8b, (v4u){xh[0], xh[1], xh[2], xh[3]}), bxl = __builtin_bit_cast(s16x8b, (v4u){xl[0], xl[1], xl[2], xl[3]});
                    const v4u* wf = (const v4u*)GWF + (size_t)(ks * 4) * 64 + lane;
                    const s16x8b w0h = __builtin_bit_cast(s16x8b, wf[0]), w0l = __builtin_bit_cast(s16x8b, wf[64]), w1h = __builtin_bit_cast(s16x8b, wf[128]), w1l = __builtin_bit_cast(s16x8b, wf[192]);
                    acc0 = __builtin_amdgcn_mfma_f32_16x16x32_bf16(w0h, bxh, acc0, 0, 0, 0); acc0 = __builtin_amdgcn_mfma_f32_16x16x32_bf16(w0l, bxh, acc0, 0, 0, 0); acc0 = __builtin_amdgcn_mfma_f32_16x16x32_bf16(w0h, bxl, acc0, 0, 0, 0);
                    acc1 = __builtin_amdgcn_mfma_f32_16x16x32_bf16(w1h, bxh, acc1, 0, 0, 0); acc1 = __builtin_amdgcn_mfma_f32_16x16x32_bf16(w1l, bxh, acc1, 0, 0, 0); acc1 = __builtin_amdgcn_mfma_f32_16x16x32_bf16(w1h, bxl, acc1, 0, 0, 0); }
                *(LAS f32x4*)(PART + (wave * 16 + tcol) * 32 + 4 * kq) = acc0; *(LAS f32x4*)(PART + (wave * 16 + tcol) * 32 + 16 + 4 * kq) = acc1;
            }
            __syncthreads();
            {
                float tvv[2][4]; int tii[2][4];
#pragma unroll
                for (int r = 0; r < 2; ++r) { const int tl = 2 * wave + r;
                    const LAS f32x4* hp = (const LAS f32x4*)(X1L + tl * XP + 32 * lane); float ss = 0.f;
#pragma unroll
                    for (int j = 0; j < 8; ++j) { const f32x4 a = hp[j]; ss += (a.x * a.x + a.y * a.y) + (a.z * a.z + a.w * a.w); }
                    const float rstd = 1.0f / sqrtf(wave_sum(ss) * (1.0f / DM) + EPS); if (lane == 0) RS[step * 16 + tl] = rstd;
                    float lg = -INFINITY;
                    if (lane < 32) { float s = 0.f;
#pragma unroll
                        for (int w = 0; w < 8; ++w) s += PART[(w * 16 + tl) * 32 + lane]; lg = s * rstd + b_router[lane]; }
                    int rank = 0; const int lgb = __float_as_int(lg);
#pragma unroll
                    for (int j = 0; j < 32; ++j) { const float vj = __int_as_float(__builtin_amdgcn_readlane(lgb, j)); rank += (vj > lg || (vj == lg && j < lane)) ? 1 : 0; }
#pragma unroll
                    for (int k = 0; k < 4; ++k) { const unsigned long long mk = __builtin_amdgcn_ballot_w64(lane < 32 && rank == k); const int idx = (int)__builtin_ctzll(mk);
                        tii[r][k] = idx; tvv[r][k] = __int_as_float(__builtin_amdgcn_readlane(lgb, idx)); } }
                if (lane < 8) { const int r = lane >> 2, k = lane & 3;
                    const float t0 = r ? tvv[1][0] : tvv[0][0], t1 = r ? tvv[1][1] : tvv[0][1], t2 = r ? tvv[1][2] : tvv[0][2], t3 = r ? tvv[1][3] : tvv[0][3];
                    const float e1 = __expf(t1 - t0), e2 = __expf(t2 - t0), e3 = __expf(t3 - t0); const float den = 1.0f / (1.0f + e1 + e2 + e3);
                    const int i0 = r ? tii[1][0] : tii[0][0], i1 = r ? tii[1][1] : tii[0][1], i2 = r ? tii[1][2] : tii[0][2], i3 = r ? tii[1][3] : tii[0][3];
                    const int ee = k == 0 ? i0 : k == 1 ? i1 : k == 2 ? i2 : i3; const float gg = (k == 0 ? 1.0f : k == 1 ? e1 : k == 2 ? e2 : e3) * den;
                    const int ai = (step * 16 + 2 * wave + r) * 4 + k;
                    AE[ai] = ee; ALR[ai] = __hip_atomic_fetch_add(LC + ee, 1, __ATOMIC_RELAXED, __HIP_MEMORY_SCOPE_WORKGROUP); AG[ai] = gg; }
            }
        }
        __syncthreads();
        if (tid < 32) { const int c = LC[tid]; LB[tid] = c ? (int)__hip_atomic_fetch_add(ctl + cwc + 16 * tid, (unsigned)c, __ATOMIC_RELAXED, __HIP_MEMORY_SCOPE_AGENT) : 0; }
        __syncthreads();
        for (int pp = 0; pp < 2; ++pp) { const int step = 1 - pp;
            if (pp) { __syncthreads(); P5_DMA(step); }
#pragma unroll
            for (int r = 0; r < 2; ++r) { const int tl = 2 * wave + r; const float sc = 16.f * RS[step * 16 + tl]; const int tok = (grp0 + step) * 16 + tl;
                const LAS f32x4* hp = (const LAS f32x4*)(X1L + tl * XP + 32 * lane); const f32x4* gp = (const f32x4*)(ffn_g + 32 * lane); v4u w0, w1;
                { const f32x4 a = hp[0] * gp[0] * sc, c = hp[1] * gp[1] * sc, d = hp[2] * gp[2] * sc, f = hp[3] * gp[3] * sc;
                  w0.x = pg8::pk4_fp8(a.x, a.y, a.z, a.w); w0.y = pg8::pk4_fp8(c.x, c.y, c.z, c.w); w0.z = pg8::pk4_fp8(d.x, d.y, d.z, d.w); w0.w = pg8::pk4_fp8(f.x, f.y, f.z, f.w); }
                { const f32x4 a = hp[4] * gp[4] * sc, c = hp[5] * gp[5] * sc, d = hp[6] * gp[6] * sc, f = hp[7] * gp[7] * sc;
                  w1.x = pg8::pk4_fp8(a.x, a.y, a.z, a.w); w1.y = pg8::pk4_fp8(c.x, c.y, c.z, c.w); w1.z = pg8::pk4_fp8(d.x, d.y, d.z, d.w); w1.w = pg8::pk4_fp8(f.x, f.y, f.z, f.w); }
#pragma unroll
                for (int k = 0; k < 4; ++k) { const int ai = (step * 16 + tl) * 4 + k; const int ee = AE[ai], rank = LB[ee] + ALR[ai];
                    GAS v4u* dst = (GAS v4u*)(XS_ + ((size_t)ee * NTOK + rank) * DM + 32 * lane); dst[0] = w0; dst[1] = w1;
                    if (lane == 0) { TOKE_[tok * 4 + k] = ee; TOKR_[tok * 4 + k] = rank; TOKG_[tok * 4 + k] = AG[ai]; } } }
        }
        __syncthreads();
        }
#undef P5_DMA
        if (BOTH(5)) GRID_BAR();
    }

    LAS int* TS = (LAS int*)(L + TAB_TS); LAS int* CN = (LAS int*)(L + TAB_CN);
    if (hi > 6) {
        if (tid == 0) { int acc = 0; for (int e = 0; e < NE; ++e) { const int c = (int)__hip_atomic_load(ctl + CW_CNT + 16 * e, __ATOMIC_RELAXED, __HIP_MEMORY_SCOPE_AGENT); CN[e] = c; TS[e] = acc; acc += (c + 255) >> 8; } TS[NE] = acc; }
        __syncthreads();
    }


    if (IN(7)) for (int rep = 0; rep < REPS(7); ++rep) {
        {
        pg8::GroupedOrder S{(const PG8_LAS int*)TS, (const PG8_LAS int*)CN, 16, G, vcu, (long)1024 * 4096 * 2, 128 * 2};
        pg8::EpiSwiGLU E{ACT, b_gu};
        pg8::Gemm g{(const pg8::bf16_t*)XS, (const pg8::bf16_t*)WGU, MAXSLOT, NE * 4096, DM / 2, 4096, 2048 * 2};
        if (side_on && (SIDE_CONV & 2)) { pg8::SideConv SD{w_dn, WDN, 2048, 128 * bx, 128, (unsigned)PART_OFF}; pg8::gemm_phase<pg8::EpiSwiGLU, pg8::GroupedOrder, true, true, true, true, pg8::SideConv>(L, g, S, E, SD); }
        else pg8::gemm_phase<pg8::EpiSwiGLU, pg8::GroupedOrder, true, true, true, true>(L, g, S, E); }
        if (BOTH(7)) GRID_BAR();
    }

    if (IN(8)) for (int rep = 0; rep < REPS(8); ++rep) {
        {
        pg8::GroupedOrder S{(const PG8_LAS int*)TS, (const PG8_LAS int*)CN, 8, G, vcu, (long)1024 * 2048 * 2, 256 * 2};
        pg8::EpiFp8Y E{(unsigned char*)YB, 1.0f / (pg8::FP8_W_SCALE * pg8::FP8_ACT_SCALE), b_dn};
        pg8::Gemm g{(const pg8::bf16_t*)ACT, (const pg8::bf16_t*)WDN, MAXSLOT, NE * 2048, DE / 2, 2048, 128 * 2};
        pg8::gemm_phase<pg8::EpiFp8Y, pg8::GroupedOrder, true, true, true, true>(L, g, S, E); }
        if (BOTH(8)) GRID_BAR();
    }

    if (IN(9)) for (int rep = 0; rep < REPS(9); ++rep) {
        unsigned poison = __hip_atomic_load(ctl + CW_BAR + XB_TMO, RLX_AGENT) != 0u;
        for (int m = gw; m < NTOK; m += NGW) {
            const GAS f32x4* xr = (const GAS f32x4*)(X1 + (size_t)m * DM) + lane;
            f32x4 v[8];
#pragma unroll
            for (int j = 0; j < 8; ++j) v[j] = __builtin_nontemporal_load(xr + 64 * j);
            const int4 te = *(const int4*)(TOKE + m * 4), tr = *(const int4*)(TOKR + m * 4); const f32x4 tg = *(const f32x4*)(TOKG + m * 4);
            const int ee[4] = {te.x, te.y, te.z, te.w}, rr[4] = {tr.x, tr.y, tr.z, tr.w};
            unsigned yy[4][8];
#pragma unroll
            for (int k = 0; k < TOPK; ++k) { const GAS unsigned* yr = (const GAS unsigned*)((const unsigned char*)YB + ((size_t)ee[k] * NTOK + rr[k]) * DM) + lane;
#pragma unroll
                for (int j = 0; j < 8; ++j) yy[k][j] = __builtin_nontemporal_load(yr + 64 * j); }
#pragma unroll
            for (int k = 0; k < TOPK; ++k) { const float gt = tg[k] * (1.0f / 16.0f);
#pragma unroll
                for (int j = 0; j < 8; ++j) { typedef float f32x2y __attribute__((ext_vector_type(2))); const f32x2y lo = __builtin_amdgcn_cvt_pk_f32_fp8((int)yy[k][j], false), hi = __builtin_amdgcn_cvt_pk_f32_fp8((int)yy[k][j], true);
                    v[j].x += gt * lo.x; v[j].y += gt * lo.y; v[j].z += gt * hi.x; v[j].w += gt * hi.y; } }
            float s = 0.f;
#pragma unroll
            for (int j = 0; j < 8; ++j) s += (v[j].x * v[j].x + v[j].y * v[j].y) + (v[j].z * v[j].z + v[j].w * v[j].w);
            float rstd = 1.0f / sqrtf(wave_sum(s) * (1.0f / DM) + EPS);
            if (poison) rstd = __builtin_nanf("");
            GAS f32x4* orow = (GAS f32x4*)(out + (size_t)m * DM) + lane; const GAS f32x4* gr = (const GAS f32x4*)fin_g + lane;
#pragma unroll
            for (int j = 0; j < 8; ++j) { const f32x4 gg = gr[64 * j]; f32x4 o; o.x = v[j].x * rstd * gg.x; o.y = v[j].y * rstd * gg.y; o.z = v[j].z * rstd * gg.z; o.w = v[j].w * rstd * gg.w; __builtin_nontemporal_store(o, orow + 64 * j); }
        }
    }
#undef IN
#undef BOTH
#undef GRID_BAR
}

extern "C" void kernel_launch(void* const* d_in, const int* in_sizes, int n_in, void* d_out, int out_size, void* d_ws, size_t ws_size, hipStream_t stream) {
    static int grid = 0;
    if (grid == 0) {
        if (n_in != 15 || in_sizes[0] != NTOK * DM || out_size != NTOK * DM || ws_size < WS_END) { fprintf(stderr, "kernel_launch: unexpected shapes / workspace (n_in %d, ws %zu)\n", n_in, ws_size); grid = -1; return; }
        int dev = 0, cus = 0, per_cu = 0;
        if (hipGetDevice(&dev) != hipSuccess || hipDeviceGetAttribute(&cus, hipDeviceAttributeMultiprocessorCount, dev) != hipSuccess) { grid = -1; return; }
        if (hipFuncSetAttribute((const void*)fwd, hipFuncAttributeMaxDynamicSharedMemorySize, LDS_BYTES) != hipSuccess) { fprintf(stderr, "kernel_launch: hipFuncSetAttribute failed\n"); grid = -1; return; }
        if (hipOccupancyMaxActiveBlocksPerMultiprocessor(&per_cu, (const void*)fwd, NWAVES * 64, LDS_BYTES) != hipSuccess || per_cu < 1) fprintf(stderr, "kernel_launch: occupancy query says %d\n", per_cu);
        (void)hipGetLastError();
        grid = cus;
    }
    if (grid < 0) return;
    if (hipMemsetAsync((char*)d_ws + WS_CTL, 0, CTL_ZERO_BYTES, stream) != hipSuccess) return;
    Args a{};
    for (int i = 0; i < 15; ++i) a.in[i] = (const float*)d_in[i];
    a.out = (float*)d_out; a.ws = (unsigned char*)d_ws;
    if (MK_N_LAUNCHES == 1) { a.ph_lo = 0; a.ph_hi = NPH; hipLaunchKernelGGL(fwd, dim3(grid), dim3(NWAVES * 64), LDS_BYTES, stream, a); }
    else { for (int p = 0; p < NPH; ++p) { a.ph_lo = p; a.ph_hi = p + 1; hipLaunchKernelGGL(fwd, dim3(grid), dim3(NWAVES * 64), LDS_BYTES, stream, a); } }
    const hipError_t le = hipPeekAtLastError();
    if (le != hipSuccess) fprintf(stderr, "kernel_launch: launch failed: %s\n", hipGetErrorName(le));
}
```

```cpp
#include <hip/hip_runtime.h>
#include <cstdio>
#include <cstdint>
namespace pg8 {
#define PG8_LAS __attribute__((address_space(3)))
typedef unsigned short bf16_t;
typedef short bf16x8 __attribute__((ext_vector_type(8)));
typedef float f32x4 __attribute__((ext_vector_type(4)));
typedef unsigned u32x4 __attribute__((ext_vector_type(4)));
constexpr int BM = 256, BK = 64, HALF = 128, HTB = HALF * BK * 2  , STAGE_BYTES = 8 * HTB, NXCD = 8, WGM = 8;

__host__ __device__ __forceinline__ int lds_byte(int r, int c) { const int st = (r >> 4) * 2 + (c >> 5), rr = r & 15, cc = c & 31, ob = rr * 64 + cc * 2; return st * 1024 + (ob ^ (((ob >> 9) & 1) << 5)); }
__host__ __device__ __forceinline__ void stage_rc(int b, int& R, int& C) { const int st = b / 1024, sb = b % 1024, swz = sb ^ (((sb >> 9) & 1) << 5); R = (st >> 1) * 16 + swz / 64; C = (st & 1) * 32 + (swz % 64) / 2; }
__host__ __device__ __forceinline__ int perm32(int rho) { const int n = rho >> 4, i = rho & 15; return 8 * (i >> 2) + 4 * n + (i & 3); }

struct Unit { int pm, pn, e, cn, rows; long boff; };
struct Gemm { const bf16_t* A; const bf16_t* Bt; int M, N, K; int b_ntot, b_hstep; };

struct StaticOrder {
    int nM, nN, nwg, G, c;
    __host__ __device__ void init(int M, int N, int G_, int c_) { nM = M / BM; nN = N / BM; nwg = nM * nN; G = G_; c = c_; }
    __host__ __device__ bool next(int i, Unit& u) const {
        const long L = (long)i * G + c; if (L >= nwg) return false;
        int wgid = (int)L; { const int q = nwg / NXCD, r = nwg % NXCD, xcd = wgid % NXCD, off = wgid / NXCD; wgid = (xcd < r ? xcd * (q + 1) : r * (q + 1) + (xcd - r) * q) + off; }
        const int nig = WGM * nN, gid = wgid / nig, fm = gid * WGM, gsz = (nM - fm) < WGM ? (nM - fm) : WGM;
        u.pm = fm + ((wgid % nig) % gsz); u.pn = (wgid % nig) / gsz; u.e = 0; u.cn = u.pn; u.rows = BM; u.boff = 0; return true;
    }
    __device__ __forceinline__ void a_ready(const Unit&) const {}
    __device__ __forceinline__ void done(const Unit&) const {}
};
struct GroupedOrder {
    const PG8_LAS int* TS; const PG8_LAS int* CN; int nN, G, v; long b_estride; int b_cnstep;
    __device__ __forceinline__ bool next(int i, Unit& u) const {
        const int U = i * G + v; const int total = __builtin_amdgcn_readfirstlane(TS[32] * nN); if (U >= total) return false;
        int e = 0;
#pragma unroll 1
        for (int j = 1; j < 32; ++j) e += (TS[j] * nN <= U) ? 1 : 0;
        const int t0 = TS[e], nt = TS[e + 1] - t0, loc = U - t0 * nN; const int pn = loc / nt, rt = loc - pn * nt; const int left = CN[e] - rt * BM;
        u.pm = __builtin_amdgcn_readfirstlane(e * 32 + rt); u.pn = __builtin_amdgcn_readfirstlane(e * nN + pn); u.e = __builtin_amdgcn_readfirstlane(e); u.cn = __builtin_amdgcn_readfirstlane(pn);
        u.rows = __builtin_amdgcn_readfirstlane(left < BM ? left : BM); u.boff = (long)u.e * b_estride + (long)u.cn * b_cnstep; return true;
    }
    __device__ __forceinline__ void a_ready(const Unit&) const {}
    __device__ __forceinline__ void done(const Unit&) const {}
};

__device__ __forceinline__ unsigned cvt_pk_bf16(float lo, float hi) { unsigned r; asm volatile("v_cvt_pk_bf16_f32 %0, %1, %2" : "=v"(r) : "v"(lo), "v"(hi)); return r; }

struct EpiBf16Plain {
    static constexpr bool PERM = true, AFTER_DRAIN = false;
    bf16_t* O; int ldc; float sc; const float* bias;
    __device__ __forceinline__ void operator()(const f32x4 (&acc)[2][2][4][2], const Unit& u, int wr, int wc, int fr, int fq) const {
        const int row0 = u.pm * BM + wr * 64 + fr, col0 = u.cn * BM + wc * 32 + 8 * fq;
        f32x4 bv[2][2];
#pragma unroll
        for (int bj = 0; bj < 2; ++bj)
#pragma unroll
            for (int n = 0; n < 2; ++n) bv[bj][n] = bias ? *(const f32x4*)(bias + (size_t)u.e * ldc + col0 + bj * HALF + 4 * n) : (f32x4){0.f, 0.f, 0.f, 0.f};
#pragma unroll
        for (int ai = 0; ai < 2; ++ai) { if (ai == 1 && u.rows <= HALF) break;
#pragma unroll
            for (int m = 0; m < 4; ++m) { bf16_t* rowp = O + (size_t)(row0 + ai * HALF + m * 16) * ldc + col0;
#pragma unroll
                for (int bj = 0; bj < 2; ++bj) { const f32x4 v0 = acc[ai][bj][m][0] * sc + bv[bj][0], v1 = acc[ai][bj][m][1] * sc + bv[bj][1];
                    u32x4 w; w.x = cvt_pk_bf16(v0[0], v0[1]); w.y = cvt_pk_bf16(v0[2], v0[3]); w.z = cvt_pk_bf16(v1[0], v1[1]); w.w = cvt_pk_bf16(v1[2], v1[3]);
                    *(u32x4*)(rowp + bj * HALF) = w; } } }
    }
};
struct EpiProj {
    static constexpr bool PERM = true, AFTER_DRAIN = false;
    bf16_t* O; const float* rope; float qscale;
    __device__ __forceinline__ void operator()(const f32x4 (&acc)[2][2][4][2], const Unit& u, int wr, int wc, int fr, int fq) const {
        const int row0 = u.pm * BM + wr * 64 + fr, col0 = u.cn * BM + wc * 32 + 8 * fq;
        const bool isq = (u.cn >= 6 && u.cn < 12), isk = (u.cn >= 12 && u.cn < 18);
        const bool rot = (isq || isk) && ((wc & 1) == 0);
        const float sc = isq ? qscale : 1.0f;
        const float sg = (fq == 0) ? -1.0f : 1.0f;
        const bool act = fq < 2;
#pragma unroll
        for (int ai = 0; ai < 2; ++ai)
#pragma unroll
            for (int m = 0; m < 4; ++m) { const int row = row0 + ai * HALF + m * 16; bf16_t* rowp = O + (size_t)row * 6144 + col0;
                f32x4 c0 = {1.f, 1.f, 1.f, 1.f}, c1 = c0, s0 = {0.f, 0.f, 0.f, 0.f}, s1 = s0;
                if (rot) { const float* rp = rope + (row & 2047) * 16; c0 = *(const f32x4*)rp; c1 = *(const f32x4*)(rp + 4); s0 = *(const f32x4*)(rp + 8); s1 = *(const f32x4*)(rp + 12); }
#pragma unroll
                for (int bj = 0; bj < 2; ++bj) { f32x4 v0 = acc[ai][bj][m][0], v1 = acc[ai][bj][m][1];
                    if (rot) { f32x4 o0, o1;
#pragma unroll
                        for (int i = 0; i < 4; ++i) { o0[i] = __shfl_xor(v0[i], 16); o1[i] = __shfl_xor(v1[i], 16); }
                        const f32x4 r0 = v0 * c0 + (o0 * s0) * sg, r1 = v1 * c1 + (o1 * s1) * sg;
                        v0 = act ? r0 : v0; v1 = act ? r1 : v1; }
                    v0 = v0 * sc; v1 = v1 * sc;
                    u32x4 w; w.x = cvt_pk_bf16(v0[0], v0[1]); w.y = cvt_pk_bf16(v0[2], v0[3]); w.z = cvt_pk_bf16(v1[0], v1[1]); w.w = cvt_pk_bf16(v1[2], v1[3]);
                    *(u32x4*)(rowp + bj * HALF) = w; } }
    }
};
struct EpiResF32 {
    static constexpr bool PERM = false, AFTER_DRAIN = false;
    const float* base; float* out; int ldc;
    __device__ __forceinline__ void operator()(const f32x4 (&acc)[2][2][4][2], const Unit& u, int wr, int wc, int fr, int fq) const {
        const int row0 = u.pm * BM + wr * 64 + fr, col0 = u.cn * BM + wc * 32 + 4 * fq;
#pragma unroll
        for (int ai = 0; ai < 2; ++ai)
#pragma unroll
            for (int m = 0; m < 4; ++m) { const size_t off = (size_t)(row0 + ai * HALF + m * 16) * ldc + col0;
#pragma unroll
                for (int bj = 0; bj < 2; ++bj)
#pragma unroll
                    for (int n = 0; n < 2; ++n) { const f32x4 b = *(const f32x4*)(base + off + bj * HALF + n * 16); *(f32x4*)(out + off + bj * HALF + n * 16) = acc[ai][bj][m][n] + b; } }
    }
};
__device__ __forceinline__ float swiglu1(float g, float up) {
    g = fminf(g, 7.0f); up = fminf(fmaxf(up, -7.0f), 7.0f);
    const float e = __builtin_amdgcn_exp2f(g * (-1.702f * 1.4426950408889634f));
    return (up + 1.0f) * g * __builtin_amdgcn_rcpf(1.0f + e);
}
__device__ __forceinline__ unsigned pk4_fp8(float a, float b, float c, float d) {
    a = fminf(fmaxf(a, -448.f), 448.f); b = fminf(fmaxf(b, -448.f), 448.f); c = fminf(fmaxf(c, -448.f), 448.f); d = fminf(fmaxf(d, -448.f), 448.f);
    int w = 0; w = __builtin_amdgcn_cvt_pk_fp8_f32(a, b, w, false); w = __builtin_amdgcn_cvt_pk_fp8_f32(c, d, w, true); return (unsigned)w; }
constexpr float FP8_W_SCALE = 64.f, FP8_X_SCALE = 16.f, FP8_ACT_SCALE = 4.f;
struct EpiFp8Y {
    static constexpr bool PERM = true, AFTER_DRAIN = false;
    unsigned char* O; float sc; const float* bias;
    __device__ __forceinline__ void operator()(const f32x4 (&acc)[2][2][4][2], const Unit& u, int wr, int wc, int fr, int fq) const {
        const int row0 = u.pm * BM + wr * 64 + fr, col0 = u.cn * BM + wc * 32 + 8 * fq;
        f32x4 bv[2][2];
#pragma unroll
        for (int bj = 0; bj < 2; ++bj)
#pragma unroll
            for (int n = 0; n < 2; ++n) bv[bj][n] = *(const f32x4*)(bias + (size_t)u.e * 2048 + col0 + bj * HALF + 4 * n);
#pragma unroll
        for (int ai = 0; ai < 2; ++ai) { if (ai == 1 && u.rows <= HALF) break;
#pragma unroll
            for (int m = 0; m < 4; ++m) { unsigned char* rowp = O + (size_t)(row0 + ai * HALF + m * 16) * 2048 + col0;
#pragma unroll
                for (int bj = 0; bj < 2; ++bj) { const f32x4 v0 = (acc[ai][bj][m][0] * sc + bv[bj][0]) * 16.f, v1 = (acc[ai][bj][m][1] * sc + bv[bj][1]) * 16.f;
                    typedef unsigned u32x2y __attribute__((ext_vector_type(2))); u32x2y w; w.x = pk4_fp8(v0[0], v0[1], v0[2], v0[3]); w.y = pk4_fp8(v1[0], v1[1], v1[2], v1[3]);
                    *(u32x2y*)(rowp + bj * HALF) = w; } } }
    }
};
struct EpiSwiGLU {
    static constexpr bool PERM = true, AFTER_DRAIN = false;
    unsigned char* O; const float* bias;
    __device__ __forceinline__ void operator()(const f32x4 (&acc)[2][2][4][2], const Unit& u, int wr, int wc, int fr, int fq) const {
        const int row0 = u.pm * BM + wr * 64 + fr, colj = u.cn * HALF + wc * 32 + 8 * fq;
        const float* bg = bias + (size_t)u.e * 4096 + colj; const float isc = 1.0f / (FP8_W_SCALE * FP8_X_SCALE);
        const f32x4 bg0 = *(const f32x4*)(bg), bg1 = *(const f32x4*)(bg + 4), bu0 = *(const f32x4*)(bg + 2048), bu1 = *(const f32x4*)(bg + 2048 + 4);
#pragma unroll
        for (int ai = 0; ai < 2; ++ai) { if (ai == 1 && u.rows <= HALF) break;
#pragma unroll
            for (int m = 0; m < 4; ++m) { unsigned char* rowp = O + (size_t)(row0 + ai * HALF + m * 16) * 2048 + colj;
                const f32x4 g0 = acc[ai][0][m][0] * isc + bg0, g1 = acc[ai][0][m][1] * isc + bg1, u0 = acc[ai][1][m][0] * isc + bu0, u1 = acc[ai][1][m][1] * isc + bu1;
                typedef unsigned u32x2e __attribute__((ext_vector_type(2))); u32x2e w;
                w.x = pk4_fp8(FP8_ACT_SCALE * swiglu1(g0[0], u0[0]), FP8_ACT_SCALE * swiglu1(g0[1], u0[1]), FP8_ACT_SCALE * swiglu1(g0[2], u0[2]), FP8_ACT_SCALE * swiglu1(g0[3], u0[3]));
                w.y = pk4_fp8(FP8_ACT_SCALE * swiglu1(g1[0], u1[0]), FP8_ACT_SCALE * swiglu1(g1[1], u1[1]), FP8_ACT_SCALE * swiglu1(g1[2], u1[2]), FP8_ACT_SCALE * swiglu1(g1[3], u1[3]));
                *(u32x2e*)rowp = w; } }
    }
};
typedef short v4i16p_t __attribute__((ext_vector_type(4)));
typedef int v2i_t __attribute__((ext_vector_type(2)));
__device__ __forceinline__ v2i_t trb(PG8_LAS const unsigned char* p) { return __builtin_bit_cast(v2i_t, __builtin_amdgcn_ds_read_tr16_b64_v4i16((PG8_LAS v4i16p_t*)p)); }
typedef int v8i_t __attribute__((ext_vector_type(8)));
typedef int v4i_t __attribute__((ext_vector_type(4)));
__device__ __forceinline__ v8i_t cat8(bf16x8 a, bf16x8 b) { const v4i_t x = __builtin_bit_cast(v4i_t, a), y = __builtin_bit_cast(v4i_t, b); return __builtin_shufflevector(x, y, 0, 1, 2, 3, 4, 5, 6, 7); }
__device__ __forceinline__ void mfma_fp8(f32x4& c, v8i_t a, v8i_t b, int sc) { asm volatile("v_mfma_scale_f32_16x16x128_f8f6f4 %0, %1, %2, %0, %3, %3 op_sel_hi:[0,0,0]" : "+v"(c) : "v"(a), "v"(b), "v"(sc)); }
struct NoSide { static constexpr bool ON = false, TWO = false; int njobs; };
struct SideConv {
    static constexpr bool ON = true, TWO = true;
    const float* W; unsigned char* OUT; int ntot; int c0, njobs; unsigned stage;
    __device__ __forceinline__ void addr(int j, int tid, const float*& s0, unsigned char*& d) const {
        const int c = c0 + j, cpk = ntot >> 11, kpg = c / cpk, half = c - kpg * cpk, e = kpg >> 10, kp = kpg & 1023;
        s0 = W + (size_t)e * 2048 * ntot + (size_t)(2 * kp) * ntot + half * 2048 + 4 * tid;
        d = OUT + ((size_t)e * 1024 + kp) * ntot * 2 + (size_t)(half * 2048 + 4 * tid) * 2;
    }
    __device__ __forceinline__ void issue(PG8_LAS unsigned char* lds0, int j, int tid, int wid) const {
        const float* s0; unsigned char* d; addr(j, tid, s0, d);
        __builtin_amdgcn_global_load_lds((const unsigned*)s0, (PG8_LAS unsigned*)(lds0 + stage + wid * 1024), 16, 0, 2);
        __builtin_amdgcn_global_load_lds((const unsigned*)(s0 + ntot), (PG8_LAS unsigned*)(lds0 + stage + 8192 + wid * 1024), 16, 0, 2);
    }
    __device__ __forceinline__ void read(v4i_t& t0, v4i_t& t1, int tid, unsigned ldsb) const {
        asm volatile("ds_read_b128 %0, %1" : "=&v"(t0) : "v"(ldsb + stage + 16u * (unsigned)tid) : "memory");
        asm volatile("ds_read_b128 %0, %1" : "=&v"(t1) : "v"(ldsb + stage + 8192u + 16u * (unsigned)tid) : "memory");
    }
    __device__ __forceinline__ void finish(v4i_t& t0, v4i_t& t1, int j, int tid) const {
        asm volatile("" : "+v"(t0), "+v"(t1));
        const float* s0; unsigned char* d; addr(j, tid, s0, d);
        const f32x4 r0 = __builtin_bit_cast(f32x4, t0) * 64.f, r1 = __builtin_bit_cast(f32x4, t1) * 64.f;
        int w0 = 0, w1 = 0; w0 = __builtin_amdgcn_cvt_pk_fp8_f32(r0[0], r1[0], w0, false); w0 = __builtin_amdgcn_cvt_pk_fp8_f32(r0[1], r1[1], w0, true);
        w1 = __builtin_amdgcn_cvt_pk_fp8_f32(r0[2], r1[2], w1, false); w1 = __builtin_amdgcn_cvt_pk_fp8_f32(r0[3], r1[3], w1, true);
        typedef int v2is __attribute__((ext_vector_type(2))); __builtin_nontemporal_store((v2is){w0, w1}, (v2is*)d);
    }
};
template <class Epi, class Sched, bool ALIGN_EPI = false, bool SP2 = false, bool FP8 = false, bool BPAIR = false, class Side = NoSide>
__device__ __forceinline__ void gemm_phase(PG8_LAS unsigned char* lds, const Gemm g, const Sched& S, const Epi& E, const Side SD = Side{}) {
    const int tid = threadIdx.x, wid = __builtin_amdgcn_readfirstlane(tid >> 6), lane = tid & 63, wr = wid >> 2, wc = wid & 3, fr = lane & 15, fq = lane >> 4;
    const int K = g.K, nt = K / BK;
    int fp8_scale1 = 0x7f7f7f7f; if constexpr (FP8) asm volatile("" : "+v"(fp8_scale1));
    unsigned voffA[2], voffB[2];
#pragma unroll
    for (int i = 0; i < 2; ++i) { int R, C; stage_rc(tid * 16 + i * 8192, R, C); const int Rb = Epi::PERM ? ((R & ~31) + perm32(R & 31)) : R;
        voffA[i] = (unsigned)(R * K + C) * 2u; voffB[i] = (unsigned)(Rb * K + C) * 2u;
        if constexpr (BPAIR) { const int b_ = tid * 16 + i * 8192, kp_ = b_ >> 8, sl_ = (b_ & 255) >> 4, pc_ = sl_ ^ (2 * ((kp_ & 3) | (((kp_ >> 3) & 1) << 2))); voffB[i] = (unsigned)(kp_ * g.b_ntot + 8 * pc_) * 2u; } }
    const size_t kstep = (size_t)(BK * 2);
    const size_t hstep = (size_t)HALF * K * 2;
    const size_t tstep = 2 * hstep;
    const size_t kstepB = BPAIR ? (size_t)64 * g.b_ntot * 2 : kstep, hstepB = BPAIR ? (size_t)g.b_hstep : hstep;
    const unsigned ldsw = (unsigned)wid * 1024u;
    const int aoff = lds_byte(wr * 64 + fr, fq * 8), boff = lds_byte(wc * 32 + fr, fq * 8);
    const int boffP = (8 * fq + ((lane & 15) >> 2)) * 256 + 16 * ((4 * wc + (lane & 3)) ^ (2 * (((lane & 15) >> 2) | ((fq & 1) << 2))));
#define PG8_SA(b, h) (((b) * 2 + (h)) * HTB)
#define PG8_SB(b, h) ((4 + (b) * 2 + (h)) * HTB)
#define PG8_STAGE(bufoff, gbase, voff) do { _Pragma("unroll") for (int _i = 0; _i < 2; ++_i) \
        __builtin_amdgcn_global_load_lds((const unsigned*)((const char*)(gbase) + (voff)[_i]), (PG8_LAS unsigned*)(lds + (bufoff) + ldsw + _i * 8192), 16, 0, 0); } while (0)
#define PG8_LDA(dst, b, h) do { _Pragma("unroll") for (int m = 0; m < 4; ++m) _Pragma("unroll") for (int k = 0; k < 2; ++k) dst[m][k] = *(const PG8_LAS bf16x8*)(lds + PG8_SA(b, h) + aoff + m * 2048 + k * 1024); } while (0)
#define PG8_TRA(dstv, addr, off) asm volatile("ds_read_b64_tr_b16 %0, %1 offset:%c2" : "=&v"(dstv) : "v"(addr), "i"(off) : "memory")
#define PG8_LDB(dst, b, h) do { if constexpr (BPAIR) { _Pragma("unroll") for (int n = 0; n < 2; ++n) { const unsigned a_ = ldsb32 + (unsigned)(PG8_SB(b, h) + boffP + 8 * n); \
            PG8_TRA(dst##r[n][0], a_, 0); PG8_TRA(dst##r[n][1], a_, 1024); PG8_TRA(dst##r[n][2], a_, 8192); PG8_TRA(dst##r[n][3], a_, 9216); } } \
        else { _Pragma("unroll") for (int n = 0; n < 2; ++n) _Pragma("unroll") for (int k = 0; k < 2; ++k) dst[n][k] = *(const PG8_LAS bf16x8*)(lds + PG8_SB(b, h) + boff + n * 2048 + k * 1024); } } while (0)
#define PG8_FIXB(dst) do { if constexpr (BPAIR) { _Pragma("unroll") for (int n = 0; n < 2; ++n) { \
            asm volatile("" : "+v"(dst##r[n][0]), "+v"(dst##r[n][1]), "+v"(dst##r[n][2]), "+v"(dst##r[n][3])); \
            dst[n][0] = __builtin_bit_cast(bf16x8, (v4i_t){dst##r[n][0][0], dst##r[n][0][1], dst##r[n][1][0], dst##r[n][1][1]}); dst[n][1] = __builtin_bit_cast(bf16x8, (v4i_t){dst##r[n][2][0], dst##r[n][2][1], dst##r[n][3][0], dst##r[n][3][1]}); } } } while (0)
#define PG8_MMA(ai, bj, At, Bt) do { __builtin_amdgcn_s_setprio(1); _Pragma("unroll") for (int m = 0; m < 4; ++m) _Pragma("unroll") for (int n = 0; n < 2; ++n) { \
        if constexpr (FP8) { mfma_fp8(acc[ai][bj][m][n], cat8(Bt[n][0], Bt[n][1]), cat8(At[m][0], At[m][1]), fp8_scale1); } \
        else { _Pragma("unroll") for (int k = 0; k < 2; ++k) acc[ai][bj][m][n] = __builtin_amdgcn_mfma_f32_16x16x32_bf16(Bt[n][k], At[m][k], acc[ai][bj][m][n], 0, 0, 0); } } \
        __builtin_amdgcn_s_setprio(0); } while (0)
#define PG8_WAIT_V(n) asm volatile("s_waitcnt vmcnt(" #n ")" ::: "memory")
#define PG8_WAIT_L(n) asm volatile("s_waitcnt lgkmcnt(" #n ")" ::: "memory")
#define PG8_BAR __builtin_amdgcn_s_barrier()
#define PG8_SCHED __builtin_amdgcn_sched_barrier(0)
    Unit cur, nxt; int ui = 0;
    if (!S.next(0, cur)) return;
    f32x4 acc[2][2][4][2];
#pragma unroll
    for (int a = 0; a < 2; ++a)
#pragma unroll
        for (int b = 0; b < 2; ++b)
#pragma unroll
            for (int m = 0; m < 4; ++m)
#pragma unroll
                for (int n = 0; n < 2; ++n) acc[a][b][m][n] = (f32x4){0.f, 0.f, 0.f, 0.f};
    bf16x8 At[4][2], B0[2][2], B1[2][2];
    int sj = 0; bool spend = false; v4i_t st0 = {0, 0, 0, 0}, st1 = st0; PG8_LAS unsigned char* const lds0 = lds;
    v2i_t B0r[2][4], B1r[2][4]; const unsigned ldsb32 = (unsigned)(size_t)lds;
    const char* cA = (const char*)g.A + (size_t)cur.pm * tstep; const char* cB = (const char*)g.Bt + (BPAIR ? (size_t)cur.boff : (size_t)cur.pn * tstep);
    S.a_ready(cur);
    if constexpr (SP2) {
        PG8_STAGE(PG8_SB(0, 0), cB, voffB); PG8_STAGE(PG8_SB(0, 1), cB + hstepB, voffB); PG8_STAGE(PG8_SA(0, 0), cA, voffA); PG8_STAGE(PG8_SA(0, 1), cA + hstep, voffA);
        if (wr == 1) PG8_BAR;
        PG8_WAIT_V(2); PG8_BAR;
        PG8_STAGE(PG8_SB(1, 0), cB + kstepB, voffB); PG8_STAGE(PG8_SA(1, 0), cA + kstep, voffA); PG8_STAGE(PG8_SB(1, 1), cB + hstepB + kstepB, voffB);
        PG8_WAIT_V(6); PG8_BAR;
    } else {
        PG8_STAGE(PG8_SB(0, 0), cB, voffB); PG8_STAGE(PG8_SA(0, 0), cA, voffA); PG8_STAGE(PG8_SB(0, 1), cB + hstepB, voffB); PG8_STAGE(PG8_SA(0, 1), cA + hstep, voffA);
        if (wr == 1) PG8_BAR;
        PG8_WAIT_V(4); PG8_BAR;
        PG8_STAGE(PG8_SB(1, 0), cB + kstepB, voffB); PG8_STAGE(PG8_SA(1, 0), cA + kstep, voffA); PG8_STAGE(PG8_SB(1, 1), cB + hstepB + kstepB, voffB);
        PG8_WAIT_V(6); PG8_BAR;
    }
    for (;;) {
        const bool has_next = S.next(ui + 1, nxt);
        const char* nA = has_next ? (const char*)g.A + (size_t)nxt.pm * tstep : cA; const char* nB = has_next ? (const char*)g.Bt + (BPAIR ? (size_t)nxt.boff : (size_t)nxt.pn * tstep) : cB;
        for (int t = 0; t < nt; t += 2) {
            const bool last = (t == nt - 2);
            const char* a1 = cA + (size_t)(t + 1) * kstep;
            const char* a2 = last ? nA : cA + (size_t)(t + 2) * kstep; const char* b2 = last ? nB : cB + (size_t)(t + 2) * kstepB;
            const char* a3 = a2 + kstep; const char* b3 = b2 + kstepB;
            if (last && has_next) S.a_ready(nxt);
            if constexpr (SP2) {
            PG8_LDB(B0, 0, 0); PG8_LDB(B1, 0, 1); PG8_SCHED; PG8_LDA(At, 0, 0); PG8_STAGE(PG8_SA(1, 1), a1 + hstep, voffA);
            PG8_WAIT_V(8);
            if constexpr (Side::ON) { if (spend) SD.read(st0, st1, tid, (unsigned)(size_t)lds); }
            PG8_WAIT_L(0); PG8_FIXB(B0); PG8_FIXB(B1);
            if constexpr (Side::ON) { if (spend) { SD.finish(st0, st1, sj - 1, tid); spend = false; } if (sj < SD.njobs) { SD.issue(lds0, sj, tid, wid); ++sj; spend = true; } }
            PG8_BAR; PG8_MMA(0, 0, At, B0); PG8_MMA(0, 1, At, B1); PG8_BAR; PG8_SCHED;
            PG8_LDA(At, 0, 1); PG8_STAGE(PG8_SB(0, 0), b2, voffB); PG8_STAGE(PG8_SB(0, 1), b2 + hstepB, voffB); PG8_STAGE(PG8_SA(0, 0), a2, voffA);
            PG8_WAIT_V(8); PG8_WAIT_L(0); PG8_BAR; if (!(FP8 && cur.rows <= HALF)) { PG8_MMA(1, 0, At, B0); PG8_MMA(1, 1, At, B1); } PG8_BAR; PG8_SCHED;
            PG8_LDB(B0, 1, 0); PG8_LDB(B1, 1, 1); PG8_SCHED; PG8_LDA(At, 1, 0); PG8_STAGE(PG8_SA(0, 1), a2 + hstep, voffA);
            PG8_WAIT_V(8);
            if constexpr (Side::ON) { if (Side::TWO && spend) SD.read(st0, st1, tid, (unsigned)(size_t)lds); }
            PG8_WAIT_L(0); PG8_FIXB(B0); PG8_FIXB(B1);
            if constexpr (Side::ON) { if (Side::TWO) { if (spend) { SD.finish(st0, st1, sj - 1, tid); spend = false; } if (sj < SD.njobs) { SD.issue(lds0, sj, tid, wid); ++sj; spend = true; } } }
            PG8_BAR; PG8_MMA(0, 0, At, B0); PG8_MMA(0, 1, At, B1); PG8_BAR; PG8_SCHED;
            PG8_LDA(At, 1, 1); PG8_STAGE(PG8_SB(1, 0), b3, voffB); PG8_STAGE(PG8_SB(1, 1), b3 + hstepB, voffB); PG8_STAGE(PG8_SA(1, 0), a3, voffA);
            PG8_WAIT_V(8); PG8_WAIT_L(0); PG8_BAR; if (!(FP8 && cur.rows <= HALF)) { PG8_MMA(1, 0, At, B0); PG8_MMA(1, 1, At, B1); } PG8_BAR; PG8_SCHED;
            } else {
            PG8_LDB(B0, 0, 0); PG8_SCHED; PG8_LDA(At, 0, 0); PG8_STAGE(PG8_SA(1, 1), a1 + hstep, voffA);
            PG8_WAIT_L(8); PG8_BAR; PG8_WAIT_L(0); PG8_MMA(0, 0, At, B0); PG8_BAR; PG8_SCHED;
            PG8_LDB(B1, 0, 1); PG8_STAGE(PG8_SB(0, 0), b2, voffB);
            PG8_BAR; PG8_WAIT_L(0); PG8_MMA(0, 1, At, B1); PG8_BAR;
            PG8_LDA(At, 0, 1); PG8_STAGE(PG8_SA(0, 0), a2, voffA);
            PG8_BAR; PG8_WAIT_L(0); PG8_MMA(1, 0, At, B0); PG8_BAR; PG8_SCHED;
            PG8_STAGE(PG8_SB(0, 1), b2 + hstepB, voffB);
            PG8_WAIT_V(6); PG8_BAR; PG8_MMA(1, 1, At, B1); PG8_BAR;
            PG8_LDB(B0, 1, 0); PG8_SCHED; PG8_LDA(At, 1, 0); PG8_STAGE(PG8_SA(0, 1), a2 + hstep, voffA);
            PG8_WAIT_L(8); PG8_BAR; PG8_WAIT_L(0); PG8_MMA(0, 0, At, B0); PG8_BAR; PG8_SCHED;
            PG8_LDB(B1, 1, 1); PG8_STAGE(PG8_SB(1, 0), b3, voffB);
            PG8_BAR; PG8_WAIT_L(0); PG8_MMA(0, 1, At, B1); PG8_BAR;
            PG8_LDA(At, 1, 1); PG8_STAGE(PG8_SA(1, 0), a3, voffA);
            PG8_BAR; PG8_WAIT_L(0); PG8_MMA(1, 0, At, B0); PG8_BAR; PG8_SCHED;
            PG8_STAGE(PG8_SB(1, 1), b3 + hstepB, voffB);
            PG8_WAIT_V(6); PG8_BAR; PG8_MMA(1, 1, At, B1); PG8_BAR;
            }
        }
        if constexpr (ALIGN_EPI) { if (wr == 0) PG8_BAR; }
        if constexpr (FP8) asm volatile("s_nop 15\n\ts_nop 15" ::: "memory");
        if constexpr (!Epi::AFTER_DRAIN) { int tz = threadIdx.x; asm volatile("" : "+v"(tz));
            const int wz = __builtin_amdgcn_readfirstlane(tz >> 6), lz = tz & 63; E(acc, cur, wz >> 2, wz & 3, lz & 15, lz >> 4); S.done(cur); }
        if (!has_next) break;
#pragma unroll
        for (int a = 0; a < 2; ++a)
#pragma unroll
            for (int b = 0; b < 2; ++b)
#pragma unroll
                for (int m = 0; m < 4; ++m)
#pragma unroll
                    for (int n = 0; n < 2; ++n) acc[a][b][m][n] = (f32x4){0.f, 0.f, 0.f, 0.f};
        cur = nxt; cA = nA; cB = nB; ++ui;
        if constexpr (ALIGN_EPI) { if (wr == 1) PG8_BAR; }
    }
    PG8_WAIT_V(0);
    if constexpr (!ALIGN_EPI) { if (wr == 0) PG8_BAR; }
    PG8_BAR;
    if constexpr (Side::ON) { if (spend) { SD.read(st0, st1, tid, (unsigned)(size_t)lds); PG8_WAIT_L(0); SD.finish(st0, st1, sj - 1, tid); spend = false; } }
    if constexpr (Epi::AFTER_DRAIN) { E.fused(acc, cur, wr, wc, fr, fq, lds, wid, lane); S.done(cur); }
#undef PG8_SA
#undef PG8_SB
#undef PG8_STAGE
#undef PG8_LDA
#undef PG8_LDB
#undef PG8_TRA
#undef PG8_FIXB
#undef PG8_MMA
#undef PG8_WAIT_V
#undef PG8_WAIT_L
#undef PG8_BAR
#undef PG8_SCHED
}
}
#define GAS __attribute__((address_space(1)))
#define LAS __attribute__((address_space(3)))
typedef unsigned short bf16;
typedef unsigned v4u __attribute__((ext_vector_type(4)));
typedef float f32x4 __attribute__((ext_vector_type(4)));
typedef short bf16x8 __attribute__((ext_vector_type(8)));
typedef GAS unsigned gu32;
typedef GAS unsigned long long gu64;
#define RLX_AGENT __ATOMIC_RELAXED, __HIP_MEMORY_SCOPE_AGENT
#define LDS_WAIT() asm volatile("s_waitcnt lgkmcnt(0)" ::: "memory")
#define VM_WAIT() asm volatile("s_waitcnt vmcnt(0)" ::: "memory")
__device__ __forceinline__ unsigned long long rt() { return __builtin_amdgcn_s_memrealtime(); }
__device__ __forceinline__ unsigned f2bf(float f) { unsigned u = __builtin_bit_cast(unsigned, f); return (u + 0x7fffu + ((u >> 16) & 1u)) >> 16; }
__device__ __forceinline__ unsigned pk2(float lo, float hi) { return f2bf(lo) | (f2bf(hi) << 16); }

#define XB_TMO      128
#define XB_XCNT(j)  (256  + 64 * (j))
#define XB_XSUB(j)  (1280 + 64 * (j))
#define XB_XGEN(j)  (2304 + 64 * (j))
#define XB_TOP      3328
#define XB_TOPGEN   3392
#define XCD_BAR_WORDS 3456
#define XB_SPIN_CAP (1u << 18)

__device__ __forceinline__ unsigned xb_ld(unsigned* p)              { return __hip_atomic_load(p, __ATOMIC_RELAXED, __HIP_MEMORY_SCOPE_AGENT); }
__device__ __forceinline__ unsigned xb_add(unsigned* p, unsigned v) { return __hip_atomic_fetch_add(p, v, __ATOMIC_RELAXED, __HIP_MEMORY_SCOPE_AGENT); }
__device__ __forceinline__ unsigned xb_xcc_id() { return (unsigned)__builtin_amdgcn_s_getreg((3 << 11) | 20) & 0xFu; }
#define XB_SPIN(cond, bar) do { unsigned _sp = 0; while (cond) { __builtin_amdgcn_s_sleep(1); \
    if ((++_sp & 255u) == 0u) { if (xb_ld(&(bar)[XB_TMO])) break; if (_sp > XB_SPIN_CAP) { atomicAdd(&(bar)[XB_TMO], 1u); break; } } } } while (0)

struct XcdBarrier {
    unsigned* bar; unsigned x;
    volatile LAS unsigned* st;
};

__device__ __forceinline__ XcdBarrier xcd_barrier_post(unsigned* bar, volatile LAS unsigned* st) {
    XcdBarrier b; b.bar = bar; b.x = xb_xcc_id(); b.st = st;
    if (threadIdx.x == 0) (void)xb_add(&bar[XB_XCNT(b.x)], 1u);
    return b;
}
__device__ __forceinline__ void xcd_barrier_complete(unsigned* bar, unsigned x, unsigned& nloc, unsigned& nx) {
    const unsigned G = gridDim.x * gridDim.y * gridDim.z;
    unsigned sum, cnt, mine, sp = 0u;
    for (;;) {
        sum = 0u; cnt = 0u; mine = 0u;
#pragma unroll
        for (unsigned j = 0; j < 16; ++j) { const unsigned c = xb_ld(&bar[XB_XCNT(j)]); sum += c; cnt += (c > 0u) ? 1u : 0u; mine = (j == x) ? c : mine; }
        if (sum == G) break;
        __builtin_amdgcn_s_sleep(1);
        if ((++sp & 255u) == 0u) { if (xb_ld(&bar[XB_TMO])) break; if (sp > XB_SPIN_CAP) { atomicAdd(&bar[XB_TMO], 1u); break; } }
    }
    nloc = mine > 0u ? mine : 1u; nx = cnt > 0u ? cnt : 1u;
}

__device__ __forceinline__ void xcd_barrier(const XcdBarrier& b) {
    asm volatile("s_waitcnt vmcnt(0)" ::: "memory");
    __syncthreads();
    if (threadIdx.x == 0) {
        unsigned* bar = b.bar;
        __builtin_amdgcn_s_waitcnt(0);
        unsigned nloc = b.st[0], nx = b.st[1];
        if (nloc == 0u) { xcd_barrier_complete(bar, b.x, nloc, nx); b.st[0] = nloc; b.st[1] = nx; }
        const unsigned old = xb_add(&bar[XB_XSUB(b.x)], 1u);
        const unsigned gen = old / nloc;
        if (old + 1u == (gen + 1u) * nloc) {
            __builtin_amdgcn_fence(__ATOMIC_RELEASE, "agent");
            asm volatile("s_waitcnt vmcnt(0)" ::: "memory");
            const unsigned og = xb_add(&bar[XB_TOP], 1u);
            const unsigned tg = og / nx;
            if (og + 1u == (tg + 1u) * nx) xb_add(&bar[XB_TOPGEN], 1u);
            else XB_SPIN(xb_ld(&bar[XB_TOPGEN]) == tg, bar);
            __builtin_amdgcn_fence(__ATOMIC_ACQUIRE, "agent");
            xb_add(&bar[XB_XGEN(b.x)], 1u);
            asm volatile("s_waitcnt vmcnt(0)" ::: "memory");
        } else {
            XB_SPIN(xb_ld(&bar[XB_XGEN(b.x)]) == gen, bar);
            __builtin_amdgcn_fence(__ATOMIC_ACQUIRE, "agent");
            asm volatile("s_waitcnt vmcnt(0)" ::: "memory");
        }
    }
    __syncthreads();
}

constexpr int NB = 4, SEQ = 2048, DM = 2048, NTOK = NB * SEQ, INC = 6144, CW = 512, AW = 1536, NH = 24, HD = 64, NE = 32, TOPK = 4, DE = 2048;
constexpr int QOFF = 1536, KOFF = 3072, VOFF = 4608;
constexpr int MAXSLOT = NE * NTOK;
constexpr float EPS = 1e-5f;
typedef unsigned u32x2v __attribute__((ext_vector_type(2)));
constexpr int NWAVES = 8;
#ifndef MK_N_LAUNCHES
#define MK_N_LAUNCHES 1
#endif
#ifndef PROBE_MASK
#define PROBE_MASK 0
#endif
#define REPS(k) (((PROBE_MASK >> (k)) & 1) ? 2 : 1)
constexpr int NPH = 10;

constexpr size_t MiB = 1u << 20;
constexpr size_t WS_CTL = 0, CTL_ZERO_BYTES = 1 * MiB;
constexpr size_t WS_ROPE = 1 * MiB;
constexpr size_t WS_TOKE = 2 * MiB, WS_TOKR = WS_TOKE + 128 * 1024, WS_TOKG = WS_TOKR + 128 * 1024;
constexpr size_t WS_LIST = 3 * MiB;
constexpr size_t WS_WIN = 8 * MiB;
constexpr size_t WS_WO = 32 * MiB;
constexpr size_t WS_XN = 40 * MiB;
constexpr size_t WS_PROJ = 72 * MiB;
constexpr size_t WS_YATT = 168 * MiB;
constexpr size_t WS_MIXED = 192 * MiB;
constexpr size_t WS_X1 = 224 * MiB;
constexpr size_t WS_XN2 = 288 * MiB;
constexpr size_t WS_XS = 320 * MiB;
constexpr size_t WS_ACT = 832 * MiB;
constexpr size_t WS_Y = 1344 * MiB;
constexpr size_t WS_WGU = 2368 * MiB;
constexpr size_t WS_WDN = 2624 * MiB;
constexpr size_t WS_END = 2752 * MiB;
constexpr int CW_TMO = 0, CW_CODE = 1;
constexpr int CW_BAR = 4096;
constexpr int CW_CNT = 8192;
constexpr int CW_ATTQ = 12288;
constexpr int CW_CONVQ = 12288 + 4096;
constexpr int CW_P1DONE = 12288 + 8192;
#ifndef ATT_ITEM
#define ATT_ITEM item2
#endif
#ifndef ATT_NOFALL
#define ATT_NOFALL 1
#endif
#ifndef ATT_JOIN
#define ATT_JOIN 0
#endif
#ifndef SIDE_CONV
#define SIDE_CONV 3
#endif
#ifndef SPLIT_P1
#define SPLIT_P1 0
#endif
#ifndef FUSED2
#define FUSED2 0
#endif
#ifndef FUSED_CONV
#define FUSED_CONV 0
#endif
#ifndef ATT_WAVES
#define ATT_WAVES 6
#endif
constexpr int RING_BYTES = 131072;
constexpr int LDSCTL_OFF = RING_BYTES;
constexpr int MISC_OFF = LDSCTL_OFF + 320;
constexpr int TAB_TS = LDSCTL_OFF + 1024;
constexpr int TAB_CN = LDSCTL_OFF + 1024 + 256;
constexpr int PART_OFF = RING_BYTES + 16384;
constexpr int LDS_BYTES = 163840;

__device__ __forceinline__ float wave_sum(float v) {
#pragma unroll
    for (int o = 1; o < 64; o <<= 1) v += __shfl_xor(v, o);
    return v;
}
__device__ __forceinline__ float bf_lo(unsigned w) { return __uint_as_float(w << 16); }
__device__ __forceinline__ float bf_hi(unsigned w) { return __uint_as_float(w & 0xffff0000u); }

__device__ __forceinline__ void p0_transpose_item(const float* W, int N, int K, bf16* WT, int k0, int n0, int out_row0, LAS float* scr, int lane) {
#pragma unroll 8
    for (int i = 0; i < 32; ++i) { const int kk = 2 * i + (lane >> 5); scr[kk * 33 + (lane & 31)] = __builtin_nontemporal_load(W + (size_t)(k0 + kk) * N + n0 + (lane & 31)); }
    LDS_WAIT(); asm volatile("" ::: "memory");
    const int c = lane & 7;
#pragma unroll
    for (int j = 0; j < 4; ++j) { const int n = (lane >> 3) + 8 * j; const LAS float* s = scr + (8 * c) * 33 + n;
        v4u o; o.x = pk2(s[0 * 33], s[1 * 33]); o.y = pk2(s[2 * 33], s[3 * 33]); o.z = pk2(s[4 * 33], s[5 * 33]); o.w = pk2(s[6 * 33], s[7 * 33]);
        *(GAS v4u*)(WT + (size_t)(out_row0 + n) * K + k0 + 8 * c) = o; }
    LDS_WAIT(); asm volatile("" ::: "memory");
}

__device__ __forceinline__ void p0_transpose_item_fp8(const float* W, int N, int K, unsigned char* WT, int k0, int n0, int out_row0, float scale, LAS float* scr, int lane) {
#pragma unroll 8
    for (int i = 0; i < 32; ++i) { const int kk = 2 * i + (lane >> 5); scr[kk * 33 + (lane & 31)] = W[(size_t)(k0 + kk) * N + n0 + (lane & 31)]; }
    LDS_WAIT(); asm volatile("" ::: "memory");
    const int c = lane & 3;
#pragma unroll
    for (int j = 0; j < 2; ++j) { const int n = (lane >> 2) + 16 * j; const LAS float* s = scr + (16 * c) * 33 + n;
        v4u o;
        o.x = pg8::pk4_fp8(scale * s[0 * 33], scale * s[1 * 33], scale * s[2 * 33], scale * s[3 * 33]);
        o.y = pg8::pk4_fp8(scale * s[4 * 33], scale * s[5 * 33], scale * s[6 * 33], scale * s[7 * 33]);
        o.z = pg8::pk4_fp8(scale * s[8 * 33], scale * s[9 * 33], scale * s[10 * 33], scale * s[11 * 33]);
        o.w = pg8::pk4_fp8(scale * s[12 * 33], scale * s[13 * 33], scale * s[14 * 33], scale * s[15 * 33]);
        *(GAS v4u*)(WT + (size_t)(out_row0 + n) * K + k0 + 16 * c) = o; }
    LDS_WAIT(); asm volatile("" ::: "memory");
}

__device__ __forceinline__ unsigned pk4_fp8_nc(float a, float b, float c, float d) { int w = 0; w = __builtin_amdgcn_cvt_pk_fp8_f32(a, b, w, false); w = __builtin_amdgcn_cvt_pk_fp8_f32(c, d, w, true); return (unsigned)w; }
struct ConvDesc { const float* src; unsigned char* dstb; int N, isdn; };
constexpr int CV_NG = 16, PER_E = 256 + 128, NCONV = 32 * PER_E;
__device__ __forceinline__ ConvDesc conv_decode(int it, const float* w_gu, const float* w_dn, unsigned char* WGU, unsigned char* WDN, int lane) {
    const int e = it / PER_E, r = it - e * PER_E; ConvDesc d;
    if (r < 256) { const int kp0 = 4 * r; d.N = 4096; d.isdn = 0; d.src = w_gu + (size_t)e * 2048 * 4096 + (size_t)(2 * kp0) * 4096 + 4 * lane; d.dstb = WGU + (size_t)e * 1024 * 8192 + (size_t)kp0 * 8192 + 8 * lane; }
    else { const int kp0 = 8 * (r - 256); d.N = 2048; d.isdn = 1; d.src = w_dn + (size_t)e * 2048 * 2048 + (size_t)(2 * kp0) * 2048 + 4 * lane; d.dstb = WDN + (size_t)e * 1024 * 4096 + (size_t)kp0 * 4096 + 8 * lane; }
    return d;
}
#define CV_LOAD(R, D, g) do { const int ro_ = (D).isdn ? 4 * ((g) >> 3) : 0, co_ = (D).isdn ? 256 * ((g) & 7) : 256 * (g); \
        _Pragma("unroll") for (int t_ = 0; t_ < 4; ++t_) _Pragma("unroll") for (int i_ = 0; i_ < 2; ++i_) R[2 * t_ + i_] = __builtin_nontemporal_load((const GAS f32x4*)((D).src + (size_t)(2 * (ro_ + t_) + i_) * (D).N + co_)); } while (0)
#define CV_PROC(R, D, g) do { const int ro_ = (D).isdn ? 4 * ((g) >> 3) : 0, co_ = (D).isdn ? 256 * ((g) & 7) : 256 * (g); \
        _Pragma("unroll") for (int t_ = 0; t_ < 4; ++t_) { u32x2v o_; \
            o_.x = pk4_fp8_nc(pg8::FP8_W_SCALE * R[2 * t_][0], pg8::FP8_W_SCALE * R[2 * t_ + 1][0], pg8::FP8_W_SCALE * R[2 * t_][1], pg8::FP8_W_SCALE * R[2 * t_ + 1][1]); \
            o_.y = pk4_fp8_nc(pg8::FP8_W_SCALE * R[2 * t_][2], pg8::FP8_W_SCALE * R[2 * t_ + 1][2], pg8::FP8_W_SCALE * R[2 * t_][3], pg8::FP8_W_SCALE * R[2 * t_ + 1][3]); \
            __builtin_nontemporal_store(o_, (GAS u32x2v*)((D).dstb + (size_t)(ro_ + t_) * (D).N * 2 + 2 * co_)); } } while (0)

namespace att {
typedef short s16x8 __attribute__((ext_vector_type(8)));
typedef short s16x4 __attribute__((ext_vector_type(4)));
typedef float f32x16 __attribute__((ext_vector_type(16)));
typedef unsigned u32x4 __attribute__((ext_vector_type(4)));
constexpr int VP = 144;
constexpr int WAVE_LDS = 32 * VP;
constexpr float C2 = 0.125f * 1.4426950408889634f;
constexpr int NITEMS = 16 * NB * NH * 4;
typedef short v4i16_t __attribute__((ext_vector_type(4)));
__device__ __forceinline__ s16x4 vtr(LAS const char* p) { return __builtin_bit_cast(s16x4, __builtin_amdgcn_ds_read_tr16_b64_v4i16((LAS v4i16_t*)p)); }

struct TileD { int abase, kp_off, kp_mul, W, mod4, sel; };
__device__ __forceinline__ TileD tile_desc(int u, int n1, int n2, int first1, int first2, int m0, int r4) {
    TileD d;
    if (u < n1) { d.abase = 4 * m0 - 128 + 32 * (first1 + u); d.kp_off = 0; d.kp_mul = 1; d.W = 128; d.mod4 = 0; d.sel = 0; }
    else if (u < n1 + n2) { d.abase = m0 - 128 + 32 * (first2 + u - n1); d.kp_off = r4; d.kp_mul = 4; d.W = 128; d.mod4 = 0; d.sel = 1; }
    else { d.abase = 32 * (u - n1 - n2); d.kp_off = r4; d.kp_mul = 4; d.W = 0x7fffffff; d.mod4 = 1; d.sel = 1; }
    return d;
}
#define ATT_LOADT(KF, VF, D) do { _Pragma("unroll") for (int j_ = 0; j_ < 4; ++j_) { const int pos_ = (D).kp_off + (D).kp_mul * ((D).abase + 8 * j_ + (lane >> 3)); \
        KF[j_] = *(const GAS u32x4*)(Kb + (size_t)pos_ * INC + 8 * (lane & 7)); VF[j_] = *(const GAS u32x4*)(Vb + (size_t)pos_ * INC + 8 * (lane & 7)); } } while (0)

template <int PMODE = 0>
__device__ __forceinline__ void item(int it, const bf16* PROJ, bf16* YATT, LAS char* vl, int lane) {
    const int bh = it >> 6, jj = it & 63; const int b = bh / NH, head = bh - b * NH, mb = 15 - (jj >> 2), r4 = jj & 3;
    const int m0 = mb * 32, q = lane & 31, h = lane >> 5;
    const int qpos = r4 + 4 * (m0 + q);
    const bf16* base = PROJ + (size_t)b * SEQ * INC;
    const bf16* Kb = base + KOFF + head * HD; const bf16* Vb = base + VOFF + head * HD;
    const int first1 = (mb == 0) ? 4 : 0, first2 = (mb < 4) ? 4 - mb : 0, n1 = 8 - first1, n2 = 5 - first2, ntile = n1 + n2 + mb + 1;
    u32x4 kA[4], vA[4], kB[4], vB[4];
    { const TileD d0 = tile_desc(0, n1, n2, first1, first2, m0, r4); ATT_LOADT(kA, vA, d0); }
    s16x8 qf[4];
    { const bf16* qp = base + (size_t)qpos * INC + QOFF + head * HD + 8 * h;
#pragma unroll
      for (int d0 = 0; d0 < 4; ++d0) qf[d0] = __builtin_bit_cast(s16x8, *(const GAS u32x4*)(qp + 16 * d0)); }
    f32x16 o0 = {}, o1 = {}; float mrun = -1e30f, lrun = 0.f;
    const int g = lane >> 4, qq = (lane & 15) >> 2, pp = lane & 3;
    LAS const char* vb = vl + (4 * h + qq) * VP + (16 * (g & 1) + 4 * pp) * 2;
    LAS char* kl = vl + WAVE_LDS;
    LAS u32x4* vd = (LAS u32x4*)(vl + (lane >> 3) * VP + (lane & 7) * 16);
    LAS u32x4* kd = (LAS u32x4*)(kl + (lane >> 3) * VP + (lane & 7) * 16);
    LAS const char* kfp = kl + (lane & 31) * VP + h * 16;
#pragma unroll 1
    for (int u = 0; u < ntile; ++u) {
        const TileD d = tile_desc(u, n1, n2, first1, first2, m0, r4);
        if (PMODE != 1) { const int un = (u + 1 < ntile) ? u + 1 : u; const TileD dn = tile_desc(un, n1, n2, first1, first2, m0, r4); ATT_LOADT(kB, vB, dn); }
#pragma unroll
        for (int j = 0; j < 4; ++j) { *(LAS u32x4*)((LAS char*)kd + 8 * j * VP) = kA[j]; *(LAS u32x4*)((LAS char*)vd + 8 * j * VP) = vA[j]; }
        if (PMODE != 2) {
        f32x16 s = {};
#pragma unroll
        for (int d0 = 0; d0 < 4; ++d0) s = __builtin_amdgcn_mfma_f32_32x32x16_bf16(*(const LAS s16x8*)(kfp + 32 * d0), qf[d0], s, 0, 0, 0);
        const int bq = d.sel ? (m0 + q) : qpos;
        const int t0 = bq - d.abase - 4 * h; const unsigned W = (unsigned)d.W; const int m4 = d.mod4 ? 3 : 0;
        float mx = -INFINITY;
#pragma unroll
        for (int r = 0; r < 16; ++r) { const int dd = t0 - ((r & 3) + 8 * (r >> 2));
            const bool ok = ((unsigned)dd <= W) && ((dd & m4) == 0);
            s[r] = ok ? s[r] : -INFINITY; mx = fmaxf(mx, s[r]); }
        mx = fmaxf(mx, __shfl_xor(mx, 32));
        const float mnew = fmaxf(mrun, mx), alpha = __builtin_amdgcn_exp2f(mrun - mnew); mrun = mnew;
        float ps = 0.f;
#pragma unroll
        for (int r = 0; r < 16; ++r) { s[r] = __builtin_amdgcn_exp2f(s[r] - mnew); ps += s[r]; }
        lrun = lrun * alpha + ps;
#pragma unroll
        for (int r = 0; r < 16; ++r) { o0[r] *= alpha; o1[r] *= alpha; }
        u32x4 p0, p1;
        p0.x = pk2(s[0], s[1]); p0.y = pk2(s[2], s[3]); p0.z = pk2(s[4], s[5]); p0.w = pk2(s[6], s[7]);
        p1.x = pk2(s[8], s[9]); p1.y = pk2(s[10], s[11]); p1.z = pk2(s[12], s[13]); p1.w = pk2(s[14], s[15]);
        const s16x8 pf0 = __builtin_bit_cast(s16x8, p0), pf1 = __builtin_bit_cast(s16x8, p1);
#pragma unroll
        for (int sstep = 0; sstep < 2; ++sstep) {
#pragma unroll
            for (int dh = 0; dh < 2; ++dh) {
                const s16x4 lo = vtr(vb + (16 * sstep) * VP + dh * 64), hi = vtr(vb + (16 * sstep + 8) * VP + dh * 64);
                const s16x8 vf = (s16x8){lo[0], lo[1], lo[2], lo[3], hi[0], hi[1], hi[2], hi[3]};
                if (dh == 0) o0 = __builtin_amdgcn_mfma_f32_32x32x16_bf16(vf, sstep ? pf1 : pf0, o0, 0, 0, 0);
                else         o1 = __builtin_amdgcn_mfma_f32_32x32x16_bf16(vf, sstep ? pf1 : pf0, o1, 0, 0, 0);
            }
        }
        }
        if (PMODE == 1) continue;
#pragma unroll
        for (int c = 0; c < 4; ++c) { kA[c] = kB[c]; vA[c] = vB[c]; }
    }
    const float inv = 1.0f / (lrun + __shfl_xor(lrun, 32));
    bf16* orow = YATT + (size_t)(b * SEQ + qpos) * AW + head * HD + 4 * h;
#pragma unroll
    for (int gq = 0; gq < 4; ++gq) {
        u32x2v a, c; a.x = pk2(o0[4 * gq] * inv, o0[4 * gq + 1] * inv); a.y = pk2(o0[4 * gq + 2] * inv, o0[4 * gq + 3] * inv);
        c.x = pk2(o1[4 * gq] * inv, o1[4 * gq + 1] * inv); c.y = pk2(o1[4 * gq + 2] * inv, o1[4 * gq + 3] * inv);
        *(u32x2v*)(orow + 8 * gq) = a; *(u32x2v*)(orow + 32 + 8 * gq) = c; }
}

__device__ __forceinline__ int krp(int key) { return (key & 0x16) | ((key >> 3) & 1) | ((key & 1) << 3); }
__device__ __forceinline__ void item2(int it, const bf16* PROJ, bf16* YATT, LAS char* wl, int lane) {
    const int bh = it >> 6, jj = it & 63; const int b = bh / NH, head = bh - b * NH, mb = 15 - (jj >> 2), r4 = jj & 3;
    const int m0 = mb * 32, q = lane & 31, h = lane >> 5;
    const int qpos = r4 + 4 * (m0 + q), bq2 = m0 + q;
    const bf16* base = PROJ + (size_t)b * SEQ * INC;
    const bf16* Kb = base + KOFF + head * HD; const bf16* Vb = base + VOFF + head * HD;
    const int first1 = (mb == 0) ? 4 : 0, first2 = (mb < 4) ? 4 - mb : 0, n1 = 8 - first1, n2 = 5 - first2, ntile = n1 + n2 + mb + 1, npair = (ntile + 1) >> 1;
    u32x4 k0[4], v0[4], k1[4], v1[4];
    { const TileD d0 = tile_desc(0, n1, n2, first1, first2, m0, r4); ATT_LOADT(k0, v0, d0); }
    { const TileD d1 = tile_desc(ntile > 1 ? 1 : 0, n1, n2, first1, first2, m0, r4); ATT_LOADT(k1, v1, d1); }
    s16x8 qf[4];
    { const bf16* qp = base + (size_t)qpos * INC + QOFF + head * HD + 8 * h;
#pragma unroll
      for (int d0 = 0; d0 < 4; ++d0) qf[d0] = __builtin_bit_cast(s16x8, *(const GAS u32x4*)(qp + 16 * d0)); }
    f32x16 o0 = {}, o1 = {}; float mrun = -1e30f, lrun = 0.f;
    const int g = lane >> 4, qq = (lane & 15) >> 2, pp = lane & 3;
    int kws[4];
#pragma unroll
    for (int j = 0; j < 4; ++j) { const int key = 8 * j + (lane >> 3); kws[j] = krp(key) * 128 + (((lane & 7) ^ (key & 7)) << 4); }
    const int vws = (lane >> 3) * 128 + (lane & 7) * 16;
    const int kfr = krp(q) * 128, kx = q & 7;
    const int vfr = (4 * h + qq) * 128 + (16 * (g & 1) + 4 * pp) * 2;
#define ATT2_MASK(S, D, T0) do { if ((D).mod4) { _Pragma("unroll") for (int r = 0; r < 16; ++r) { const int dd = (T0) - ((r & 3) + 8 * (r >> 2)); S[r] = (dd >= 0 && (dd & 3) == 0) ? S[r] : -INFINITY; mx = fmaxf(mx, S[r]); } } \
        else { const unsigned W_ = (unsigned)(D).W; _Pragma("unroll") for (int r = 0; r < 16; ++r) { const int dd = (T0) - ((r & 3) + 8 * (r >> 2)); S[r] = ((unsigned)dd <= W_) ? S[r] : -INFINITY; mx = fmaxf(mx, S[r]); } } } while (0)
#pragma unroll 1
    for (int p = 0; p < npair; ++p) {
        const bool nul1 = (2 * p + 1 >= ntile);
        const TileD dA = tile_desc(2 * p, n1, n2, first1, first2, m0, r4), dB = tile_desc(nul1 ? 2 * p : 2 * p + 1, n1, n2, first1, first2, m0, r4);
#pragma unroll
        for (int j = 0; j < 4; ++j) { *(LAS u32x4*)(wl + kws[j]) = k0[j]; *(LAS u32x4*)(wl + 4096 + vws + 1024 * j) = v0[j]; *(LAS u32x4*)(wl + 8192 + kws[j]) = k1[j]; *(LAS u32x4*)(wl + 12288 + vws + 1024 * j) = v1[j]; }
        { const int ua = (2 * p + 2 < ntile) ? 2 * p + 2 : ntile - 1, ub = (2 * p + 3 < ntile) ? 2 * p + 3 : ntile - 1;
          const TileD na = tile_desc(ua, n1, n2, first1, first2, m0, r4), nb = tile_desc(ub, n1, n2, first1, first2, m0, r4); ATT_LOADT(k0, v0, na); ATT_LOADT(k1, v1, nb); }
        f32x16 sA = {}, sB = {};
#pragma unroll
        for (int d0 = 0; d0 < 4; ++d0) { const int co = ((2 * d0 + h) ^ kx) << 4;
            sA = __builtin_amdgcn_mfma_f32_32x32x16_bf16(*(const LAS s16x8*)(wl + kfr + co), qf[d0], sA, 0, 0, 0);
            sB = __builtin_amdgcn_mfma_f32_32x32x16_bf16(*(const LAS s16x8*)(wl + 8192 + kfr + co), qf[d0], sB, 0, 0, 0); }
        const int t0A = (dA.sel ? bq2 : qpos) - dA.abase - 4 * h; const int t0B = nul1 ? -(1 << 20) : ((dB.sel ? bq2 : qpos) - dB.abase - 4 * h);
        float mx = -INFINITY;
        ATT2_MASK(sA, dA, t0A); ATT2_MASK(sB, dB, t0B);
        mx = fmaxf(mx, __shfl_xor(mx, 32));
        const float mnew = fmaxf(mrun, mx), alpha = __builtin_amdgcn_exp2f(mrun - mnew); mrun = mnew;
        float ps = 0.f;
#pragma unroll
        for (int r = 0; r < 16; ++r) { sA[r] = __builtin_amdgcn_exp2f(sA[r] - mnew); sB[r] = __builtin_amdgcn_exp2f(sB[r] - mnew); ps += sA[r] + sB[r]; }
        lrun = lrun * alpha + ps;
#pragma unroll
        for (int r = 0; r < 16; ++r) { o0[r] *= alpha; o1[r] *= alpha; }
        u32x4 pa0, pa1, pb0, pb1;
        pa0.x = pk2(sA[0], sA[1]); pa0.y = pk2(sA[2], sA[3]); pa0.z = pk2(sA[4], sA[5]); pa0.w = pk2(sA[6], sA[7]);
        pa1.x = pk2(sA[8], sA[9]); pa1.y = pk2(sA[10], sA[11]); pa1.z = pk2(sA[12], sA[13]); pa1.w = pk2(sA[14], sA[15]);
        pb0.x = pk2(sB[0], sB[1]); pb0.y = pk2(sB[2], sB[3]); pb0.z = pk2(sB[4], sB[5]); pb0.w = pk2(sB[6], sB[7]);
        pb1.x = pk2(sB[8], sB[9]); pb1.y = pk2(sB[10], sB[11]); pb1.z = pk2(sB[12], sB[13]); pb1.w = pk2(sB[14], sB[15]);
#pragma unroll
        for (int tt = 0; tt < 2; ++tt) { LAS const char* vb = wl + 4096 + 8192 * tt + vfr;
#pragma unroll
            for (int sstep = 0; sstep < 2; ++sstep) { const s16x8 pf = __builtin_bit_cast(s16x8, tt ? (sstep ? pb1 : pb0) : (sstep ? pa1 : pa0));
#pragma unroll
                for (int dh = 0; dh < 2; ++dh) {
                    const s16x4 lo = vtr(vb + (16 * sstep) * 128 + dh * 64), hi = vtr(vb + (16 * sstep + 8) * 128 + dh * 64);
                    const s16x8 vf = (s16x8){lo[0], lo[1], lo[2], lo[3], hi[0], hi[1], hi[2], hi[3]};
                    if (dh == 0) o0 = __builtin_amdgcn_mfma_f32_32x32x16_bf16(vf, pf, o0, 0, 0, 0);
                    else         o1 = __builtin_amdgcn_mfma_f32_32x32x16_bf16(vf, pf, o1, 0, 0, 0); } } }
    }
#undef ATT2_MASK
    const float inv = 1.0f / (lrun + __shfl_xor(lrun, 32));
    bf16* orow = YATT + (size_t)(b * SEQ + qpos) * AW + head * HD + 4 * h;
#pragma unroll
    for (int gq = 0; gq < 4; ++gq) {
        u32x2v a, c; a.x = pk2(o0[4 * gq] * inv, o0[4 * gq + 1] * inv); a.y = pk2(o0[4 * gq + 2] * inv, o0[4 * gq + 3] * inv);
        c.x = pk2(o1[4 * gq] * inv, o1[4 * gq + 1] * inv); c.y = pk2(o1[4 * gq + 2] * inv, o1[4 * gq + 3] * inv);
        *(u32x2v*)(orow + 8 * gq) = a; *(u32x2v*)(orow + 32 + 8 * gq) = c; }
}
}

struct Args { const float* in[15]; float* out; unsigned char* ws; int ph_lo, ph_hi; };
static_assert(sizeof(Args) == 15 * 8 + 8 + 8 + 8, "Args has no padding");

__global__ void __launch_bounds__(NWAVES * 64, 2) fwd(Args args) {
    extern __shared__ __attribute__((aligned(16))) unsigned char lds[];
    LAS unsigned char* L = (LAS unsigned char*)lds;
    volatile LAS unsigned* MISC = (volatile LAS unsigned*)(L + MISC_OFF);
    const int tid = threadIdx.x, lane = tid & 63, wave = __builtin_amdgcn_readfirstlane(tid >> 6);
    const int G = gridDim.x; const int bx = blockIdx.x; const int vcu = (G % 8 == 0) ? (bx % 8) * (G / 8) + bx / 8 : bx;
    unsigned char* ws = args.ws;
    gu32* ctl = (gu32*)(ws + WS_CTL);
    const float* x = args.in[0]; const float* mix_g = args.in[1]; const float* w_in = args.in[2]; const float* conv_w = args.in[3]; const float* conv_g = args.in[4];
    const float* attn_g = args.in[5]; const float* w_out = args.in[6]; const float* ffn_g = args.in[7]; const float* w_router = args.in[8]; const float* b_router = args.in[9];
    const float* w_gu = args.in[10]; const float* b_gu = args.in[11]; const float* w_dn = args.in[12]; const float* b_dn = args.in[13]; const float* fin_g = args.in[14];
    float* out = args.out;
    float* ROPE = (float*)(ws + WS_ROPE); unsigned char* GWF = ws + WS_ROPE + 256 * 1024;
    int* TOKE = (int*)(ws + WS_TOKE); int* TOKR = (int*)(ws + WS_TOKR); float* TOKG = (float*)(ws + WS_TOKG); int* LIST = (int*)(ws + WS_LIST);
    bf16* WIN = (bf16*)(ws + WS_WIN); bf16* WO = (bf16*)(ws + WS_WO); bf16* XN = (bf16*)(ws + WS_XN); bf16* PROJ = (bf16*)(ws + WS_PROJ); bf16* YATT = (bf16*)(ws + WS_YATT);
    bf16* MIXED = (bf16*)(ws + WS_MIXED); float* X1 = (float*)(ws + WS_X1); unsigned char* XN2 = ws + WS_XN2; unsigned char* XS = ws + WS_XS; unsigned char* ACT = ws + WS_ACT;
    bf16* YB = (bf16*)(ws + WS_Y); unsigned char* WGU = ws + WS_WGU; unsigned char* WDN = ws + WS_WDN;

    for (int u = tid; u < (LDS_BYTES - LDSCTL_OFF) / 4; u += NWAVES * 64) ((LAS unsigned*)(L + LDSCTL_OFF))[u] = 0u;
    __syncthreads();
    XcdBarrier bar; bar.bar = (unsigned*)(ctl + CW_BAR); bar.x = 0; bar.st = nullptr;
    if (MK_N_LAUNCHES == 1) bar = xcd_barrier_post((unsigned*)(ctl + CW_BAR), MISC + 8);
    const int lo = args.ph_lo, hi = args.ph_hi;
#define IN(k) (lo <= (k) && (k) < hi)
#define BOTH(k) (IN(k) && IN((k) + 1))
#define GRID_BAR() do { if (MK_N_LAUNCHES == 1) xcd_barrier(bar); } while (0)
    const int gw = vcu * NWAVES + wave, NGW = G * NWAVES;
    const bool side_on = (MK_N_LAUNCHES == 1) && (G == 256) && (SIDE_CONV != 0);

    if (IN(0)) for (int rep = 0; rep < REPS(0); ++rep) {
        LAS float* scr = (LAS float*)(L + wave * 16384);
        constexpr int I_IN = 32 * (INC / 32), I_O = 32 * (DM / 32);
        constexpr int NIT = I_IN + I_O;
        for (int it = gw; it < NIT; it += NGW) {
            int r = it;
            if (r < I_IN) { const int nblk = INC / 32, kb = r / nblk, nb = r % nblk; p0_transpose_item(w_in, INC, DM, WIN, 64 * kb, 32 * nb, 32 * nb, scr, lane); continue; } r -= I_IN;
            { const int nblk = DM / 32, kb = r / nblk, nb = r % nblk; p0_transpose_item(w_out, DM, DM, WO, 64 * kb, 32 * nb, 32 * nb, scr, lane); }
        }
        for (int i = gw * 64 + lane; i < SEQ * 8; i += NGW * 64) { const int pos = i >> 3, f = i & 7;
            const float inv_freq = exp2f(-(float)f * 0.125f * 18.931568569324174f);
            const float ang = (float)pos * inv_freq;
            const double a = (double)ang; const double k = rint(a * 0.15915494309189535); const float red = (float)(a - k * 6.283185307179586);
            ROPE[pos * 16 + f] = cosf(red); ROPE[pos * 16 + 8 + f] = sinf(red); }
        for (int i = gw * 64 + lane; i < 64 * 2 * 64; i += NGW * 64) { const int ln = i & 63, eb = (i >> 6) & 1, ks = i >> 7; const int e = 16 * eb + (ln & 15), k0 = 32 * ks + 8 * (ln >> 4);
            unsigned hi[4], lo[4];
#pragma unroll
            for (int j = 0; j < 4; ++j) { const float v0 = w_router[(size_t)(k0 + 2 * j) * NE + e] * ffn_g[k0 + 2 * j], v1 = w_router[(size_t)(k0 + 2 * j + 1) * NE + e] * ffn_g[k0 + 2 * j + 1];
                const unsigned h0 = f2bf(v0), h1 = f2bf(v1); hi[j] = h0 | (h1 << 16); lo[j] = pk2(v0 - __uint_as_float(h0 << 16), v1 - __uint_as_float(h1 << 16)); }
            v4u* dst = (v4u*)GWF + ((size_t)(ks * 2 + eb) * 2) * 64 + ln; dst[0] = (v4u){hi[0], hi[1], hi[2], hi[3]}; dst[64] = (v4u){lo[0], lo[1], lo[2], lo[3]}; }
        for (int m = gw; m < NTOK; m += NGW) {
            const GAS f32x4* xr = (const GAS f32x4*)(x + (size_t)m * DM) + lane; const GAS f32x4* gr = (const GAS f32x4*)mix_g + lane;
            f32x4 v[8]; float s = 0.f;
#pragma unroll
            for (int j = 0; j < 8; ++j) { v[j] = xr[64 * j]; s += (v[j].x * v[j].x + v[j].y * v[j].y) + (v[j].z * v[j].z + v[j].w * v[j].w); }
            const float rstd = 1.0f / sqrtf(wave_sum(s) * (1.0f / DM) + EPS);
            GAS u32x2v* o8 = (GAS u32x2v*)(XN + (size_t)m * DM) + lane;
#pragma unroll
            for (int j = 0; j < 8; ++j) { const f32x4 gg = gr[64 * j]; u32x2v o; o.x = pk2(v[j].x * rstd * gg.x, v[j].y * rstd * gg.y); o.y = pk2(v[j].z * rstd * gg.z, v[j].w * rstd * gg.w); o8[64 * j] = o; }
        }
        if (BOTH(0)) GRID_BAR();
    }

    const int ga = (side_on && (SIDE_CONV & 1)) ? 16 : 0, gb = (side_on && (SIDE_CONV & 2)) ? 32 : 0;
    const int cv_lo = ga < gb ? ga : gb, cv_hi = ga < gb ? gb : ga, cv_pn = ga < gb ? 256 : 128, cv_po = ga < gb ? 0 : 256;
    const int nconv_eff = (cv_hi - cv_lo) * cv_pn + (NE - cv_hi) * PER_E;
#define CV_MAP(ci) ((ci) < (cv_hi - cv_lo) * cv_pn ? (cv_lo + (ci) / cv_pn) * PER_E + cv_po + (ci) % cv_pn : (cv_hi + ((ci) - (cv_hi - cv_lo) * cv_pn) / PER_E) * PER_E + ((ci) - (cv_hi - cv_lo) * cv_pn) % PER_E)
#define RUN_P2(ATTW, QA, QC, TRIED0, STOPW, STOPN) do { \
        LAS char* vl = (LAS char*)(L + wave * 16384); \
        LAS unsigned char* T = L + wave * 16384; \
        int mode = (wave < (ATTW)) ? 0 : 1, tried = (TRIED0), aq = 0; const int xcc = (int)xb_xcc_id() & 7; \
        while (tried < 2) { \
            if (mode == 0) { \
                  \
                bool got = false; \
                while (aq < 8) { const int qx = (xcc + aq) & 7; int idx = 0; if (lane == 0) idx = (int)__hip_atomic_fetch_add(ctl + (QA) + 16 * qx, 1u, __ATOMIC_RELAXED, __HIP_MEMORY_SCOPE_AGENT); \
                    idx = __builtin_amdgcn_readfirstlane(idx); \
                    if (idx < 768) { const int it = 64 * (qx + 8 * (idx >> 6)) + (idx & 63); __builtin_amdgcn_s_setprio(3); att::ATT_ITEM(it, PROJ, YATT, vl, lane); __builtin_amdgcn_s_setprio(0); got = true; break; } \
                    ++aq; } \
                if (got) continue; \
            } else { \
                 \
                int it = 0; if (lane == 0) it = (int)__hip_atomic_fetch_add(ctl + (QC), 1u, __ATOMIC_RELAXED, __HIP_MEMORY_SCOPE_AGENT); \
                it = __builtin_amdgcn_readfirstlane(it); \
                if (it < nconv_eff) { \
                    ConvDesc cur = conv_decode(CV_MAP(it), w_gu, w_dn, WGU, WDN, lane); \
                    f32x4 ra[8], rb[8]; \
                    CV_LOAD(ra, cur, 0); \
                    bool stop = false; \
                    for (;;) { \
                        int nx = nconv_eff; if (!stop && lane == 0) nx = (int)__hip_atomic_fetch_add(ctl + (QC), 1u, __ATOMIC_RELAXED, __HIP_MEMORY_SCOPE_AGENT); \
                        unsigned sv = 0u; if ((STOPW) >= 0) sv = __hip_atomic_load(ctl + ((STOPW) >= 0 ? (STOPW) : 0), __ATOMIC_RELAXED, __HIP_MEMORY_SCOPE_AGENT); \
_Pragma("unroll 1") \
                        for (int g = 0; g < CV_NG - 2; g += 2) { CV_LOAD(rb, cur, g + 1); CV_PROC(ra, cur, g); CV_LOAD(ra, cur, g + 2); CV_PROC(rb, cur, g + 1); } \
                        CV_LOAD(rb, cur, CV_NG - 1); CV_PROC(ra, cur, CV_NG - 2); \
                        nx = __builtin_amdgcn_readfirstlane(nx); const bool more = nx < nconv_eff; \
                        const ConvDesc nd = conv_decode(CV_MAP(more ? nx : it), w_gu, w_dn, WGU, WDN, lane); \
                        CV_LOAD(ra, nd, 0);                                   \
                        CV_PROC(rb, cur, CV_NG - 1); \
                        if ((STOPW) >= 0) stop = (unsigned)__builtin_amdgcn_readfirstlane((int)sv) >= (unsigned)(STOPN); \
                        if (!more) break; \
                        cur = nd; it = nx; \
                    } \
                } \
            } \
            if (mode == 0 && (ATTW) < 8 && (ATTW) > 0 && ATT_NOFALL && wave < (ATTW) - ATT_JOIN) break;     \
            mode ^= 1; ++tried; \
        } \
    } while (0)
    if (IN(1)) {
        const bool split = (MK_N_LAUNCHES == 1) && (G == 256) && (SPLIT_P1 != 0);
        const bool conv_wg = split && (((bx >> 3) & 1) == 1);
        if (!conv_wg) {
            pg8::Gemm g{XN, WIN, NTOK, INC, DM}; pg8::StaticOrder S; S.init(NTOK, INC, split ? 128 : G, split ? (((bx >> 4) << 3) | (bx & 7)) : bx);
            pg8::EpiProj E{PROJ, ROPE, att::C2};
            if (side_on && (SIDE_CONV & 1)) { pg8::SideConv SD{w_gu, WGU, 4096, 128 * bx, 96, (unsigned)PART_OFF}; pg8::gemm_phase<pg8::EpiProj, pg8::StaticOrder, true, true, false, false, pg8::SideConv>(L, g, S, E, SD); }
            else pg8::gemm_phase<pg8::EpiProj, pg8::StaticOrder, true, true>(L, g, S, E);
            __syncthreads();
            if (tid == 0) __hip_atomic_fetch_add(ctl + CW_P1DONE, 1u, __ATOMIC_RELAXED, __HIP_MEMORY_SCOPE_AGENT);
        } else {
            RUN_P2(0, CW_ATTQ, CW_CONVQ, 1, CW_P1DONE, 128);
        }
        if (BOTH(1)) GRID_BAR();
    }

    if (IN(2)) {
        RUN_P2(ATT_WAVES, CW_ATTQ, CW_CONVQ, 0, -1, 0);
        if (BOTH(2)) GRID_BAR();
        if ((PROBE_MASK >> 10) & 1) { RUN_P2(0, CW_ATTQ, CW_CONVQ + 64, 0, -1, 0); GRID_BAR(); }
        if ((PROBE_MASK >> 12) & 1) {
            unsigned char* SCR = ws + (size_t)2048 * MiB;
            for (int itp = gw; itp < 2 * NE * 1024; itp += NGW) {
                const int isdn = itp >= NE * 1024; const int r = isdn ? itp - NE * 1024 : itp; const int e = r >> 10, kp = r & 1023; const int N = isdn ? 2048 : 4096;
                const float* s0 = (isdn ? w_dn + (size_t)e * 2048 * 2048 : w_gu + (size_t)e * 2048 * 4096) + (size_t)(2 * kp) * N + 4 * lane; const float* s1 = s0 + N;
                unsigned char* d = SCR + (isdn ? (size_t)NE * 1024 * 8192 + ((size_t)e * 1024 + kp) * 4096 : ((size_t)e * 1024 + kp) * 8192) + 8 * lane;
                for (int i0 = 0; i0 < N / 256; i0 += 8) {
                    f32x4 a[8], c[8];
#pragma unroll
                    for (int i = 0; i < 8; ++i) { a[i] = *(const GAS f32x4*)(s0 + 256 * (i0 + i)); c[i] = *(const GAS f32x4*)(s1 + 256 * (i0 + i)); }
#pragma unroll
                    for (int i = 0; i < 8; ++i) { u32x2v o; o.x = pk4_fp8_nc(64.f * a[i][0], 64.f * c[i][0], 64.f * a[i][1], 64.f * c[i][1]); o.y = pk4_fp8_nc(64.f * a[i][2], 64.f * c[i][2], 64.f * a[i][3], 64.f * c[i][3]);
                        *(GAS u32x2v*)(d + 512 * (i0 + i)) = o; }
                }
            }
            GRID_BAR();
        }
        if ((PROBE_MASK >> 14) & 1) { RUN_P2(ATT_WAVES, CW_ATTQ + 2048, CW_CONVQ + 192, 0, -1, 0); GRID_BAR(); }
        if ((PROBE_MASK >> 13) & 1) { RUN_P2(4, CW_ATTQ, CW_CONVQ + 128, 1, -1, 0); GRID_BAR(); }
        if ((PROBE_MASK >> 15) & 1) { for (;;) { int it = 0; if (lane == 0) it = (int)__hip_atomic_fetch_add(ctl + CW_ATTQ + 256 + 64, 1u, __ATOMIC_RELAXED, __HIP_MEMORY_SCOPE_AGENT); it = __builtin_amdgcn_readfirstlane(it); if (it >= att::NITEMS) break;
            att::item<1>(it, PROJ, (bf16*)(ws + (size_t)3000 * MiB), (LAS char*)(L + wave * 16384), lane); } GRID_BAR(); }
        if ((PROBE_MASK >> 16) & 1) { for (;;) { int it = 0; if (lane == 0) it = (int)__hip_atomic_fetch_add(ctl + CW_ATTQ + 256 + 128, 1u, __ATOMIC_RELAXED, __HIP_MEMORY_SCOPE_AGENT); it = __builtin_amdgcn_readfirstlane(it); if (it >= att::NITEMS) break;
            att::item<2>(it, PROJ, (bf16*)(ws + (size_t)3000 * MiB), (LAS char*)(L + wave * 16384), lane); } GRID_BAR(); }
        if ((PROBE_MASK >> 11) & 1) { RUN_P2(8, CW_ATTQ + 1024, CW_CONVQ, 0, -1, 0); GRID_BAR(); }
    }

    if (IN(3)) for (int rep = 0; rep < REPS(3); ++rep) {
        for (int m = gw; m < NTOK; m += NGW) {
            const int spos = m & (SEQ - 1);
            const bf16* ya = YATT + (size_t)m * AW + 8 * lane;
            v4u a[3];
#pragma unroll
            for (int j = 0; j < 3; ++j) a[j] = *(const v4u*)(ya + 512 * j);
            const bf16* pr = PROJ + (size_t)m * INC + 8 * lane;
            float u[3][8];
#pragma unroll
            for (int d = 0; d < 3; ++d) {
                const int back = 2 - d;
                if (spos >= back) { const v4u cx = *(const v4u*)(pr - (size_t)back * INC); const v4u cc = *(const v4u*)(pr - (size_t)back * INC + 2 * CW);
                    u[d][0] = bf_lo(cx.x) * bf_lo(cc.x); u[d][1] = bf_hi(cx.x) * bf_hi(cc.x); u[d][2] = bf_lo(cx.y) * bf_lo(cc.y); u[d][3] = bf_hi(cx.y) * bf_hi(cc.y);
                    u[d][4] = bf_lo(cx.z) * bf_lo(cc.z); u[d][5] = bf_hi(cx.z) * bf_hi(cc.z); u[d][6] = bf_lo(cx.w) * bf_lo(cc.w); u[d][7] = bf_hi(cx.w) * bf_hi(cc.w); }
                else {
#pragma unroll
                    for (int j = 0; j < 8; ++j) u[d][j] = 0.f; }
            }
            const v4u cb = *(const v4u*)(pr + CW);
            float bb[8] = {bf_lo(cb.x), bf_hi(cb.x), bf_lo(cb.y), bf_hi(cb.y), bf_lo(cb.z), bf_hi(cb.z), bf_lo(cb.w), bf_hi(cb.w)};
            float y[8]; float s = 0.f;
#pragma unroll
            for (int j = 0; j < 8; ++j) { const int c = 8 * lane + j; const float acc = conv_w[c] * u[0][j] + conv_w[CW + c] * u[1][j] + conv_w[2 * CW + c] * u[2][j]; y[j] = bb[j] * acc; s += y[j] * y[j]; }
            const float rc = 1.0f / sqrtf(wave_sum(s) * (1.0f / CW) + EPS);
            { v4u o; const float* gq = conv_g + 8 * lane;
              o.x = pk2(y[0] * rc * gq[0], y[1] * rc * gq[1]); o.y = pk2(y[2] * rc * gq[2], y[3] * rc * gq[3]); o.z = pk2(y[4] * rc * gq[4], y[5] * rc * gq[5]); o.w = pk2(y[6] * rc * gq[6], y[7] * rc * gq[7]);
              *(v4u*)(MIXED + (size_t)m * DM + 8 * lane) = o; }
            float s2 = 0.f;
#pragma unroll
            for (int j = 0; j < 3; ++j) {
                const float f0 = bf_lo(a[j].x), f1 = bf_hi(a[j].x), f2 = bf_lo(a[j].y), f3 = bf_hi(a[j].y), f4 = bf_lo(a[j].z), f5 = bf_hi(a[j].z), f6 = bf_lo(a[j].w), f7 = bf_hi(a[j].w);
                s2 += (f0 * f0 + f1 * f1) + (f2 * f2 + f3 * f3) + (f4 * f4 + f5 * f5) + (f6 * f6 + f7 * f7); }
            const float ra = 1.0f / sqrtf(wave_sum(s2) * (1.0f / AW) + EPS);
#pragma unroll
            for (int j = 0; j < 3; ++j) { const float* gq = attn_g + 512 * j + 8 * lane; v4u o;
                o.x = pk2(bf_lo(a[j].x) * ra * gq[0], bf_hi(a[j].x) * ra * gq[1]); o.y = pk2(bf_lo(a[j].y) * ra * gq[2], bf_hi(a[j].y) * ra * gq[3]);
                o.z = pk2(bf_lo(a[j].z) * ra * gq[4], bf_hi(a[j].z) * ra * gq[5]); o.w = pk2(bf_lo(a[j].w) * ra * gq[6], bf_hi(a[j].w) * ra * gq[7]);
                *(v4u*)(MIXED + (size_t)m * DM + CW + 512 * j + 8 * lane) = o; }
        }
        if (BOTH(3)) GRID_BAR();
    }

    if (IN(4)) for (int rep = 0; rep < REPS(4); ++rep) {
        pg8::Gemm g{MIXED, WO, NTOK, DM, DM}; pg8::StaticOrder S; S.init(NTOK, DM, G, (int)blockIdx.x);
        pg8::EpiResF32 E{x, X1, DM};
        if (side_on && (SIDE_CONV & 1)) { pg8::SideConv SD{w_gu, WGU, 4096, 128 * bx + 96, 32, (unsigned)PART_OFF}; pg8::gemm_phase<pg8::EpiResF32, pg8::StaticOrder, false, true, false, false, pg8::SideConv>(L, g, S, E, SD); }
        else pg8::gemm_phase<pg8::EpiResF32, pg8::StaticOrder, false, true>(L, g, S, E);
        if (BOTH(4)) GRID_BAR();
    }

    if (IN(5)) for (int rep = 0; rep < REPS(5); ++rep) {
        const int cwc = CW_CNT + 1024 * rep; int* TOKE_ = TOKE + rep * (1 << 20); int* TOKR_ = TOKR + rep * (1 << 20); float* TOKG_ = TOKG + rep * (1 << 20); unsigned char* XS_ = XS + (size_t)rep * ((size_t)2752 * MiB - WS_XS);
        LAS float* X1L = (LAS float*)L; constexpr int XP = 2052;
        LAS float* PART = (LAS float*)(L + PART_OFF);
        const int e_ = lane & 31, kbase = 256 * wave + 128 * (lane >> 5);
        LAS int* LC = (LAS int*)(L + LDSCTL_OFF + 2048); LAS int* LB = (LAS int*)(L + LDSCTL_OFF + 2304);
        LAS int* AE = (LAS int*)(L + LDSCTL_OFF + 4096); LAS int* ALR = AE + 128; LAS float* AG = (LAS float*)(AE + 256); LAS float* RS = (LAS float*)(AE + 384);
        for (int blk = vcu; blk < NTOK / 32; blk += G) {
        if (tid < 32) LC[tid] = 0;
        __syncthreads();
        const int grp0 = 2 * blk;
#define P5_DMA(step) do { _Pragma("unroll") for (int r = 0; r < 2; ++r) _Pragma("unroll") for (int c = 0; c < 8; ++c) \
            __builtin_amdgcn_global_load_lds((const unsigned*)(X1 + (size_t)((grp0 + (step)) * 16 + 2 * wave + r) * DM + c * 256 + lane * 4), (LAS unsigned*)(L + (2 * wave + r) * (XP * 4) + c * 1024), 16, 0, 0); \
            asm volatile("s_waitcnt vmcnt(0)" ::: "memory"); __syncthreads(); } while (0)
        for (int step = 0; step < 2; ++step) {
            if (step) __syncthreads();
            P5_DMA(step);
            {
                typedef short s16x8b __attribute__((ext_vector_type(8)));
                f32x4 acc0 = {0.f, 0.f, 0.f, 0.f}, acc1 = acc0;
                const int tcol = lane & 15, kq = lane >> 4;
#pragma unroll
                for (int s8 = 0; s8 < 8; ++s8) { const int ks = 8 * wave + s8;
                    const LAS f32x4* xp = (const LAS f32x4*)(X1L + tcol * XP + 32 * ks + 8 * kq); const f32x4 xa = xp[0], xb = xp[1];
                    unsigned xh[4], xl[4];
                    { const unsigned h0 = f2bf(xa.x), h1 = f2bf(xa.y), h2 = f2bf(xa.z), h3 = f2bf(xa.w), h4 = f2bf(xb.x), h5 = f2bf(xb.y), h6 = f2bf(xb.z), h7 = f2bf(xb.w);
                      xh[0] = h0 | (h1 << 16); xh[1] = h2 | (h3 << 16); xh[2] = h4 | (h5 << 16); xh[3] = h6 | (h7 << 16);
                      xl[0] = pk2(xa.x - __uint_as_float(h0 << 16), xa.y - __uint_as_float(h1 << 16)); xl[1] = pk2(xa.z - __uint_as_float(h2 << 16), xa.w - __uint_as_float(h3 << 16));
                      xl[2] = pk2(xb.x - __uint_as_float(h4 << 16), xb.y - __uint_as_float(h5 << 16)); xl[3] = pk2(xb.z - __uint_as_float(h6 << 16), xb.w - __uint_as_float(h7 << 16)); }
                    const s16x8b bxh = __builtin_bit_cast(s16x8b, (v4u){xh[0], xh[1], xh[2], xh[3]}), bxl = __builtin_bit_cast(s16x8b, (v4u){xl[0], xl[1], xl[2], xl[3]});
                    const v4u* wf = (const v4u*)GWF + (size_t)(ks * 4) * 64 + lane;
                    const s16x8b w0h = __builtin_bit_cast(s16x8b, wf[0]), w0l = __builtin_bit_cast(s16x8b, wf[64]), w1h = __builtin_bit_cast(s16x8b, wf[128]), w1l = __builtin_bit_cast(s16x8b, wf[192]);
                    acc0 = __builtin_amdgcn_mfma_f32_16x16x32_bf16(w0h, bxh, acc0, 0, 0, 0); acc0 = __builtin_amdgcn_mfma_f32_16x16x32_bf16(w0l, bxh, acc0, 0, 0, 0); acc0 = __builtin_amdgcn_mfma_f32_16x16x32_bf16(w0h, bxl, acc0, 0, 0, 0);
                    acc1 = __builtin_amdgcn_mfma_f32_16x16x32_bf16(w1h, bxh, acc1, 0, 0, 0); acc1 = __builtin_amdgcn_mfma_f32_16x16x32_bf16(w1l, bxh, acc1, 0, 0, 0); acc1 = __builtin_amdgcn_mfma_f32_16x16x32_bf16(w1h, bxl, acc1, 0, 0, 0); }
                *(LAS f32x4*)(PART + (wave * 16 + tcol) * 32 + 4 * kq) = acc0; *(LAS f32x4*)(PART + (wave * 16 + tcol) * 32 + 16 + 4 * kq) = acc1;
            }
            __syncthreads();
            {
                float tvv[2][4]; int tii[2][4];
#pragma unroll
                for (int r = 0; r < 2; ++r) { const int tl = 2 * wave + r;
                    const LAS f32x4* hp = (const LAS f32x4*)(X1L + tl * XP + 32 * lane); float ss = 0.f;
#pragma unroll
                    for (int j = 0; j < 8; ++j) { const f32x4 a = hp[j]; ss += (a.x * a.x + a.y * a.y) + (a.z * a.z + a.w * a.w); }
                    const float rstd = 1.0f / sqrtf(wave_sum(ss) * (1.0f / DM) + EPS); if (lane == 0) RS[step * 16 + tl] = rstd;
                    float lg = -INFINITY;
                    if (lane < 32) { float s = 0.f;
#pragma unroll
                        for (int w = 0; w < 8; ++w) s += PART[(w * 16 + tl) * 32 + lane]; lg = s * rstd + b_router[lane]; }
                    int rank = 0; const int lgb = __float_as_int(lg);
#pragma unroll
                    for (int j = 0; j < 32; ++j) { const float vj = __int_as_float(__builtin_amdgcn_readlane(lgb, j)); rank += (vj > lg || (vj == lg && j < lane)) ? 1 : 0; }
#pragma unroll
                    for (int k = 0; k < 4; ++k) { const unsigned long long mk = __builtin_amdgcn_ballot_w64(lane < 32 && rank == k); const int idx = (int)__builtin_ctzll(mk);
                        tii[r][k] = idx; tvv[r][k] = __int_as_float(__builtin_amdgcn_readlane(lgb, idx)); } }
                if (lane < 8) { const int r = lane >> 2, k = lane & 3;
                    const float t0 = r ? tvv[1][0] : tvv[0][0], t1 = r ? tvv[1][1] : tvv[0][1], t2 = r ? tvv[1][2] : tvv[0][2], t3 = r ? tvv[1][3] : tvv[0][3];
                    const float e1 = __expf(t1 - t0), e2 = __expf(t2 - t0), e3 = __expf(t3 - t0); const float den = 1.0f / (1.0f + e1 + e2 + e3);
                    const int i0 = r ? tii[1][0] : tii[0][0], i1 = r ? tii[1][1] : tii[0][1], i2 = r ? tii[1][2] : tii[0][2], i3 = r ? tii[1][3] : tii[0][3];
                    const int ee = k == 0 ? i0 : k == 1 ? i1 : k == 2 ? i2 : i3; const float gg = (k == 0 ? 1.0f : k == 1 ? e1 : k == 2 ? e2 : e3) * den;
                    const int ai = (step * 16 + 2 * wave + r) * 4 + k;
                    AE[ai] = ee; ALR[ai] = __hip_atomic_fetch_add(LC + ee, 1, __ATOMIC_RELAXED, __HIP_MEMORY_SCOPE_WORKGROUP); AG[ai] = gg; }
            }
        }
        __syncthreads();
        if (tid < 32) { const int c = LC[tid]; LB[tid] = c ? (int)__hip_atomic_fetch_add(ctl + cwc + 16 * tid, (unsigned)c, __ATOMIC_RELAXED, __HIP_MEMORY_SCOPE_AGENT) : 0; }
        __syncthreads();
        for (int pp = 0; pp < 2; ++pp) { const int step = 1 - pp;
            if (pp) { __syncthreads(); P5_DMA(step); }
#pragma unroll
            for (int r = 0; r < 2; ++r) { const int tl = 2 * wave + r; const float sc = 16.f * RS[step * 16 + tl]; const int tok = (grp0 + step) * 16 + tl;
                const LAS f32x4* hp = (const LAS f32x4*)(X1L + tl * XP + 32 * lane); const f32x4* gp = (const f32x4*)(ffn_g + 32 * lane); v4u w0, w1;
                { const f32x4 a = hp[0] * gp[0] * sc, c = hp[1] * gp[1] * sc, d = hp[2] * gp[2] * sc, f = hp[3] * gp[3] * sc;
                  w0.x = pg8::pk4_fp8(a.x, a.y, a.z, a.w); w0.y = pg8::pk4_fp8(c.x, c.y, c.z, c.w); w0.z = pg8::pk4_fp8(d.x, d.y, d.z, d.w); w0.w = pg8::pk4_fp8(f.x, f.y, f.z, f.w); }
                { const f32x4 a = hp[4] * gp[4] * sc, c = hp[5] * gp[5] * sc, d = hp[6] * gp[6] * sc, f = hp[7] * gp[7] * sc;
                  w1.x = pg8::pk4_fp8(a.x, a.y, a.z, a.w); w1.y = pg8::pk4_fp8(c.x, c.y, c.z, c.w); w1.z = pg8::pk4_fp8(d.x, d.y, d.z, d.w); w1.w = pg8::pk4_fp8(f.x, f.y, f.z, f.w); }
#pragma unroll
                for (int k = 0; k < 4; ++k) { const int ai = (step * 16 + tl) * 4 + k; const int ee = AE[ai], rank = LB[ee] + ALR[ai];
                    GAS v4u* dst = (GAS v4u*)(XS_ + ((size_t)ee * NTOK + rank) * DM + 32 * lane); dst[0] = w0; dst[1] = w1;
                    if (lane == 0) { TOKE_[tok * 4 + k] = ee; TOKR_[tok * 4 + k] = rank; TOKG_[tok * 4 + k] = AG[ai]; } } }
        }
        __syncthreads();
        }
#undef P5_DMA
        if (BOTH(5)) GRID_BAR();
    }

    LAS int* TS = (LAS int*)(L + TAB_TS); LAS int* CN = (LAS int*)(L + TAB_CN);
    if (hi > 6) {
        if (tid == 0) { int acc = 0; for (int e = 0; e < NE; ++e) { const int c = (int)__hip_atomic_load(ctl + CW_CNT + 16 * e, __ATOMIC_RELAXED, __HIP_MEMORY_SCOPE_AGENT); CN[e] = c; TS[e] = acc; acc += (c + 255) >> 8; } TS[NE] = acc; }
        __syncthreads();
    }


    if (IN(7)) for (int rep = 0; rep < REPS(7); ++rep) {
        {
        pg8::GroupedOrder S{(const PG8_LAS int*)TS, (const PG8_LAS int*)CN, 16, G, vcu, (long)1024 * 4096 * 2, 128 * 2};
        pg8::EpiSwiGLU E{ACT, b_gu};
        pg8::Gemm g{(const pg8::bf16_t*)XS, (const pg8::bf16_t*)WGU, MAXSLOT, NE * 4096, DM / 2, 4096, 2048 * 2};
        if (side_on && (SIDE_CONV & 2)) { pg8::SideConv SD{w_dn, WDN, 2048, 128 * bx, 128, (unsigned)PART_OFF}; pg8::gemm_phase<pg8::EpiSwiGLU, pg8::GroupedOrder, true, true, true, true, pg8::SideConv>(L, g, S, E, SD); }
        else pg8::gemm_phase<pg8::EpiSwiGLU, pg8::GroupedOrder, true, true, true, true>(L, g, S, E); }
        if (BOTH(7)) GRID_BAR();
    }

    if (IN(8)) for (int rep = 0; rep < REPS(8); ++rep) {
        {
        pg8::GroupedOrder S{(const PG8_LAS int*)TS, (const PG8_LAS int*)CN, 8, G, vcu, (long)1024 * 2048 * 2, 256 * 2};
        pg8::EpiFp8Y E{(unsigned char*)YB, 1.0f / (pg8::FP8_W_SCALE * pg8::FP8_ACT_SCALE), b_dn};
        pg8::Gemm g{(const pg8::bf16_t*)ACT, (const pg8::bf16_t*)WDN, MAXSLOT, NE * 2048, DE / 2, 2048, 128 * 2};
        pg8::gemm_phase<pg8::EpiFp8Y, pg8::GroupedOrder, true, true, true, true>(L, g, S, E); }
        if (BOTH(8)) GRID_BAR();
    }

    if (IN(9)) for (int rep = 0; rep < REPS(9); ++rep) {
        unsigned poison = __hip_atomic_load(ctl + CW_BAR + XB_TMO, RLX_AGENT) != 0u;
        for (int m = gw; m < NTOK; m += NGW) {
            const GAS f32x4* xr = (const GAS f32x4*)(X1 + (size_t)m * DM) + lane;
            f32x4 v[8];
#pragma unroll
            for (int j = 0; j < 8; ++j) v[j] = __builtin_nontemporal_load(xr + 64 * j);
            const int4 te = *(const int4*)(TOKE + m * 4), tr = *(const int4*)(TOKR + m * 4); const f32x4 tg = *(const f32x4*)(TOKG + m * 4);
            const int ee[4] = {te.x, te.y, te.z, te.w}, rr[4] = {tr.x, tr.y, tr.z, tr.w};
            unsigned yy[4][8];
#pragma unroll
            for (int k = 0; k < TOPK; ++k) { const GAS unsigned* yr = (const GAS unsigned*)((const unsigned char*)YB + ((size_t)ee[k] * NTOK + rr[k]) * DM) + lane;
#pragma unroll
                for (int j = 0; j < 8; ++j) yy[k][j] = __builtin_nontemporal_load(yr + 64 * j); }
#pragma unroll
            for (int k = 0; k < TOPK; ++k) { const float gt = tg[k] * (1.0f / 16.0f);
#pragma unroll
                for (int j = 0; j < 8; ++j) { typedef float f32x2y __attribute__((ext_vector_type(2))); const f32x2y lo = __builtin_amdgcn_cvt_pk_f32_fp8((int)yy[k][j], false), hi = __builtin_amdgcn_cvt_pk_f32_fp8((int)yy[k][j], true);
                    v[j].x += gt * lo.x; v[j].y += gt * lo.y; v[j].z += gt * hi.x; v[j].w += gt * hi.y; } }
            float s = 0.f;
#pragma unroll
            for (int j = 0; j < 8; ++j) s += (v[j].x * v[j].x + v[j].y * v[j].y) + (v[j].z * v[j].z + v[j].w * v[j].w);
            float rstd = 1.0f / sqrtf(wave_sum(s) * (1.0f / DM) + EPS);
            if (poison) rstd = __builtin_nanf("");
            GAS f32x4* orow = (GAS f32x4*)(out + (size_t)m * DM) + lane; const GAS f32x4* gr = (const GAS f32x4*)fin_g + lane;
#pragma unroll
            for (int j = 0; j < 8; ++j) { const f32x4 gg = gr[64 * j]; f32x4 o; o.x = v[j].x * rstd * gg.x; o.y = v[j].y * rstd * gg.y; o.z = v[j].z * rstd * gg.z; o.w = v[j].w * rstd * gg.w; __builtin_nontemporal_store(o, orow + 64 * j); }
        }
    }
#undef IN
#undef BOTH
#undef GRID_BAR
}

extern "C" void kernel_launch(void* const* d_in, const int* in_sizes, int n_in, void* d_out, int out_size, void* d_ws, size_t ws_size, hipStream_t stream) {
    static int grid = 0;
    if (grid == 0) {
        if (n_in != 15 || in_sizes[0] != NTOK * DM || out_size != NTOK * DM || ws_size < WS_END) { fprintf(stderr, "kernel_launch: unexpected shapes / workspace (n_in %d, ws %zu)\n", n_in, ws_size); grid = -1; return; }
        int dev = 0, cus = 0, per_cu = 0;
        if (hipGetDevice(&dev) != hipSuccess || hipDeviceGetAttribute(&cus, hipDeviceAttributeMultiprocessorCount, dev) != hipSuccess) { grid = -1; return; }
        if (hipFuncSetAttribute((const void*)fwd, hipFuncAttributeMaxDynamicSharedMemorySize, LDS_BYTES) != hipSuccess) { fprintf(stderr, "kernel_launch: hipFuncSetAttribute failed\n"); grid = -1; return; }
        if (hipOccupancyMaxActiveBlocksPerMultiprocessor(&per_cu, (const void*)fwd, NWAVES * 64, LDS_BYTES) != hipSuccess || per_cu < 1) fprintf(stderr, "kernel_launch: occupancy query says %d\n", per_cu);
        (void)hipGetLastError();
        grid = cus;
    }
    if (grid < 0) return;
    if (hipMemsetAsync((char*)d_ws + WS_CTL, 0, CTL_ZERO_BYTES, stream) != hipSuccess) return;
    Args a{};
    for (int i = 0; i < 15; ++i) a.in[i] = (const float*)d_in[i];
    a.out = (float*)d_out; a.ws = (unsigned char*)d_ws;
    if (MK_N_LAUNCHES == 1) { a.ph_lo = 0; a.ph_hi = NPH; hipLaunchKernelGGL(fwd, dim3(grid), dim3(NWAVES * 64), LDS_BYTES, stream, a); }
    else { for (int p = 0; p < NPH; ++p) { a.ph_lo = p; a.ph_hi = p + 1; hipLaunchKernelGGL(fwd, dim3(grid), dim3(NWAVES * 64), LDS_BYTES, stream, a); } }
    const hipError_t le = hipPeekAtLastError();
    if (le != hipSuccess) fprintf(stderr, "kernel_launch: launch failed: %s\n", hipGetErrorName(le));
}
```

```cpp
#include <hip/hip_runtime.h>
#include <cstdio>
#include <cstdint>
namespace pg8 {
#define PG8_LAS __attribute__((address_space(3)))
typedef unsigned short bf16_t;
typedef short bf16x8 __attribute__((ext_vector_type(8)));
typedef float f32x4 __attribute__((ext_vector_type(4)));
typedef unsigned u32x4 __attribute__((ext_vector_type(4)));
constexpr int BM = 256, BK = 64, HALF = 128, HTB = HALF * BK * 2  , STAGE_BYTES = 8 * HTB, NXCD = 8, WGM = 8;

__host__ __device__ __forceinline__ int lds_byte(int r, int c) { const int st = (r >> 4) * 2 + (c >> 5), rr = r & 15, cc = c & 31, ob = rr * 64 + cc * 2; return st * 1024 + (ob ^ (((ob >> 9) & 1) << 5)); }
__host__ __device__ __forceinline__ void stage_rc(int b, int& R, int& C) { const int st = b / 1024, sb = b % 1024, swz = sb ^ (((sb >> 9) & 1) << 5); R = (st >> 1) * 16 + swz / 64; C = (st & 1) * 32 + (swz % 64) / 2; }
__host__ __device__ __forceinline__ int perm32(int rho) { const int n = rho >> 4, i = rho & 15; return 8 * (i >> 2) + 4 * n + (i & 3); }

struct Unit { int pm, pn, e, cn, rows; long boff; };
struct Gemm { const bf16_t* A; const bf16_t* Bt; int M, N, K; int b_ntot, b_hstep; };

struct StaticOrder {
    int nM, nN, nwg, G, c;
    __host__ __device__ void init(int M, int N, int G_, int c_) { nM = M / BM; nN = N / BM; nwg = nM * nN; G = G_; c = c_; }
    __host__ __device__ bool next(int i, Unit& u) const {
        const long L = (long)i * G + c; if (L >= nwg) return false;
        int wgid = (int)L; { const int q = nwg / NXCD, r = nwg % NXCD, xcd = wgid % NXCD, off = wgid / NXCD; wgid = (xcd < r ? xcd * (q + 1) : r * (q + 1) + (xcd - r) * q) + off; }
        const int nig = WGM * nN, gid = wgid / nig, fm = gid * WGM, gsz = (nM - fm) < WGM ? (nM - fm) : WGM;
        u.pm = fm + ((wgid % nig) % gsz); u.pn = (wgid % nig) / gsz; u.e = 0; u.cn = u.pn; u.rows = BM; u.boff = 0; return true;
    }
    __device__ __forceinline__ void a_ready(const Unit&) const {}
    __device__ __forceinline__ void done(const Unit&) const {}
};
struct GroupedOrder {
    const PG8_LAS int* TS; const PG8_LAS int* CN; int nN, G, v; long b_estride; int b_cnstep;
    __device__ __forceinline__ bool next(int i, Unit& u) const {
        const PG8_LAS int* TH = TS + 33;
        const int U = i * G + v; const int FT = __builtin_amdgcn_readfirstlane(TS[32] * nN), total = FT + __builtin_amdgcn_readfirstlane(TH[32] * nN); if (U >= total) return false;
        int e = 0, pn, rt;
        if (U < FT) {
#pragma unroll 1
            for (int j = 1; j < 32; ++j) e += (TS[j] * nN <= U) ? 1 : 0;
            const int t0 = TS[e], nt = TS[e + 1] - t0, loc = U - t0 * nN; pn = loc / nt; rt = loc - pn * nt;
        } else { const int U2 = U - FT;
#pragma unroll 1
            for (int j = 1; j < 32; ++j) e += (TH[j] * nN <= U2) ? 1 : 0;
            pn = U2 - TH[e] * nN; rt = TS[e + 1] - TS[e]; }
        const int left = CN[e] - rt * BM;
        u.pm = __builtin_amdgcn_readfirstlane(e * 32 + rt); u.pn = __builtin_amdgcn_readfirstlane(e * nN + pn); u.e = __builtin_amdgcn_readfirstlane(e); u.cn = __builtin_amdgcn_readfirstlane(pn);
        u.rows = __builtin_amdgcn_readfirstlane(left < BM ? left : BM); u.boff = (long)u.e * b_estride + (long)u.cn * b_cnstep; return true;
    }
    __device__ __forceinline__ void a_ready(const Unit&) const {}
    __device__ __forceinline__ void done(const Unit&) const {}
};

__device__ __forceinline__ unsigned cvt_pk_bf16(float lo, float hi) { unsigned r; asm volatile("v_cvt_pk_bf16_f32 %0, %1, %2" : "=v"(r) : "v"(lo), "v"(hi)); return r; }

struct EpiBf16Plain {
    static constexpr bool PERM = true, AFTER_DRAIN = false;
    bf16_t* O; int ldc; float sc; const float* bias;
    __device__ __forceinline__ void operator()(const f32x4 (&acc)[2][2][4][2], const Unit& u, int wr, int wc, int fr, int fq) const {
        const int row0 = u.pm * BM + wr * 64 + fr, col0 = u.cn * BM + wc * 32 + 8 * fq;
        f32x4 bv[2][2];
#pragma unroll
        for (int bj = 0; bj < 2; ++bj)
#pragma unroll
            for (int n = 0; n < 2; ++n) bv[bj][n] = bias ? *(const f32x4*)(bias + (size_t)u.e * ldc + col0 + bj * HALF + 4 * n) : (f32x4){0.f, 0.f, 0.f, 0.f};
#pragma unroll
        for (int ai = 0; ai < 2; ++ai) { if (ai == 1 && u.rows <= HALF) break;
#pragma unroll
            for (int m = 0; m < 4; ++m) { bf16_t* rowp = O + (size_t)(row0 + ai * HALF + m * 16) * ldc + col0;
#pragma unroll
                for (int bj = 0; bj < 2; ++bj) { const f32x4 v0 = acc[ai][bj][m][0] * sc + bv[bj][0], v1 = acc[ai][bj][m][1] * sc + bv[bj][1];
                    u32x4 w; w.x = cvt_pk_bf16(v0[0], v0[1]); w.y = cvt_pk_bf16(v0[2], v0[3]); w.z = cvt_pk_bf16(v1[0], v1[1]); w.w = cvt_pk_bf16(v1[2], v1[3]);
                    *(u32x4*)(rowp + bj * HALF) = w; } } }
    }
};
struct EpiProj {
    static constexpr bool PERM = true, AFTER_DRAIN = false;
    bf16_t* O; const float* rope; float qscale;
    __device__ __forceinline__ void operator()(const f32x4 (&acc)[2][2][4][2], const Unit& u, int wr, int wc, int fr, int fq) const {
        const int row0 = u.pm * BM + wr * 64 + fr, col0 = u.cn * BM + wc * 32 + 8 * fq;
        const bool isq = (u.cn >= 6 && u.cn < 12), isk = (u.cn >= 12 && u.cn < 18);
        const bool rot = (isq || isk) && ((wc & 1) == 0);
        const float sc = isq ? qscale : 1.0f;
        const float sg = (fq == 0) ? -1.0f : 1.0f;
        const bool act = fq < 2;
#pragma unroll
        for (int ai = 0; ai < 2; ++ai)
#pragma unroll
            for (int m = 0; m < 4; ++m) { const int row = row0 + ai * HALF + m * 16; bf16_t* rowp = O + (size_t)row * 6144 + col0;
                f32x4 c0 = {1.f, 1.f, 1.f, 1.f}, c1 = c0, s0 = {0.f, 0.f, 0.f, 0.f}, s1 = s0;
                if (rot) { const float* rp = rope + (row & 2047) * 16; c0 = *(const f32x4*)rp; c1 = *(const f32x4*)(rp + 4); s0 = *(const f32x4*)(rp + 8); s1 = *(const f32x4*)(rp + 12); }
#pragma unroll
                for (int bj = 0; bj < 2; ++bj) { f32x4 v0 = acc[ai][bj][m][0], v1 = acc[ai][bj][m][1];
                    if (rot) { f32x4 o0, o1;
#pragma unroll
                        for (int i = 0; i < 4; ++i) { o0[i] = __shfl_xor(v0[i], 16); o1[i] = __shfl_xor(v1[i], 16); }
                        const f32x4 r0 = v0 * c0 + (o0 * s0) * sg, r1 = v1 * c1 + (o1 * s1) * sg;
                        v0 = act ? r0 : v0; v1 = act ? r1 : v1; }
                    v0 = v0 * sc; v1 = v1 * sc;
                    u32x4 w; w.x = cvt_pk_bf16(v0[0], v0[1]); w.y = cvt_pk_bf16(v0[2], v0[3]); w.z = cvt_pk_bf16(v1[0], v1[1]); w.w = cvt_pk_bf16(v1[2], v1[3]);
                    *(u32x4*)(rowp + bj * HALF) = w; } }
    }
};
struct EpiResF32 {
    static constexpr bool PERM = false, AFTER_DRAIN = false;
    const float* base; float* out; int ldc;
    __device__ __forceinline__ void operator()(const f32x4 (&acc)[2][2][4][2], const Unit& u, int wr, int wc, int fr, int fq) const {
        const int row0 = u.pm * BM + wr * 64 + fr, col0 = u.cn * BM + wc * 32 + 4 * fq;
#pragma unroll
        for (int ai = 0; ai < 2; ++ai)
#pragma unroll
            for (int m = 0; m < 4; ++m) { const size_t off = (size_t)(row0 + ai * HALF + m * 16) * ldc + col0;
#pragma unroll
                for (int bj = 0; bj < 2; ++bj)
#pragma unroll
                    for (int n = 0; n < 2; ++n) { const f32x4 b = *(const f32x4*)(base + off + bj * HALF + n * 16); *(f32x4*)(out + off + bj * HALF + n * 16) = acc[ai][bj][m][n] + b; } }
    }
};
__device__ __forceinline__ float swiglu1(float g, float up) {
    g = fminf(g, 7.0f); up = fminf(fmaxf(up, -7.0f), 7.0f);
    const float e = __builtin_amdgcn_exp2f(g * (-1.702f * 1.4426950408889634f));
    return (up + 1.0f) * g * __builtin_amdgcn_rcpf(1.0f + e);
}
__device__ __forceinline__ unsigned pk4_fp8(float a, float b, float c, float d) {
    a = fminf(fmaxf(a, -448.f), 448.f); b = fminf(fmaxf(b, -448.f), 448.f); c = fminf(fmaxf(c, -448.f), 448.f); d = fminf(fmaxf(d, -448.f), 448.f);
    int w = 0; w = __builtin_amdgcn_cvt_pk_fp8_f32(a, b, w, false); w = __builtin_amdgcn_cvt_pk_fp8_f32(c, d, w, true); return (unsigned)w; }
constexpr float FP8_W_SCALE = 64.f, FP8_X_SCALE = 16.f, FP8_ACT_SCALE = 4.f;
struct EpiFp8Y {
    static constexpr bool PERM = true, AFTER_DRAIN = false;
    unsigned char* O; float sc; const float* bias;
    __device__ __forceinline__ void operator()(const f32x4 (&acc)[2][2][4][2], const Unit& u, int wr, int wc, int fr, int fq) const {
        const int row0 = u.pm * BM + wr * 64 + fr, col0 = u.cn * BM + wc * 32 + 8 * fq;
        f32x4 bv[2][2];
#pragma unroll
        for (int bj = 0; bj < 2; ++bj)
#pragma unroll
            for (int n = 0; n < 2; ++n) bv[bj][n] = *(const f32x4*)(bias + (size_t)u.e * 2048 + col0 + bj * HALF + 4 * n);
#pragma unroll
        for (int ai = 0; ai < 2; ++ai) { if (ai == 1 && u.rows <= HALF) break;
#pragma unroll
            for (int m = 0; m < 4; ++m) { unsigned char* rowp = O + (size_t)(row0 + ai * HALF + m * 16) * 2048 + col0;
#pragma unroll
                for (int bj = 0; bj < 2; ++bj) { const f32x4 v0 = (acc[ai][bj][m][0] * sc + bv[bj][0]) * 16.f, v1 = (acc[ai][bj][m][1] * sc + bv[bj][1]) * 16.f;
                    typedef unsigned u32x2y __attribute__((ext_vector_type(2))); u32x2y w; w.x = pk4_fp8(v0[0], v0[1], v0[2], v0[3]); w.y = pk4_fp8(v1[0], v1[1], v1[2], v1[3]);
                    *(u32x2y*)(rowp + bj * HALF) = w; } } }
    }
};
struct EpiSwiGLU {
    static constexpr bool PERM = true, AFTER_DRAIN = false;
    unsigned char* O; const float* bias;
    __device__ __forceinline__ void operator()(const f32x4 (&acc)[2][2][4][2], const Unit& u, int wr, int wc, int fr, int fq) const {
        const int row0 = u.pm * BM + wr * 64 + fr, colj = u.cn * HALF + wc * 32 + 8 * fq;
        const float* bg = bias + (size_t)u.e * 4096 + colj; const float isc = 1.0f / (FP8_W_SCALE * FP8_X_SCALE);
        const f32x4 bg0 = *(const f32x4*)(bg), bg1 = *(const f32x4*)(bg + 4), bu0 = *(const f32x4*)(bg + 2048), bu1 = *(const f32x4*)(bg + 2048 + 4);
#pragma unroll
        for (int ai = 0; ai < 2; ++ai) { if (ai == 1 && u.rows <= HALF) break;
#pragma unroll
            for (int m = 0; m < 4; ++m) { unsigned char* rowp = O + (size_t)(row0 + ai * HALF + m * 16) * 2048 + colj;
                const f32x4 g0 = acc[ai][0][m][0] * isc + bg0, g1 = acc[ai][0][m][1] * isc + bg1, u0 = acc[ai][1][m][0] * isc + bu0, u1 = acc[ai][1][m][1] * isc + bu1;
                typedef unsigned u32x2e __attribute__((ext_vector_type(2))); u32x2e w;
                w.x = pk4_fp8(FP8_ACT_SCALE * swiglu1(g0[0], u0[0]), FP8_ACT_SCALE * swiglu1(g0[1], u0[1]), FP8_ACT_SCALE * swiglu1(g0[2], u0[2]), FP8_ACT_SCALE * swiglu1(g0[3], u0[3]));
                w.y = pk4_fp8(FP8_ACT_SCALE * swiglu1(g1[0], u1[0]), FP8_ACT_SCALE * swiglu1(g1[1], u1[1]), FP8_ACT_SCALE * swiglu1(g1[2], u1[2]), FP8_ACT_SCALE * swiglu1(g1[3], u1[3]));
                *(u32x2e*)rowp = w; } }
    }
};
typedef short v4i16p_t __attribute__((ext_vector_type(4)));
typedef int v2i_t __attribute__((ext_vector_type(2)));
__device__ __forceinline__ v2i_t trb(PG8_LAS const unsigned char* p) { return __builtin_bit_cast(v2i_t, __builtin_amdgcn_ds_read_tr16_b64_v4i16((PG8_LAS v4i16p_t*)p)); }
typedef int v8i_t __attribute__((ext_vector_type(8)));
typedef int v4i_t __attribute__((ext_vector_type(4)));
__device__ __forceinline__ v8i_t cat8(bf16x8 a, bf16x8 b) { const v4i_t x = __builtin_bit_cast(v4i_t, a), y = __builtin_bit_cast(v4i_t, b); return __builtin_shufflevector(x, y, 0, 1, 2, 3, 4, 5, 6, 7); }
__device__ __forceinline__ void mfma_fp8(f32x4& c, v8i_t a, v8i_t b, int sc) { asm volatile("v_mfma_scale_f32_16x16x128_f8f6f4 %0, %1, %2, %0, %3, %3 op_sel_hi:[0,0,0]" : "+v"(c) : "v"(a), "v"(b), "v"(sc)); }
struct NoSide { static constexpr bool ON = false, TWO = false; int njobs; };
struct SideConv {
    static constexpr bool ON = true, TWO = true;
    const float* W; unsigned char* OUT; int ntot; int c0, njobs; unsigned stage;
    __device__ __forceinline__ void addr(int j, int tid, const float*& s0, unsigned char*& d) const {
        const int c = c0 + j, cpk = ntot >> 11, kpg = c / cpk, half = c - kpg * cpk, e = kpg >> 10, kp = kpg & 1023;
        s0 = W + (size_t)e * 2048 * ntot + (size_t)(2 * kp) * ntot + half * 2048 + 4 * tid;
        d = OUT + ((size_t)e * 1024 + kp) * ntot * 2 + (size_t)(half * 2048 + 4 * tid) * 2;
    }
    __device__ __forceinline__ void issue(PG8_LAS unsigned char* lds0, int j, int tid, int wid) const {
        const float* s0; unsigned char* d; addr(j, tid, s0, d);
        __builtin_amdgcn_global_load_lds((const unsigned*)s0, (PG8_LAS unsigned*)(lds0 + stage + wid * 1024), 16, 0, 2);
        __builtin_amdgcn_global_load_lds((const unsigned*)(s0 + ntot), (PG8_LAS unsigned*)(lds0 + stage + 8192 + wid * 1024), 16, 0, 2);
    }
    __device__ __forceinline__ void read(v4i_t& t0, v4i_t& t1, int tid, unsigned ldsb) const {
        asm volatile("ds_read_b128 %0, %1" : "=&v"(t0) : "v"(ldsb + stage + 16u * (unsigned)tid) : "memory");
        asm volatile("ds_read_b128 %0, %1" : "=&v"(t1) : "v"(ldsb + stage + 8192u + 16u * (unsigned)tid) : "memory");
    }
    __device__ __forceinline__ void finish(v4i_t& t0, v4i_t& t1, int j, int tid) const {
        asm volatile("" : "+v"(t0), "+v"(t1));
        const float* s0; unsigned char* d; addr(j, tid, s0, d);
        const f32x4 r0 = __builtin_bit_cast(f32x4, t0) * 64.f, r1 = __builtin_bit_cast(f32x4, t1) * 64.f;
        int w0 = 0, w1 = 0; w0 = __builtin_amdgcn_cvt_pk_fp8_f32(r0[0], r1[0], w0, false); w0 = __builtin_amdgcn_cvt_pk_fp8_f32(r0[1], r1[1], w0, true);
        w1 = __builtin_amdgcn_cvt_pk_fp8_f32(r0[2], r1[2], w1, false); w1 = __builtin_amdgcn_cvt_pk_fp8_f32(r0[3], r1[3], w1, true);
        typedef int v2is __attribute__((ext_vector_type(2))); __builtin_nontemporal_store((v2is){w0, w1}, (v2is*)d);
    }
};
template <class Epi, class Sched, bool ALIGN_EPI = false, bool SP2 = false, bool FP8 = false, bool BPAIR = false, class Side = NoSide>
__device__ __forceinline__ void gemm_phase(PG8_LAS unsigned char* lds, const Gemm g, const Sched& S, const Epi& E, const Side SD = Side{}) {
    const int tid = threadIdx.x, wid = __builtin_amdgcn_readfirstlane(tid >> 6), lane = tid & 63, wr = wid >> 2, wc = wid & 3, fr = lane & 15, fq = lane >> 4;
    const int K = g.K, nt = K / BK;
    int fp8_scale1 = 0x7f7f7f7f; if constexpr (FP8) asm volatile("" : "+v"(fp8_scale1));
    unsigned voffA[2], voffB[2];
#pragma unroll
    for (int i = 0; i < 2; ++i) { int R, C; stage_rc(tid * 16 + i * 8192, R, C); const int Rb = Epi::PERM ? ((R & ~31) + perm32(R & 31)) : R;
        voffA[i] = (unsigned)(R * K + C) * 2u; voffB[i] = (unsigned)(Rb * K + C) * 2u;
        if constexpr (BPAIR) { const int b_ = tid * 16 + i * 8192, kp_ = b_ >> 8, sl_ = (b_ & 255) >> 4, pc_ = sl_ ^ (2 * ((kp_ & 3) | (((kp_ >> 3) & 1) << 2))); voffB[i] = (unsigned)(kp_ * g.b_ntot + 8 * pc_) * 2u; } }
    const size_t kstep = (size_t)(BK * 2);
    const size_t hstep = (size_t)HALF * K * 2;
    const size_t tstep = 2 * hstep;
    const size_t kstepB = BPAIR ? (size_t)64 * g.b_ntot * 2 : kstep, hstepB = BPAIR ? (size_t)g.b_hstep : hstep;
    const unsigned ldsw = (unsigned)wid * 1024u;
    const int aoff = lds_byte(wr * 64 + fr, fq * 8), boff = lds_byte(wc * 32 + fr, fq * 8);
    const int boffP = (8 * fq + ((lane & 15) >> 2)) * 256 + 16 * ((4 * wc + (lane & 3)) ^ (2 * (((lane & 15) >> 2) | ((fq & 1) << 2))));
#define PG8_SA(b, h) (((b) * 2 + (h)) * HTB)
#define PG8_SB(b, h) ((4 + (b) * 2 + (h)) * HTB)
#define PG8_STAGE(bufoff, gbase, voff) do { _Pragma("unroll") for (int _i = 0; _i < 2; ++_i) \
        __builtin_amdgcn_global_load_lds((const unsigned*)((const char*)(gbase) + (voff)[_i]), (PG8_LAS unsigned*)(lds + (bufoff) + ldsw + _i * 8192), 16, 0, 0); } while (0)
#define PG8_LDA(dst, b, h) do { _Pragma("unroll") for (int m = 0; m < 4; ++m) _Pragma("unroll") for (int k = 0; k < 2; ++k) dst[m][k] = *(const PG8_LAS bf16x8*)(lds + PG8_SA(b, h) + aoff + m * 2048 + k * 1024); } while (0)
#define PG8_TRA(dstv, addr, off) asm volatile("ds_read_b64_tr_b16 %0, %1 offset:%c2" : "=&v"(dstv) : "v"(addr), "i"(off) : "memory")
#define PG8_LDB(dst, b, h) do { if constexpr (BPAIR) { _Pragma("unroll") for (int n = 0; n < 2; ++n) { const unsigned a_ = ldsb32 + (unsigned)(PG8_SB(b, h) + boffP + 8 * n); \
            PG8_TRA(dst##r[n][0], a_, 0); PG8_TRA(dst##r[n][1], a_, 1024); PG8_TRA(dst##r[n][2], a_, 8192); PG8_TRA(dst##r[n][3], a_, 9216); } } \
        else { _Pragma("unroll") for (int n = 0; n < 2; ++n) _Pragma("unroll") for (int k = 0; k < 2; ++k) dst[n][k] = *(const PG8_LAS bf16x8*)(lds + PG8_SB(b, h) + boff + n * 2048 + k * 1024); } } while (0)
#define PG8_FIXB(dst) do { if constexpr (BPAIR) { _Pragma("unroll") for (int n = 0; n < 2; ++n) { \
            asm volatile("" : "+v"(dst##r[n][0]), "+v"(dst##r[n][1]), "+v"(dst##r[n][2]), "+v"(dst##r[n][3])); \
            dst[n][0] = __builtin_bit_cast(bf16x8, (v4i_t){dst##r[n][0][0], dst##r[n][0][1], dst##r[n][1][0], dst##r[n][1][1]}); dst[n][1] = __builtin_bit_cast(bf16x8, (v4i_t){dst##r[n][2][0], dst##r[n][2][1], dst##r[n][3][0], dst##r[n][3][1]}); } } } while (0)
#define PG8_MMA(ai, bj, At, Bt) do { __builtin_amdgcn_s_setprio(1); _Pragma("unroll") for (int m = 0; m < 4; ++m) _Pragma("unroll") for (int n = 0; n < 2; ++n) { \
        if constexpr (FP8) { mfma_fp8(acc[ai][bj][m][n], cat8(Bt[n][0], Bt[n][1]), cat8(At[m][0], At[m][1]), fp8_scale1); } \
        else { _Pragma("unroll") for (int k = 0; k < 2; ++k) acc[ai][bj][m][n] = __builtin_amdgcn_mfma_f32_16x16x32_bf16(Bt[n][k], At[m][k], acc[ai][bj][m][n], 0, 0, 0); } } \
        __builtin_amdgcn_s_setprio(0); } while (0)
#define PG8_WAIT_V(n) asm volatile("s_waitcnt vmcnt(" #n ")" ::: "memory")
#define PG8_WAIT_L(n) asm volatile("s_waitcnt lgkmcnt(" #n ")" ::: "memory")
#define PG8_BAR __builtin_amdgcn_s_barrier()
#define PG8_SCHED __builtin_amdgcn_sched_barrier(0)
    Unit cur, nxt; int ui = 0;
    if (!S.next(0, cur)) return;
    f32x4 acc[2][2][4][2];
#pragma unroll
    for (int a = 0; a < 2; ++a)
#pragma unroll
        for (int b = 0; b < 2; ++b)
#pragma unroll
            for (int m = 0; m < 4; ++m)
#pragma unroll
                for (int n = 0; n < 2; ++n) acc[a][b][m][n] = (f32x4){0.f, 0.f, 0.f, 0.f};
    bf16x8 At[4][2], B0[2][2], B1[2][2];
    int sj = 0; bool spend = false; v4i_t st0 = {0, 0, 0, 0}, st1 = st0; PG8_LAS unsigned char* const lds0 = lds;
    v2i_t B0r[2][4], B1r[2][4]; const unsigned ldsb32 = (unsigned)(size_t)lds;
    const char* cA = (const char*)g.A + (size_t)cur.pm * tstep; const char* cB = (const char*)g.Bt + (BPAIR ? (size_t)cur.boff : (size_t)cur.pn * tstep);
    S.a_ready(cur);
    if constexpr (SP2) {
        PG8_STAGE(PG8_SB(0, 0), cB, voffB); PG8_STAGE(PG8_SB(0, 1), cB + hstepB, voffB); PG8_STAGE(PG8_SA(0, 0), cA, voffA); PG8_STAGE(PG8_SA(0, 1), cA + hstep, voffA);
        if (wr == 1) PG8_BAR;
        PG8_WAIT_V(2); PG8_BAR;
        PG8_STAGE(PG8_SB(1, 0), cB + kstepB, voffB); PG8_STAGE(PG8_SA(1, 0), cA + kstep, voffA); PG8_STAGE(PG8_SB(1, 1), cB + hstepB + kstepB, voffB);
        PG8_WAIT_V(6); PG8_BAR;
    } else {
        PG8_STAGE(PG8_SB(0, 0), cB, voffB); PG8_STAGE(PG8_SA(0, 0), cA, voffA); PG8_STAGE(PG8_SB(0, 1), cB + hstepB, voffB); PG8_STAGE(PG8_SA(0, 1), cA + hstep, voffA);
        if (wr == 1) PG8_BAR;
        PG8_WAIT_V(4); PG8_BAR;
        PG8_STAGE(PG8_SB(1, 0), cB + kstepB, voffB); PG8_STAGE(PG8_SA(1, 0), cA + kstep, voffA); PG8_STAGE(PG8_SB(1, 1), cB + hstepB + kstepB, voffB);
        PG8_WAIT_V(6); PG8_BAR;
    }
    for (;;) {
        const bool has_next = S.next(ui + 1, nxt);
        const char* nA = has_next ? (const char*)g.A + (size_t)nxt.pm * tstep : cA; const char* nB = has_next ? (const char*)g.Bt + (BPAIR ? (size_t)nxt.boff : (size_t)nxt.pn * tstep) : cB;
        for (int t = 0; t < nt; t += 2) {
            const bool last = (t == nt - 2);
            const char* a1 = cA + (size_t)(t + 1) * kstep;
            const char* a2 = last ? nA : cA + (size_t)(t + 2) * kstep; const char* b2 = last ? nB : cB + (size_t)(t + 2) * kstepB;
            const char* a3 = a2 + kstep; const char* b3 = b2 + kstepB;
            if (last && has_next) S.a_ready(nxt);
            if constexpr (SP2) {
            PG8_LDB(B0, 0, 0); PG8_LDB(B1, 0, 1); PG8_SCHED; PG8_LDA(At, 0, 0); PG8_STAGE(PG8_SA(1, 1), a1 + hstep, voffA);
            PG8_WAIT_V(8);
            if constexpr (Side::ON) { if (spend) SD.read(st0, st1, tid, (unsigned)(size_t)lds); }
            PG8_WAIT_L(0); PG8_FIXB(B0); PG8_FIXB(B1);
            if constexpr (Side::ON) { if (spend) { SD.finish(st0, st1, sj - 1, tid); spend = false; } if (sj < SD.njobs) { SD.issue(lds0, sj, tid, wid); ++sj; spend = true; } }
            PG8_BAR; PG8_MMA(0, 0, At, B0); PG8_MMA(0, 1, At, B1); PG8_BAR; PG8_SCHED;
            PG8_LDA(At, 0, 1); PG8_STAGE(PG8_SB(0, 0), b2, voffB); PG8_STAGE(PG8_SB(0, 1), b2 + hstepB, voffB); PG8_STAGE(PG8_SA(0, 0), a2, voffA);
            PG8_WAIT_V(8); PG8_WAIT_L(0); PG8_BAR; if (!(FP8 && cur.rows <= HALF)) { PG8_MMA(1, 0, At, B0); PG8_MMA(1, 1, At, B1); } PG8_BAR; PG8_SCHED;
            PG8_LDB(B0, 1, 0); PG8_LDB(B1, 1, 1); PG8_SCHED; PG8_LDA(At, 1, 0); PG8_STAGE(PG8_SA(0, 1), a2 + hstep, voffA);
            PG8_WAIT_V(8);
            if constexpr (Side::ON) { if (Side::TWO && spend) SD.read(st0, st1, tid, (unsigned)(size_t)lds); }
            PG8_WAIT_L(0); PG8_FIXB(B0); PG8_FIXB(B1);
            if constexpr (Side::ON) { if (Side::TWO) { if (spend) { SD.finish(st0, st1, sj - 1, tid); spend = false; } if (sj < SD.njobs) { SD.issue(lds0, sj, tid, wid); ++sj; spend = true; } } }
            PG8_BAR; PG8_MMA(0, 0, At, B0); PG8_MMA(0, 1, At, B1); PG8_BAR; PG8_SCHED;
            PG8_LDA(At, 1, 1); PG8_STAGE(PG8_SB(1, 0), b3, voffB); PG8_STAGE(PG8_SB(1, 1), b3 + hstepB, voffB); PG8_STAGE(PG8_SA(1, 0), a3, voffA);
            PG8_WAIT_V(8); PG8_WAIT_L(0); PG8_BAR; if (!(FP8 && cur.rows <= HALF)) { PG8_MMA(1, 0, At, B0); PG8_MMA(1, 1, At, B1); } PG8_BAR; PG8_SCHED;
            } else {
            PG8_LDB(B0, 0, 0); PG8_SCHED; PG8_LDA(At, 0, 0); PG8_STAGE(PG8_SA(1, 1), a1 + hstep, voffA);
            PG8_WAIT_L(8); PG8_BAR; PG8_WAIT_L(0); PG8_MMA(0, 0, At, B0); PG8_BAR; PG8_SCHED;
            PG8_LDB(B1, 0, 1); PG8_STAGE(PG8_SB(0, 0), b2, voffB);
            PG8_BAR; PG8_WAIT_L(0); PG8_MMA(0, 1, At, B1); PG8_BAR;
            PG8_LDA(At, 0, 1); PG8_STAGE(PG8_SA(0, 0), a2, voffA);
            PG8_BAR; PG8_WAIT_L(0); PG8_MMA(1, 0, At, B0); PG8_BAR; PG8_SCHED;
            PG8_STAGE(PG8_SB(0, 1), b2 + hstepB, voffB);
            PG8_WAIT_V(6); PG8_BAR; PG8_MMA(1, 1, At, B1); PG8_BAR;
            PG8_LDB(B0, 1, 0); PG8_SCHED; PG8_LDA(At, 1, 0); PG8_STAGE(PG8_SA(0, 1), a2 + hstep, voffA);
            PG8_WAIT_L(8); PG8_BAR; PG8_WAIT_L(0); PG8_MMA(0, 0, At, B0); PG8_BAR; PG8_SCHED;
            PG8_LDB(B1, 1, 1); PG8_STAGE(PG8_SB(1, 0), b3, voffB);
            PG8_BAR; PG8_WAIT_L(0); PG8_MMA(0, 1, At, B1); PG8_BAR;
            PG8_LDA(At, 1, 1); PG8_STAGE(PG8_SA(1, 0), a3, voffA);
            PG8_BAR; PG8_WAIT_L(0); PG8_MMA(1, 0, At, B0); PG8_BAR; PG8_SCHED;
            PG8_STAGE(PG8_SB(1, 1), b3 + hstepB, voffB);
            PG8_WAIT_V(6); PG8_BAR; PG8_MMA(1, 1, At, B1); PG8_BAR;
            }
        }
        if constexpr (ALIGN_EPI) { if (wr == 0) PG8_BAR; }
        if constexpr (FP8) asm volatile("s_nop 15\n\ts_nop 15" ::: "memory");
        if constexpr (!Epi::AFTER_DRAIN) { int tz = threadIdx.x; asm volatile("" : "+v"(tz));
            const int wz = __builtin_amdgcn_readfirstlane(tz >> 6), lz = tz & 63; E(acc, cur, wz >> 2, wz & 3, lz & 15, lz >> 4); S.done(cur); }
        if (!has_next) break;
#pragma unroll
        for (int a = 0; a < 2; ++a)
#pragma unroll
            for (int b = 0; b < 2; ++b)
#pragma unroll
                for (int m = 0; m < 4; ++m)
#pragma unroll
                    for (int n = 0; n < 2; ++n) acc[a][b][m][n] = (f32x4){0.f, 0.f, 0.f, 0.f};
        cur = nxt; cA = nA; cB = nB; ++ui;
        if constexpr (ALIGN_EPI) { if (wr == 1) PG8_BAR; }
    }
    PG8_WAIT_V(0);
    if constexpr (!ALIGN_EPI) { if (wr == 0) PG8_BAR; }
    PG8_BAR;
    if constexpr (Side::ON) { if (spend) { SD.read(st0, st1, tid, (unsigned)(size_t)lds); PG8_WAIT_L(0); SD.finish(st0, st1, sj - 1, tid); spend = false; } }
    if constexpr (Epi::AFTER_DRAIN) { E.fused(acc, cur, wr, wc, fr, fq, lds, wid, lane); S.done(cur); }
#undef PG8_SA
#undef PG8_SB
#undef PG8_STAGE
#undef PG8_LDA
#undef PG8_LDB
#undef PG8_TRA
#undef PG8_FIXB
#undef PG8_MMA
#undef PG8_WAIT_V
#undef PG8_WAIT_L
#undef PG8_BAR
#undef PG8_SCHED
}
}
#define GAS __attribute__((address_space(1)))
#define LAS __attribute__((address_space(3)))
typedef unsigned short bf16;
typedef unsigned v4u __attribute__((ext_vector_type(4)));
typedef float f32x4 __attribute__((ext_vector_type(4)));
typedef short bf16x8 __attribute__((ext_vector_type(8)));
typedef GAS unsigned gu32;
typedef GAS unsigned long long gu64;
#define RLX_AGENT __ATOMIC_RELAXED, __HIP_MEMORY_SCOPE_AGENT
#define LDS_WAIT() asm volatile("s_waitcnt lgkmcnt(0)" ::: "memory")
#define VM_WAIT() asm volatile("s_waitcnt vmcnt(0)" ::: "memory")
__device__ __forceinline__ unsigned long long rt() { return __builtin_amdgcn_s_memrealtime(); }
__device__ __forceinline__ unsigned f2bf(float f) { unsigned u = __builtin_bit_cast(unsigned, f); return (u + 0x7fffu + ((u >> 16) & 1u)) >> 16; }
__device__ __forceinline__ unsigned pk2(float lo, float hi) { return f2bf(lo) | (f2bf(hi) << 16); }

#define XB_TMO      128
#define XB_XCNT(j)  (256  + 64 * (j))
#define XB_XSUB(j)  (1280 + 64 * (j))
#define XB_XGEN(j)  (2304 + 64 * (j))
#define XB_TOP      3328
#define XB_TOPGEN   3392
#define XCD_BAR_WORDS 3456
#define XB_SPIN_CAP (1u << 18)

__device__ __forceinline__ unsigned xb_ld(unsigned* p)              { return __hip_atomic_load(p, __ATOMIC_RELAXED, __HIP_MEMORY_SCOPE_AGENT); }
__device__ __forceinline__ unsigned xb_add(unsigned* p, unsigned v) { return __hip_atomic_fetch_add(p, v, __ATOMIC_RELAXED, __HIP_MEMORY_SCOPE_AGENT); }
__device__ __forceinline__ unsigned xb_xcc_id() { return (unsigned)__builtin_amdgcn_s_getreg((3 << 11) | 20) & 0xFu; }
#define XB_SPIN(cond, bar) do { unsigned _sp = 0; while (cond) { __builtin_amdgcn_s_sleep(1); \
    if ((++_sp & 255u) == 0u) { if (xb_ld(&(bar)[XB_TMO])) break; if (_sp > XB_SPIN_CAP) { atomicAdd(&(bar)[XB_TMO], 1u); break; } } } } while (0)

struct XcdBarrier {
    unsigned* bar; unsigned x;
    volatile LAS unsigned* st;
};

__device__ __forceinline__ XcdBarrier xcd_barrier_post(unsigned* bar, volatile LAS unsigned* st) {
    XcdBarrier b; b.bar = bar; b.x = xb_xcc_id(); b.st = st;
    if (threadIdx.x == 0) (void)xb_add(&bar[XB_XCNT(b.x)], 1u);
    return b;
}
__device__ __forceinline__ void xcd_barrier_complete(unsigned* bar, unsigned x, unsigned& nloc, unsigned& nx) {
    const unsigned G = gridDim.x * gridDim.y * gridDim.z;
    unsigned sum, cnt, mine, sp = 0u;
    for (;;) {
        sum = 0u; cnt = 0u; mine = 0u;
#pragma unroll
        for (unsigned j = 0; j < 16; ++j) { const unsigned c = xb_ld(&bar[XB_XCNT(j)]); sum += c; cnt += (c > 0u) ? 1u : 0u; mine = (j == x) ? c : mine; }
        if (sum == G) break;
        __builtin_amdgcn_s_sleep(1);
        if ((++sp & 255u) == 0u) { if (xb_ld(&bar[XB_TMO])) break; if (sp > XB_SPIN_CAP) { atomicAdd(&bar[XB_TMO], 1u); break; } }
    }
    nloc = mine > 0u ? mine : 1u; nx = cnt > 0u ? cnt : 1u;
}

__device__ __forceinline__ void xcd_barrier(const XcdBarrier& b) {
    asm volatile("s_waitcnt vmcnt(0)" ::: "memory");
    __syncthreads();
    if (threadIdx.x == 0) {
        unsigned* bar = b.bar;
        __builtin_amdgcn_s_waitcnt(0);
        unsigned nloc = b.st[0], nx = b.st[1];
        if (nloc == 0u) { xcd_barrier_complete(bar, b.x, nloc, nx); b.st[0] = nloc; b.st[1] = nx; }
        const unsigned old = xb_add(&bar[XB_XSUB(b.x)], 1u);
        const unsigned gen = old / nloc;
        if (old + 1u == (gen + 1u) * nloc) {
            __builtin_amdgcn_fence(__ATOMIC_RELEASE, "agent");
            asm volatile("s_waitcnt vmcnt(0)" ::: "memory");
            const unsigned og = xb_add(&bar[XB_TOP], 1u);
            const unsigned tg = og / nx;
            if (og + 1u == (tg + 1u) * nx) xb_add(&bar[XB_TOPGEN], 1u);
            else XB_SPIN(xb_ld(&bar[XB_TOPGEN]) == tg, bar);
            __builtin_amdgcn_fence(__ATOMIC_ACQUIRE, "agent");
            xb_add(&bar[XB_XGEN(b.x)], 1u);
            asm volatile("s_waitcnt vmcnt(0)" ::: "memory");
        } else {
            XB_SPIN(xb_ld(&bar[XB_XGEN(b.x)]) == gen, bar);
            __builtin_amdgcn_fence(__ATOMIC_ACQUIRE, "agent");
            asm volatile("s_waitcnt vmcnt(0)" ::: "memory");
        }
    }
    __syncthreads();
}

constexpr int NB = 4, SEQ = 2048, DM = 2048, NTOK = NB * SEQ, INC = 6144, CW = 512, AW = 1536, NH = 24, HD = 64, NE = 32, TOPK = 4, DE = 2048;
constexpr int QOFF = 1536, KOFF = 3072, VOFF = 4608;
constexpr int MAXSLOT = NE * NTOK;
constexpr float EPS = 1e-5f;
typedef unsigned u32x2v __attribute__((ext_vector_type(2)));
constexpr int NWAVES = 8;
#ifndef MK_N_LAUNCHES
#define MK_N_LAUNCHES 1
#endif
#ifndef PROBE_MASK
#define PROBE_MASK 0
#endif
#ifndef PROBE_N
#define PROBE_N 2
#endif
#define REPS(k) (((PROBE_MASK >> (k)) & 1) ? PROBE_N : 1)
constexpr int NPH = 10;

constexpr size_t MiB = 1u << 20;
constexpr size_t WS_CTL = 0, CTL_ZERO_BYTES = 1 * MiB;
constexpr size_t WS_ROPE = 1 * MiB;
constexpr size_t WS_TOKE = 2 * MiB, WS_TOKR = WS_TOKE + 128 * 1024, WS_TOKG = WS_TOKR + 128 * 1024;
constexpr size_t WS_LIST = 3 * MiB;
constexpr size_t WS_WIN = 8 * MiB;
constexpr size_t WS_WO = 32 * MiB;
constexpr size_t WS_XN = 40 * MiB;
constexpr size_t WS_PROJ = 72 * MiB;
constexpr size_t WS_YATT = 168 * MiB;
constexpr size_t WS_MIXED = 192 * MiB;
constexpr size_t WS_X1 = 224 * MiB;
constexpr size_t WS_XN2 = 288 * MiB;
constexpr size_t WS_XS = 320 * MiB;
constexpr size_t WS_ACT = 832 * MiB;
constexpr size_t WS_Y = 1344 * MiB;
constexpr size_t WS_WGU = 2368 * MiB;
constexpr size_t WS_WDN = 2624 * MiB;
constexpr size_t WS_END = 2752 * MiB;
constexpr int CW_TMO = 0, CW_CODE = 1;
constexpr int CW_BAR = 4096;
constexpr int CW_CNT = 8192;
constexpr int CW_ATTQ = 12288;
constexpr int CW_CONVQ = 12288 + 4096;
constexpr int CW_P1DONE = 12288 + 8192;
#ifndef ATT_ITEM
#define ATT_ITEM item2
#endif
#ifndef ATT_NOFALL
#define ATT_NOFALL 1
#endif
#ifndef ATT_JOIN
#define ATT_JOIN 0
#endif
#ifndef SIDE_CONV
#define SIDE_CONV 3
#endif
#ifndef SPLIT_P1
#define SPLIT_P1 0
#endif
#ifndef FUSED2
#define FUSED2 0
#endif
#ifndef FUSED_CONV
#define FUSED_CONV 0
#endif
#ifndef ATT_WAVES
#define ATT_WAVES 6
#endif
constexpr int RING_BYTES = 131072;
constexpr int LDSCTL_OFF = RING_BYTES;
constexpr int MISC_OFF = LDSCTL_OFF + 320;
constexpr int TAB_TS = LDSCTL_OFF + 1024;
constexpr int TAB_CN = LDSCTL_OFF + 1024 + 512;
constexpr int PART_OFF = RING_BYTES + 16384;
constexpr int LDS_BYTES = 163840;

__device__ __forceinline__ float wave_sum(float v) {
#pragma unroll
    for (int o = 1; o < 64; o <<= 1) v += __shfl_xor(v, o);
    return v;
}
__device__ __forceinline__ float bf_lo(unsigned w) { return __uint_as_float(w << 16); }
__device__ __forceinline__ float bf_hi(unsigned w) { return __uint_as_float(w & 0xffff0000u); }

__device__ __forceinline__ void p0_transpose_item(const float* W, int N, int K, bf16* WT, int k0, int n0, int out_row0, LAS float* scr, int lane) {
#pragma unroll 8
    for (int i = 0; i < 32; ++i) { const int kk = 2 * i + (lane >> 5); scr[kk * 33 + (lane & 31)] = __builtin_nontemporal_load(W + (size_t)(k0 + kk) * N + n0 + (lane & 31)); }
    LDS_WAIT(); asm volatile("" ::: "memory");
    const int c = lane & 7;
#pragma unroll
    for (int j = 0; j < 4; ++j) { const int n = (lane >> 3) + 8 * j; const LAS float* s = scr + (8 * c) * 33 + n;
        v4u o; o.x = pk2(s[0 * 33], s[1 * 33]); o.y = pk2(s[2 * 33], s[3 * 33]); o.z = pk2(s[4 * 33], s[5 * 33]); o.w = pk2(s[6 * 33], s[7 * 33]);
        *(GAS v4u*)(WT + (size_t)(out_row0 + n) * K + k0 + 8 * c) = o; }
    LDS_WAIT(); asm volatile("" ::: "memory");
}

__device__ __forceinline__ void p0_transpose_item_fp8(const float* W, int N, int K, unsigned char* WT, int k0, int n0, int out_row0, float scale, LAS float* scr, int lane) {
#pragma unroll 8
    for (int i = 0; i < 32; ++i) { const int kk = 2 * i + (lane >> 5); scr[kk * 33 + (lane & 31)] = W[(size_t)(k0 + kk) * N + n0 + (lane & 31)]; }
    LDS_WAIT(); asm volatile("" ::: "memory");
    const int c = lane & 3;
#pragma unroll
    for (int j = 0; j < 2; ++j) { const int n = (lane >> 2) + 16 * j; const LAS float* s = scr + (16 * c) * 33 + n;
        v4u o;
        o.x = pg8::pk4_fp8(scale * s[0 * 33], scale * s[1 * 33], scale * s[2 * 33], scale * s[3 * 33]);
        o.y = pg8::pk4_fp8(scale * s[4 * 33], scale * s[5 * 33], scale * s[6 * 33], scale * s[7 * 33]);
        o.z = pg8::pk4_fp8(scale * s[8 * 33], scale * s[9 * 33], scale * s[10 * 33], scale * s[11 * 33]);
        o.w = pg8::pk4_fp8(scale * s[12 * 33], scale * s[13 * 33], scale * s[14 * 33], scale * s[15 * 33]);
        *(GAS v4u*)(WT + (size_t)(out_row0 + n) * K + k0 + 16 * c) = o; }
    LDS_WAIT(); asm volatile("" ::: "memory");
}

__device__ __forceinline__ unsigned pk4_fp8_nc(float a, float b, float c, float d) { int w = 0; w = __builtin_amdgcn_cvt_pk_fp8_f32(a, b, w, false); w = __builtin_amdgcn_cvt_pk_fp8_f32(c, d, w, true); return (unsigned)w; }
struct ConvDesc { const float* src; unsigned char* dstb; int N, isdn; };
constexpr int CV_NG = 16, PER_E = 256 + 128, NCONV = 32 * PER_E;
__device__ __forceinline__ ConvDesc conv_decode(int it, const float* w_gu, const float* w_dn, unsigned char* WGU, unsigned char* WDN, int lane) {
    const int e = it / PER_E, r = it - e * PER_E; ConvDesc d;
    if (r < 256) { const int kp0 = 4 * r; d.N = 4096; d.isdn = 0; d.src = w_gu + (size_t)e * 2048 * 4096 + (size_t)(2 * kp0) * 4096 + 4 * lane; d.dstb = WGU + (size_t)e * 1024 * 8192 + (size_t)kp0 * 8192 + 8 * lane; }
    else { const int kp0 = 8 * (r - 256); d.N = 2048; d.isdn = 1; d.src = w_dn + (size_t)e * 2048 * 2048 + (size_t)(2 * kp0) * 2048 + 4 * lane; d.dstb = WDN + (size_t)e * 1024 * 4096 + (size_t)kp0 * 4096 + 8 * lane; }
    return d;
}
#define CV_LOAD(R, D, g) do { const int ro_ = (D).isdn ? 4 * ((g) >> 3) : 0, co_ = (D).isdn ? 256 * ((g) & 7) : 256 * (g); \
        _Pragma("unroll") for (int t_ = 0; t_ < 4; ++t_) _Pragma("unroll") for (int i_ = 0; i_ < 2; ++i_) R[2 * t_ + i_] = __builtin_nontemporal_load((const GAS f32x4*)((D).src + (size_t)(2 * (ro_ + t_) + i_) * (D).N + co_)); } while (0)
#define CV_PROC(R, D, g) do { const int ro_ = (D).isdn ? 4 * ((g) >> 3) : 0, co_ = (D).isdn ? 256 * ((g) & 7) : 256 * (g); \
        _Pragma("unroll") for (int t_ = 0; t_ < 4; ++t_) { u32x2v o_; \
            o_.x = pk4_fp8_nc(pg8::FP8_W_SCALE * R[2 * t_][0], pg8::FP8_W_SCALE * R[2 * t_ + 1][0], pg8::FP8_W_SCALE * R[2 * t_][1], pg8::FP8_W_SCALE * R[2 * t_ + 1][1]); \
            o_.y = pk4_fp8_nc(pg8::FP8_W_SCALE * R[2 * t_][2], pg8::FP8_W_SCALE * R[2 * t_ + 1][2], pg8::FP8_W_SCALE * R[2 * t_][3], pg8::FP8_W_SCALE * R[2 * t_ + 1][3]); \
            __builtin_nontemporal_store(o_, (GAS u32x2v*)((D).dstb + (size_t)(ro_ + t_) * (D).N * 2 + 2 * co_)); } } while (0)

namespace att {
typedef short s16x8 __attribute__((ext_vector_type(8)));
typedef short s16x4 __attribute__((ext_vector_type(4)));
typedef float f32x16 __attribute__((ext_vector_type(16)));
typedef unsigned u32x4 __attribute__((ext_vector_type(4)));
constexpr int VP = 144;
constexpr int WAVE_LDS = 32 * VP;
constexpr float C2 = 0.125f * 1.4426950408889634f;
constexpr int NITEMS = 16 * NB * NH * 4;
typedef short v4i16_t __attribute__((ext_vector_type(4)));
__device__ __forceinline__ s16x4 vtr(LAS const char* p) { return __builtin_bit_cast(s16x4, __builtin_amdgcn_ds_read_tr16_b64_v4i16((LAS v4i16_t*)p)); }

struct TileD { int abase, kp_off, kp_mul, W, mod4, sel; };
__device__ __forceinline__ TileD tile_desc(int u, int n1, int n2, int first1, int first2, int m0, int r4) {
    TileD d;
    if (u < n1) { d.abase = 4 * m0 - 128 + 32 * (first1 + u); d.kp_off = 0; d.kp_mul = 1; d.W = 128; d.mod4 = 0; d.sel = 0; }
    else if (u < n1 + n2) { d.abase = m0 - 128 + 32 * (first2 + u - n1); d.kp_off = r4; d.kp_mul = 4; d.W = 128; d.mod4 = 0; d.sel = 1; }
    else { d.abase = 32 * (u - n1 - n2); d.kp_off = r4; d.kp_mul = 4; d.W = 0x7fffffff; d.mod4 = 1; d.sel = 1; }
    return d;
}
#define ATT_LOADT(KF, VF, D) do { _Pragma("unroll") for (int j_ = 0; j_ < 4; ++j_) { const int pos_ = (D).kp_off + (D).kp_mul * ((D).abase + 8 * j_ + (lane >> 3)); \
        KF[j_] = *(const GAS u32x4*)(Kb + (size_t)pos_ * INC + 8 * (lane & 7)); VF[j_] = *(const GAS u32x4*)(Vb + (size_t)pos_ * INC + 8 * (lane & 7)); } } while (0)

template <int PMODE = 0>
__device__ __forceinline__ void item(int it, const bf16* PROJ, bf16* YATT, LAS char* vl, int lane) {
    const int bh = it >> 6, jj = it & 63; const int b = bh / NH, head = bh - b * NH, mb = 15 - (jj >> 2), r4 = jj & 3;
    const int m0 = mb * 32, q = lane & 31, h = lane >> 5;
    const int qpos = r4 + 4 * (m0 + q);
    const bf16* base = PROJ + (size_t)b * SEQ * INC;
    const bf16* Kb = base + KOFF + head * HD; const bf16* Vb = base + VOFF + head * HD;
    const int first1 = (mb == 0) ? 4 : 0, first2 = (mb < 4) ? 4 - mb : 0, n1 = 8 - first1, n2 = 5 - first2, ntile = n1 + n2 + mb + 1;
    u32x4 kA[4], vA[4], kB[4], vB[4];
    { const TileD d0 = tile_desc(0, n1, n2, first1, first2, m0, r4); ATT_LOADT(kA, vA, d0); }
    s16x8 qf[4];
    { const bf16* qp = base + (size_t)qpos * INC + QOFF + head * HD + 8 * h;
#pragma unroll
      for (int d0 = 0; d0 < 4; ++d0) qf[d0] = __builtin_bit_cast(s16x8, *(const GAS u32x4*)(qp + 16 * d0)); }
    f32x16 o0 = {}, o1 = {}; float mrun = -1e30f, lrun = 0.f;
    const int g = lane >> 4, qq = (lane & 15) >> 2, pp = lane & 3;
    LAS const char* vb = vl + (4 * h + qq) * VP + (16 * (g & 1) + 4 * pp) * 2;
    LAS char* kl = vl + WAVE_LDS;
    LAS u32x4* vd = (LAS u32x4*)(vl + (lane >> 3) * VP + (lane & 7) * 16);
    LAS u32x4* kd = (LAS u32x4*)(kl + (lane >> 3) * VP + (lane & 7) * 16);
    LAS const char* kfp = kl + (lane & 31) * VP + h * 16;
#pragma unroll 1
    for (int u = 0; u < ntile; ++u) {
        const TileD d = tile_desc(u, n1, n2, first1, first2, m0, r4);
        if (PMODE != 1) { const int un = (u + 1 < ntile) ? u + 1 : u; const TileD dn = tile_desc(un, n1, n2, first1, first2, m0, r4); ATT_LOADT(kB, vB, dn); }
#pragma unroll
        for (int j = 0; j < 4; ++j) { *(LAS u32x4*)((LAS char*)kd + 8 * j * VP) = kA[j]; *(LAS u32x4*)((LAS char*)vd + 8 * j * VP) = vA[j]; }
        if (PMODE != 2) {
        f32x16 s = {};
#pragma unroll
        for (int d0 = 0; d0 < 4; ++d0) s = __builtin_amdgcn_mfma_f32_32x32x16_bf16(*(const LAS s16x8*)(kfp + 32 * d0), qf[d0], s, 0, 0, 0);
        const int bq = d.sel ? (m0 + q) : qpos;
        const int t0 = bq - d.abase - 4 * h; const unsigned W = (unsigned)d.W; const int m4 = d.mod4 ? 3 : 0;
        float mx = -INFINITY;
#pragma unroll
        for (int r = 0; r < 16; ++r) { const int dd = t0 - ((r & 3) + 8 * (r >> 2));
            const bool ok = ((unsigned)dd <= W) && ((dd & m4) == 0);
            s[r] = ok ? s[r] : -INFINITY; mx = fmaxf(mx, s[r]); }
        mx = fmaxf(mx, __shfl_xor(mx, 32));
        const float mnew = fmaxf(mrun, mx), alpha = __builtin_amdgcn_exp2f(mrun - mnew); mrun = mnew;
        float ps = 0.f;
#pragma unroll
        for (int r = 0; r < 16; ++r) { s[r] = __builtin_amdgcn_exp2f(s[r] - mnew); ps += s[r]; }
        lrun = lrun * alpha + ps;
#pragma unroll
        for (int r = 0; r < 16; ++r) { o0[r] *= alpha; o1[r] *= alpha; }
        u32x4 p0, p1;
        p0.x = pk2(s[0], s[1]); p0.y = pk2(s[2], s[3]); p0.z = pk2(s[4], s[5]); p0.w = pk2(s[6], s[7]);
        p1.x = pk2(s[8], s[9]); p1.y = pk2(s[10], s[11]); p1.z = pk2(s[12], s[13]); p1.w = pk2(s[14], s[15]);
        const s16x8 pf0 = __builtin_bit_cast(s16x8, p0), pf1 = __builtin_bit_cast(s16x8, p1);
#pragma unroll
        for (int sstep = 0; sstep < 2; ++sstep) {
#pragma unroll
            for (int dh = 0; dh < 2; ++dh) {
                const s16x4 lo = vtr(vb + (16 * sstep) * VP + dh * 64), hi = vtr(vb + (16 * sstep + 8) * VP + dh * 64);
                const s16x8 vf = (s16x8){lo[0], lo[1], lo[2], lo[3], hi[0], hi[1], hi[2], hi[3]};
                if (dh == 0) o0 = __builtin_amdgcn_mfma_f32_32x32x16_bf16(vf, sstep ? pf1 : pf0, o0, 0, 0, 0);
                else         o1 = __builtin_amdgcn_mfma_f32_32x32x16_bf16(vf, sstep ? pf1 : pf0, o1, 0, 0, 0);
            }
        }
        }
        if (PMODE == 1) continue;
#pragma unroll
        for (int c = 0; c < 4; ++c) { kA[c] = kB[c]; vA[c] = vB[c]; }
    }
    const float inv = 1.0f / (lrun + __shfl_xor(lrun, 32));
    bf16* orow = YATT + (size_t)(b * SEQ + qpos) * AW + head * HD + 4 * h;
#pragma unroll
    for (int gq = 0; gq < 4; ++gq) {
        u32x2v a, c; a.x = pk2(o0[4 * gq] * inv, o0[4 * gq + 1] * inv); a.y = pk2(o0[4 * gq + 2] * inv, o0[4 * gq + 3] * inv);
        c.x = pk2(o1[4 * gq] * inv, o1[4 * gq + 1] * inv); c.y = pk2(o1[4 * gq + 2] * inv, o1[4 * gq + 3] * inv);
        *(u32x2v*)(orow + 8 * gq) = a; *(u32x2v*)(orow + 32 + 8 * gq) = c; }
}

__device__ __forceinline__ int krp(int key) { return (key & 0x16) | ((key >> 3) & 1) | ((key & 1) << 3); }
__device__ __forceinline__ void item2(int it, const bf16* PROJ, bf16* YATT, LAS char* wl, int lane) {
    const int bh = it >> 6, jj = it & 63; const int b = bh / NH, head = bh - b * NH, mb = 15 - (jj >> 2), r4 = jj & 3;
    const int m0 = mb * 32, q = lane & 31, h = lane >> 5;
    const int qpos = r4 + 4 * (m0 + q), bq2 = m0 + q;
    const bf16* base = PROJ + (size_t)b * SEQ * INC;
    const bf16* Kb = base + KOFF + head * HD; const bf16* Vb = base + VOFF + head * HD;
    const int first1 = (mb == 0) ? 4 : 0, first2 = (mb < 4) ? 4 - mb : 0, n1 = 8 - first1, n2 = 5 - first2, ntile = n1 + n2 + mb + 1, npair = (ntile + 1) >> 1;
    u32x4 k0[4], v0[4], k1[4], v1[4];
    { const TileD d0 = tile_desc(0, n1, n2, first1, first2, m0, r4); ATT_LOADT(k0, v0, d0); }
    { const TileD d1 = tile_desc(ntile > 1 ? 1 : 0, n1, n2, first1, first2, m0, r4); ATT_LOADT(k1, v1, d1); }
    s16x8 qf[4];
    { const bf16* qp = base + (size_t)qpos * INC + QOFF + head * HD + 8 * h;
#pragma unroll
      for (int d0 = 0; d0 < 4; ++d0) qf[d0] = __builtin_bit_cast(s16x8, *(const GAS u32x4*)(qp + 16 * d0)); }
    f32x16 o0 = {}, o1 = {}; float mrun = -1e30f, lrun = 0.f;
    const int g = lane >> 4, qq = (lane & 15) >> 2, pp = lane & 3;
    int kws[4];
#pragma unroll
    for (int j = 0; j < 4; ++j) { const int key = 8 * j + (lane >> 3); kws[j] = krp(key) * 128 + (((lane & 7) ^ (key & 7)) << 4); }
    const int vws = (lane >> 3) * 128 + (lane & 7) * 16;
    const int kfr = krp(q) * 128, kx = q & 7;
    const int vfr = (4 * h + qq) * 128 + (16 * (g & 1) + 4 * pp) * 2;
#define ATT2_MASK(S, D, T0) do { if ((D).mod4) { _Pragma("unroll") for (int r = 0; r < 16; ++r) { const int dd = (T0) - ((r & 3) + 8 * (r >> 2)); S[r] = (dd >= 0 && (dd & 3) == 0) ? S[r] : -INFINITY; mx = fmaxf(mx, S[r]); } } \
        else { const unsigned W_ = (unsigned)(D).W; _Pragma("unroll") for (int r = 0; r < 16; ++r) { const int dd = (T0) - ((r & 3) + 8 * (r >> 2)); S[r] = ((unsigned)dd <= W_) ? S[r] : -INFINITY; mx = fmaxf(mx, S[r]); } } } while (0)
#pragma unroll 1
    for (int p = 0; p < npair; ++p) {
        const bool nul1 = (2 * p + 1 >= ntile);
        const TileD dA = tile_desc(2 * p, n1, n2, first1, first2, m0, r4), dB = tile_desc(nul1 ? 2 * p : 2 * p + 1, n1, n2, first1, first2, m0, r4);
#pragma unroll
        for (int j = 0; j < 4; ++j) { *(LAS u32x4*)(wl + kws[j]) = k0[j]; *(LAS u32x4*)(wl + 4096 + vws + 1024 * j) = v0[j]; *(LAS u32x4*)(wl + 8192 + kws[j]) = k1[j]; *(LAS u32x4*)(wl + 12288 + vws + 1024 * j) = v1[j]; }
        { const int ua = (2 * p + 2 < ntile) ? 2 * p + 2 : ntile - 1, ub = (2 * p + 3 < ntile) ? 2 * p + 3 : ntile - 1;
          const TileD na = tile_desc(ua, n1, n2, first1, first2, m0, r4), nb = tile_desc(ub, n1, n2, first1, first2, m0, r4); ATT_LOADT(k0, v0, na); ATT_LOADT(k1, v1, nb); }
        f32x16 sA = {}, sB = {};
#pragma unroll
        for (int d0 = 0; d0 < 4; ++d0) { const int co = ((2 * d0 + h) ^ kx) << 4;
            sA = __builtin_amdgcn_mfma_f32_32x32x16_bf16(*(const LAS s16x8*)(wl + kfr + co), qf[d0], sA, 0, 0, 0);
            sB = __builtin_amdgcn_mfma_f32_32x32x16_bf16(*(const LAS s16x8*)(wl + 8192 + kfr + co), qf[d0], sB, 0, 0, 0); }
        const int t0A = (dA.sel ? bq2 : qpos) - dA.abase - 4 * h; const int t0B = nul1 ? -(1 << 20) : ((dB.sel ? bq2 : qpos) - dB.abase - 4 * h);
        float mx = -INFINITY;
        ATT2_MASK(sA, dA, t0A); ATT2_MASK(sB, dB, t0B);
        mx = fmaxf(mx, __shfl_xor(mx, 32));
        const float mnew = fmaxf(mrun, mx), alpha = __builtin_amdgcn_exp2f(mrun - mnew); mrun = mnew;
        float ps = 0.f;
#pragma unroll
        for (int r = 0; r < 16; ++r) { sA[r] = __builtin_amdgcn_exp2f(sA[r] - mnew); sB[r] = __builtin_amdgcn_exp2f(sB[r] - mnew); ps += sA[r] + sB[r]; }
        lrun = lrun * alpha + ps;
#pragma unroll
        for (int r = 0; r < 16; ++r) { o0[r] *= alpha; o1[r] *= alpha; }
        u32x4 pa0, pa1, pb0, pb1;
        pa0.x = pk2(sA[0], sA[1]); pa0.y = pk2(sA[2], sA[3]); pa0.z = pk2(sA[4], sA[5]); pa0.w = pk2(sA[6], sA[7]);
        pa1.x = pk2(sA[8], sA[9]); pa1.y = pk2(sA[10], sA[11]); pa1.z = pk2(sA[12], sA[13]); pa1.w = pk2(sA[14], sA[15]);
        pb0.x = pk2(sB[0], sB[1]); pb0.y = pk2(sB[2], sB[3]); pb0.z = pk2(sB[4], sB[5]); pb0.w = pk2(sB[6], sB[7]);
        pb1.x = pk2(sB[8], sB[9]); pb1.y = pk2(sB[10], sB[11]); pb1.z = pk2(sB[12], sB[13]); pb1.w = pk2(sB[14], sB[15]);
#pragma unroll
        for (int tt = 0; tt < 2; ++tt) { LAS const char* vb = wl + 4096 + 8192 * tt + vfr;
#pragma unroll
            for (int sstep = 0; sstep < 2; ++sstep) { const s16x8 pf = __builtin_bit_cast(s16x8, tt ? (sstep ? pb1 : pb0) : (sstep ? pa1 : pa0));
#pragma unroll
                for (int dh = 0; dh < 2; ++dh) {
                    const s16x4 lo = vtr(vb + (16 * sstep) * 128 + dh * 64), hi = vtr(vb + (16 * sstep + 8) * 128 + dh * 64);
                    const s16x8 vf = (s16x8){lo[0], lo[1], lo[2], lo[3], hi[0], hi[1], hi[2], hi[3]};
                    if (dh == 0) o0 = __builtin_amdgcn_mfma_f32_32x32x16_bf16(vf, pf, o0, 0, 0, 0);
                    else         o1 = __builtin_amdgcn_mfma_f32_32x32x16_bf16(vf, pf, o1, 0, 0, 0); } } }
    }
#undef ATT2_MASK
    const float inv = 1.0f / (lrun + __shfl_xor(lrun, 32));
    bf16* orow = YATT + (size_t)(b * SEQ + qpos) * AW + head * HD + 4 * h;
#pragma unroll
    for (int gq = 0; gq < 4; ++gq) {
        u32x2v a, c; a.x = pk2(o0[4 * gq] * inv, o0[4 * gq + 1] * inv); a.y = pk2(o0[4 * gq + 2] * inv, o0[4 * gq + 3] * inv);
        c.x = pk2(o1[4 * gq] * inv, o1[4 * gq + 1] * inv); c.y = pk2(o1[4 * gq + 2] * inv, o1[4 * gq + 3] * inv);
        *(u32x2v*)(orow + 8 * gq) = a; *(u32x2v*)(orow + 32 + 8 * gq) = c; }
}
}

struct Args { const float* in[15]; float* out; unsigned char* ws; int ph_lo, ph_hi; };
static_assert(sizeof(Args) == 15 * 8 + 8 + 8 + 8, "Args has no padding");

__global__ void __launch_bounds__(NWAVES * 64, 2) fwd(Args args) {
    extern __shared__ __attribute__((aligned(16))) unsigned char lds[];
    LAS unsigned char* L = (LAS unsigned char*)lds;
    volatile LAS unsigned* MISC = (volatile LAS unsigned*)(L + MISC_OFF);
    const int tid = threadIdx.x, lane = tid & 63, wave = __builtin_amdgcn_readfirstlane(tid >> 6);
    const int G = gridDim.x; const int bx = blockIdx.x; const int vcu = (G % 8 == 0) ? (bx % 8) * (G / 8) + bx / 8 : bx;
    unsigned char* ws = args.ws;
    gu32* ctl = (gu32*)(ws + WS_CTL);
    const float* x = args.in[0]; const float* mix_g = args.in[1]; const float* w_in = args.in[2]; const float* conv_w = args.in[3]; const float* conv_g = args.in[4];
    const float* attn_g = args.in[5]; const float* w_out = args.in[6]; const float* ffn_g = args.in[7]; const float* w_router = args.in[8]; const float* b_router = args.in[9];
    const float* w_gu = args.in[10]; const float* b_gu = args.in[11]; const float* w_dn = args.in[12]; const float* b_dn = args.in[13]; const float* fin_g = args.in[14];
    float* out = args.out;
    float* ROPE = (float*)(ws + WS_ROPE); unsigned char* GWF = ws + WS_ROPE + 256 * 1024;
    int* TOKE = (int*)(ws + WS_TOKE); int* TOKR = (int*)(ws + WS_TOKR); float* TOKG = (float*)(ws + WS_TOKG); int* LIST = (int*)(ws + WS_LIST);
    bf16* WIN = (bf16*)(ws + WS_WIN); bf16* WO = (bf16*)(ws + WS_WO); bf16* XN = (bf16*)(ws + WS_XN); bf16* PROJ = (bf16*)(ws + WS_PROJ); bf16* YATT = (bf16*)(ws + WS_YATT);
    bf16* MIXED = (bf16*)(ws + WS_MIXED); float* X1 = (float*)(ws + WS_X1); unsigned char* XN2 = ws + WS_XN2; unsigned char* XS = ws + WS_XS; unsigned char* ACT = ws + WS_ACT;
    bf16* YB = (bf16*)(ws + WS_Y); unsigned char* WGU = ws + WS_WGU; unsigned char* WDN = ws + WS_WDN;

    for (int u = tid; u < (LDS_BYTES - LDSCTL_OFF) / 4; u += NWAVES * 64) ((LAS unsigned*)(L + LDSCTL_OFF))[u] = 0u;
    __syncthreads();
    XcdBarrier bar; bar.bar = (unsigned*)(ctl + CW_BAR); bar.x = 0; bar.st = nullptr;
    if (MK_N_LAUNCHES == 1) bar = xcd_barrier_post((unsigned*)(ctl + CW_BAR), MISC + 8);
    const int lo = args.ph_lo, hi = args.ph_hi;
#define IN(k) (lo <= (k) && (k) < hi)
#define BOTH(k) (IN(k) && IN((k) + 1))
#define GRID_BAR() do { if (MK_N_LAUNCHES == 1) xcd_barrier(bar); } while (0)
    const int gw = vcu * NWAVES + wave, NGW = G * NWAVES;
    const bool side_on = (MK_N_LAUNCHES == 1) && (G == 256) && (SIDE_CONV != 0);

    if (IN(0)) for (int rep = 0; rep < REPS(0); ++rep) {
        LAS float* scr = (LAS float*)(L + wave * 16384);
        constexpr int I_IN = 32 * (INC / 32), I_O = 32 * (DM / 32);
        constexpr int NIT = I_IN + I_O;
        for (int it = gw; it < NIT; it += NGW) {
            int r = it;
            if (r < I_IN) { const int nblk = INC / 32, kb = r / nblk, nb = r % nblk; p0_transpose_item(w_in, INC, DM, WIN, 64 * kb, 32 * nb, 32 * nb, scr, lane); continue; } r -= I_IN;
            { const int nblk = DM / 32, kb = r / nblk, nb = r % nblk; p0_transpose_item(w_out, DM, DM, WO, 64 * kb, 32 * nb, 32 * nb, scr, lane); }
        }
        for (int i = gw * 64 + lane; i < SEQ * 8; i += NGW * 64) { const int pos = i >> 3, f = i & 7;
            const float inv_freq = exp2f(-(float)f * 0.125f * 18.931568569324174f);
            const float ang = (float)pos * inv_freq;
            const double a = (double)ang; const double k = rint(a * 0.15915494309189535); const float red = (float)(a - k * 6.283185307179586);
            ROPE[pos * 16 + f] = cosf(red); ROPE[pos * 16 + 8 + f] = sinf(red); }
        for (int i = gw * 64 + lane; i < 64 * 2 * 64; i += NGW * 64) { const int ln = i & 63, eb = (i >> 6) & 1, ks = i >> 7; const int e = 16 * eb + (ln & 15), k0 = 32 * ks + 8 * (ln >> 4);
            unsigned hi[4], lo[4];
#pragma unroll
            for (int j = 0; j < 4; ++j) { const float v0 = w_router[(size_t)(k0 + 2 * j) * NE + e] * ffn_g[k0 + 2 * j], v1 = w_router[(size_t)(k0 + 2 * j + 1) * NE + e] * ffn_g[k0 + 2 * j + 1];
                const unsigned h0 = f2bf(v0), h1 = f2bf(v1); hi[j] = h0 | (h1 << 16); lo[j] = pk2(v0 - __uint_as_float(h0 << 16), v1 - __uint_as_float(h1 << 16)); }
            v4u* dst = (v4u*)GWF + ((size_t)(ks * 2 + eb) * 2) * 64 + ln; dst[0] = (v4u){hi[0], hi[1], hi[2], hi[3]}; dst[64] = (v4u){lo[0], lo[1], lo[2], lo[3]}; }
        for (int m = gw; m < NTOK; m += NGW) {
            const GAS f32x4* xr = (const GAS f32x4*)(x + (size_t)m * DM) + lane; const GAS f32x4* gr = (const GAS f32x4*)mix_g + lane;
            f32x4 v[8]; float s = 0.f;
#pragma unroll
            for (int j = 0; j < 8; ++j) { v[j] = xr[64 * j]; s += (v[j].x * v[j].x + v[j].y * v[j].y) + (v[j].z * v[j].z + v[j].w * v[j].w); }
            const float rstd = 1.0f / sqrtf(wave_sum(s) * (1.0f / DM) + EPS);
            GAS u32x2v* o8 = (GAS u32x2v*)(XN + (size_t)m * DM) + lane;
#pragma unroll
            for (int j = 0; j < 8; ++j) { const f32x4 gg = gr[64 * j]; u32x2v o; o.x = pk2(v[j].x * rstd * gg.x, v[j].y * rstd * gg.y); o.y = pk2(v[j].z * rstd * gg.z, v[j].w * rstd * gg.w); o8[64 * j] = o; }
        }
        if (BOTH(0)) GRID_BAR();
    }

    const int ga = (side_on && (SIDE_CONV & 1)) ? 16 : 0, gb = (side_on && (SIDE_CONV & 2)) ? 32 : 0;
    const int cv_lo = ga < gb ? ga : gb, cv_hi = ga < gb ? gb : ga, cv_pn = ga < gb ? 256 : 128, cv_po = ga < gb ? 0 : 256;
    const int nconv_eff = (cv_hi - cv_lo) * cv_pn + (NE - cv_hi) * PER_E;
#define CV_MAP(ci) ((ci) < (cv_hi - cv_lo) * cv_pn ? (cv_lo + (ci) / cv_pn) * PER_E + cv_po + (ci) % cv_pn : (cv_hi + ((ci) - (cv_hi - cv_lo) * cv_pn) / PER_E) * PER_E + ((ci) - (cv_hi - cv_lo) * cv_pn) % PER_E)
#define RUN_P2(ATTW, QA, QC, TRIED0, STOPW, STOPN) do { \
        LAS char* vl = (LAS char*)(L + wave * 16384); \
        LAS unsigned char* T = L + wave * 16384; \
        int mode = (wave < (ATTW)) ? 0 : 1, tried = (TRIED0), aq = 0; const int xcc = (int)xb_xcc_id() & 7; \
        while (tried < 2) { \
            if (mode == 0) { \
                  \
                bool got = false; \
                while (aq < 8) { const int qx = (xcc + aq) & 7; int idx = 0; if (lane == 0) idx = (int)__hip_atomic_fetch_add(ctl + (QA) + 16 * qx, 1u, __ATOMIC_RELAXED, __HIP_MEMORY_SCOPE_AGENT); \
                    idx = __builtin_amdgcn_readfirstlane(idx); \
                    if (idx < 768) { const int it = 64 * (qx + 8 * (idx >> 6)) + (idx & 63); __builtin_amdgcn_s_setprio(3); att::ATT_ITEM(it, PROJ, YATT, vl, lane); __builtin_amdgcn_s_setprio(0); got = true; break; } \
                    ++aq; } \
                if (got) continue; \
            } else { \
                 \
                int it = 0; if (lane == 0) it = (int)__hip_atomic_fetch_add(ctl + (QC), 1u, __ATOMIC_RELAXED, __HIP_MEMORY_SCOPE_AGENT); \
                it = __builtin_amdgcn_readfirstlane(it); \
                if (it < nconv_eff) { \
                    ConvDesc cur = conv_decode(CV_MAP(it), w_gu, w_dn, WGU, WDN, lane); \
                    f32x4 ra[8], rb[8]; \
                    CV_LOAD(ra, cur, 0); \
                    bool stop = false; \
                    for (;;) { \
                        int nx = nconv_eff; if (!stop && lane == 0) nx = (int)__hip_atomic_fetch_add(ctl + (QC), 1u, __ATOMIC_RELAXED, __HIP_MEMORY_SCOPE_AGENT); \
                        unsigned sv = 0u; if ((STOPW) >= 0) sv = __hip_atomic_load(ctl + ((STOPW) >= 0 ? (STOPW) : 0), __ATOMIC_RELAXED, __HIP_MEMORY_SCOPE_AGENT); \
_Pragma("unroll 1") \
                        for (int g = 0; g < CV_NG - 2; g += 2) { CV_LOAD(rb, cur, g + 1); CV_PROC(ra, cur, g); CV_LOAD(ra, cur, g + 2); CV_PROC(rb, cur, g + 1); } \
                        CV_LOAD(rb, cur, CV_NG - 1); CV_PROC(ra, cur, CV_NG - 2); \
                        nx = __builtin_amdgcn_readfirstlane(nx); const bool more = nx < nconv_eff; \
                        const ConvDesc nd = conv_decode(CV_MAP(more ? nx : it), w_gu, w_dn, WGU, WDN, lane); \
                        CV_LOAD(ra, nd, 0);                                   \
                        CV_PROC(rb, cur, CV_NG - 1); \
                        if ((STOPW) >= 0) stop = (unsigned)__builtin_amdgcn_readfirstlane((int)sv) >= (unsigned)(STOPN); \
                        if (!more) break; \
                        cur = nd; it = nx; \
                    } \
                } \
            } \
            if (mode == 0 && (ATTW) < 8 && (ATTW) > 0 && ATT_NOFALL && wave < (ATTW) - ATT_JOIN) break;     \
            mode ^= 1; ++tried; \
        } \
    } while (0)
    if (IN(1)) {
        const bool split = (MK_N_LAUNCHES == 1) && (G == 256) && (SPLIT_P1 != 0);
        const bool conv_wg = split && (((bx >> 3) & 1) == 1);
        if (!conv_wg) {
            pg8::Gemm g{XN, WIN, NTOK, INC, DM}; pg8::StaticOrder S; S.init(NTOK, INC, split ? 128 : G, split ? (((bx >> 4) << 3) | (bx & 7)) : bx);
            pg8::EpiProj E{PROJ, ROPE, att::C2};
            if (side_on && (SIDE_CONV & 1)) { pg8::SideConv SD{w_gu, WGU, 4096, 128 * bx, 96, (unsigned)PART_OFF}; pg8::gemm_phase<pg8::EpiProj, pg8::StaticOrder, true, true, false, false, pg8::SideConv>(L, g, S, E, SD); }
            else pg8::gemm_phase<pg8::EpiProj, pg8::StaticOrder, true, true>(L, g, S, E);
            __syncthreads();
            if (tid == 0) __hip_atomic_fetch_add(ctl + CW_P1DONE, 1u, __ATOMIC_RELAXED, __HIP_MEMORY_SCOPE_AGENT);
        } else {
            RUN_P2(0, CW_ATTQ, CW_CONVQ, 1, CW_P1DONE, 128);
        }
        if (BOTH(1)) GRID_BAR();
    }

    if (IN(2)) {
        RUN_P2(ATT_WAVES, CW_ATTQ, CW_CONVQ, 0, -1, 0);
        if (BOTH(2)) GRID_BAR();
        if ((PROBE_MASK >> 10) & 1) { RUN_P2(0, CW_ATTQ, CW_CONVQ + 64, 0, -1, 0); GRID_BAR(); }
        if ((PROBE_MASK >> 12) & 1) {
            unsigned char* SCR = ws + (size_t)2048 * MiB;
            for (int itp = gw; itp < 2 * NE * 1024; itp += NGW) {
                const int isdn = itp >= NE * 1024; const int r = isdn ? itp - NE * 1024 : itp; const int e = r >> 10, kp = r & 1023; const int N = isdn ? 2048 : 4096;
                const float* s0 = (isdn ? w_dn + (size_t)e * 2048 * 2048 : w_gu + (size_t)e * 2048 * 4096) + (size_t)(2 * kp) * N + 4 * lane; const float* s1 = s0 + N;
                unsigned char* d = SCR + (isdn ? (size_t)NE * 1024 * 8192 + ((size_t)e * 1024 + kp) * 4096 : ((size_t)e * 1024 + kp) * 8192) + 8 * lane;
                for (int i0 = 0; i0 < N / 256; i0 += 8) {
                    f32x4 a[8], c[8];
#pragma unroll
                    for (int i = 0; i < 8; ++i) { a[i] = *(const GAS f32x4*)(s0 + 256 * (i0 + i)); c[i] = *(const GAS f32x4*)(s1 + 256 * (i0 + i)); }
#pragma unroll
                    for (int i = 0; i < 8; ++i) { u32x2v o; o.x = pk4_fp8_nc(64.f * a[i][0], 64.f * c[i][0], 64.f * a[i][1], 64.f * c[i][1]); o.y = pk4_fp8_nc(64.f * a[i][2], 64.f * c[i][2], 64.f * a[i][3], 64.f * c[i][3]);
                        *(GAS u32x2v*)(d + 512 * (i0 + i)) = o; }
                }
            }
            GRID_BAR();
        }
        if ((PROBE_MASK >> 14) & 1) { RUN_P2(ATT_WAVES, CW_ATTQ + 2048, CW_CONVQ + 192, 0, -1, 0); GRID_BAR(); }
        if ((PROBE_MASK >> 13) & 1) { RUN_P2(4, CW_ATTQ, CW_CONVQ + 128, 1, -1, 0); GRID_BAR(); }
        if ((PROBE_MASK >> 15) & 1) { for (;;) { int it = 0; if (lane == 0) it = (int)__hip_atomic_fetch_add(ctl + CW_ATTQ + 256 + 64, 1u, __ATOMIC_RELAXED, __HIP_MEMORY_SCOPE_AGENT); it = __builtin_amdgcn_readfirstlane(it); if (it >= att::NITEMS) break;
            att::item<1>(it, PROJ, (bf16*)(ws + (size_t)3000 * MiB), (LAS char*)(L + wave * 16384), lane); } GRID_BAR(); }
        if ((PROBE_MASK >> 16) & 1) { for (;;) { int it = 0; if (lane == 0) it = (int)__hip_atomic_fetch_add(ctl + CW_ATTQ + 256 + 128, 1u, __ATOMIC_RELAXED, __HIP_MEMORY_SCOPE_AGENT); it = __builtin_amdgcn_readfirstlane(it); if (it >= att::NITEMS) break;
            att::item<2>(it, PROJ, (bf16*)(ws + (size_t)3000 * MiB), (LAS char*)(L + wave * 16384), lane); } GRID_BAR(); }
        if ((PROBE_MASK >> 11) & 1) { RUN_P2(8, CW_ATTQ + 1024, CW_CONVQ, 0, -1, 0); GRID_BAR(); }
    }

    if (IN(3)) for (int rep = 0; rep < REPS(3); ++rep) {
        float cw0[8], cw1[8], cw2[8], cgq[8], agq[3][8];
#pragma unroll
        for (int j = 0; j < 8; ++j) { const int c = 8 * lane + j; cw0[j] = conv_w[c]; cw1[j] = conv_w[CW + c]; cw2[j] = conv_w[2 * CW + c]; cgq[j] = conv_g[c]; agq[0][j] = attn_g[c]; agq[1][j] = attn_g[512 + c]; agq[2][j] = attn_g[1024 + c]; }
#define P3_LOAD(A, CX, CC, CB, mm) do { const int sp_ = (mm) & (SEQ - 1); const bf16* ya_ = YATT + (size_t)(mm) * AW + 8 * lane; const bf16* pr_ = PROJ + (size_t)(mm) * INC + 8 * lane; \
            _Pragma("unroll") for (int j = 0; j < 3; ++j) A[j] = *(const v4u*)(ya_ + 512 * j); \
            _Pragma("unroll") for (int d = 0; d < 3; ++d) { const int back = 2 - d; const bool ok_ = sp_ >= back; const bf16* q_ = ok_ ? pr_ - (size_t)back * INC : pr_; CX[d] = *(const v4u*)q_; CC[d] = *(const v4u*)(q_ + 2 * CW); \
                if (!ok_) { CX[d] = (v4u){0u, 0u, 0u, 0u}; } } \
            CB = *(const v4u*)(pr_ + CW); } while (0)
        v4u a[3], cx[3], cc[3], cb;
        if (gw < NTOK) P3_LOAD(a, cx, cc, cb, gw);
        for (int m = gw; m < NTOK; m += NGW) {
            v4u na[3], ncx[3], ncc[3], ncb; const int mn = (m + NGW < NTOK) ? m + NGW : m;
            P3_LOAD(na, ncx, ncc, ncb, mn);
            float u[3][8];
#pragma unroll
            for (int d = 0; d < 3; ++d) {
                u[d][0] = bf_lo(cx[d].x) * bf_lo(cc[d].x); u[d][1] = bf_hi(cx[d].x) * bf_hi(cc[d].x); u[d][2] = bf_lo(cx[d].y) * bf_lo(cc[d].y); u[d][3] = bf_hi(cx[d].y) * bf_hi(cc[d].y);
                u[d][4] = bf_lo(cx[d].z) * bf_lo(cc[d].z); u[d][5] = bf_hi(cx[d].z) * bf_hi(cc[d].z); u[d][6] = bf_lo(cx[d].w) * bf_lo(cc[d].w); u[d][7] = bf_hi(cx[d].w) * bf_hi(cc[d].w); }
            float bb[8] = {bf_lo(cb.x), bf_hi(cb.x), bf_lo(cb.y), bf_hi(cb.y), bf_lo(cb.z), bf_hi(cb.z), bf_lo(cb.w), bf_hi(cb.w)};
            float y[8]; float s = 0.f;
#pragma unroll
            for (int j = 0; j < 8; ++j) { const float acc = cw0[j] * u[0][j] + cw1[j] * u[1][j] + cw2[j] * u[2][j]; y[j] = bb[j] * acc; s += y[j] * y[j]; }
            float s2 = 0.f;
#pragma unroll
            for (int j = 0; j < 3; ++j) {
                const float f0 = bf_lo(a[j].x), f1 = bf_hi(a[j].x), f2 = bf_lo(a[j].y), f3 = bf_hi(a[j].y), f4 = bf_lo(a[j].z), f5 = bf_hi(a[j].z), f6 = bf_lo(a[j].w), f7 = bf_hi(a[j].w);
                s2 += (f0 * f0 + f1 * f1) + (f2 * f2 + f3 * f3) + (f4 * f4 + f5 * f5) + (f6 * f6 + f7 * f7); }
#pragma unroll
            for (int o = 1; o < 64; o <<= 1) { s += __shfl_xor(s, o); s2 += __shfl_xor(s2, o); }
            const float rc = 1.0f / sqrtf(s * (1.0f / CW) + EPS), ra = 1.0f / sqrtf(s2 * (1.0f / AW) + EPS);
            { v4u o;
              o.x = pk2(y[0] * rc * cgq[0], y[1] * rc * cgq[1]); o.y = pk2(y[2] * rc * cgq[2], y[3] * rc * cgq[3]); o.z = pk2(y[4] * rc * cgq[4], y[5] * rc * cgq[5]); o.w = pk2(y[6] * rc * cgq[6], y[7] * rc * cgq[7]);
              *(v4u*)(MIXED + (size_t)m * DM + 8 * lane) = o; }
#pragma unroll
            for (int j = 0; j < 3; ++j) { const float* gq = agq[j]; v4u o;
                o.x = pk2(bf_lo(a[j].x) * ra * gq[0], bf_hi(a[j].x) * ra * gq[1]); o.y = pk2(bf_lo(a[j].y) * ra * gq[2], bf_hi(a[j].y) * ra * gq[3]);
                o.z = pk2(bf_lo(a[j].z) * ra * gq[4], bf_hi(a[j].z) * ra * gq[5]); o.w = pk2(bf_lo(a[j].w) * ra * gq[6], bf_hi(a[j].w) * ra * gq[7]);
                *(v4u*)(MIXED + (size_t)m * DM + CW + 512 * j + 8 * lane) = o; }
#pragma unroll
            for (int j = 0; j < 3; ++j) { a[j] = na[j]; cx[j] = ncx[j]; cc[j] = ncc[j]; }
            cb = ncb;
        }
#undef P3_LOAD
        if (BOTH(3)) GRID_BAR();
    }

    if (IN(4)) for (int rep = 0; rep < REPS(4); ++rep) {
        pg8::Gemm g{MIXED, WO, NTOK, DM, DM}; pg8::StaticOrder S; S.init(NTOK, DM, G, (int)blockIdx.x);
        pg8::EpiResF32 E{x, X1, DM};
        if (side_on && (SIDE_CONV & 1)) { pg8::SideConv SD{w_gu, WGU, 4096, 128 * bx + 96, 32, (unsigned)PART_OFF}; pg8::gemm_phase<pg8::EpiResF32, pg8::StaticOrder, false, true, false, false, pg8::SideConv>(L, g, S, E, SD); }
        else pg8::gemm_phase<pg8::EpiResF32, pg8::StaticOrder, false, true>(L, g, S, E);
        if (BOTH(4)) GRID_BAR();
    }

    if (IN(5)) for (int rep = 0; rep < REPS(5); ++rep) {
        const int cwc = CW_CNT + 2048 * rep; int* TOKE_ = TOKE + rep * (1 << 20); int* TOKR_ = TOKR + rep * (1 << 20); float* TOKG_ = TOKG + rep * (1 << 20); unsigned char* XS_ = XS + (size_t)rep * ((size_t)2752 * MiB - WS_XS);
        LAS float* X1L = (LAS float*)L; constexpr int XP = 2052;
        LAS float* PART = (LAS float*)(L + PART_OFF);
        const int e_ = lane & 31, kbase = 256 * wave + 128 * (lane >> 5);
        LAS int* LC = (LAS int*)(L + LDSCTL_OFF + 2048); LAS int* LB = (LAS int*)(L + LDSCTL_OFF + 2304);
        LAS int* AE = (LAS int*)(L + LDSCTL_OFF + 4096); LAS int* ALR = AE + 128; LAS float* AG = (LAS float*)(AE + 256); LAS float* RS = (LAS float*)(AE + 384);
        for (int blk = vcu; blk < NTOK / 32; blk += G) {
        if (tid < 32) LC[tid] = 0;
        __syncthreads();
        const int grp0 = 2 * blk;
#define P5_DMA(step) do { _Pragma("unroll") for (int r = 0; r < 2; ++r) _Pragma("unroll") for (int c = 0; c < 8; ++c) \
            __builtin_amdgcn_global_load_lds((const unsigned*)(X1 + (size_t)((grp0 + (step)) * 16 + 2 * wave + r) * DM + c * 256 + lane * 4), (LAS unsigned*)(L + (2 * wave + r) * (XP * 4) + c * 1024), 16, 0, 0); \
            asm volatile("s_waitcnt vmcnt(0)" ::: "memory"); __syncthreads(); } while (0)
        for (int step = 0; step < 2; ++step) {
            if (step) __syncthreads();
            if (tid < 32) LC[tid] = 0;
            P5_DMA(step);
            {
                typedef short s16x8b __attribute__((ext_vector_type(8)));
                f32x4 acc0 = {0.f, 0.f, 0.f, 0.f}, acc1 = acc0;
                const int tcol = lane & 15, kq = lane >> 4;
#pragma unroll
                for (int s8 = 0; s8 < 8; ++s8) { const int ks = 8 * wave + s8;
                    const LAS f32x4* xp = (const LAS f32x4*)(X1L + tcol * XP + 32 * ks + 8 * kq); const f32x4 xa = xp[0], xb = xp[1];
                    unsigned xh[4], xl[4];
                    { const unsigned h0 = f2bf(xa.x), h1 = f2bf(xa.y), h2 = f2bf(xa.z), h3 = f2bf(xa.w), h4 = f2bf(xb.x), h5 = f2bf(xb.y), h6 = f2bf(xb.z), h7 = f2bf(xb.w);
                      xh[0] = h0 | (h1 << 16); xh[1] = h2 | (h3 << 16); xh[2] = h4 | (h5 << 16); xh[3] = h6 | (h7 << 16);
                      xl[0] = pk2(xa.x - __uint_as_float(h0 << 16), xa.y - __uint_as_float(h1 << 16)); xl[1] = pk2(xa.z - __uint_as_float(h2 << 16), xa.w - __uint_as_float(h3 << 16));
                      xl[2] = pk2(xb.x - __uint_as_float(h4 << 16), xb.y - __uint_as_float(h5 << 16)); xl[3] = pk2(xb.z - __uint_as_float(h6 << 16), xb.w - __uint_as_float(h7 << 16)); }
                    const s16x8b bxh = __builtin_bit_cast(s16x8b, (v4u){xh[0], xh[1], xh[2], xh[3]}), bxl = __builtin_bit_cast(s16x8b, (v4u){xl[0], xl[1], xl[2], xl[3]});
                    const v4u* wf = (const v4u*)GWF + (size_t)(ks * 4) * 64 + lane;
                    const s16x8b w0h = __builtin_bit_cast(s16x8b, wf[0]), w0l = __builtin_bit_cast(s16x8b, wf[64]), w1h = __builtin_bit_cast(s16x8b, wf[128]), w1l = __builtin_bit_cast(s16x8b, wf[192]);
                    acc0 = __builtin_amdgcn_mfma_f32_16x16x32_bf16(w0h, bxh, acc0, 0, 0, 0); acc0 = __builtin_amdgcn_mfma_f32_16x16x32_bf16(w0l, bxh, acc0, 0, 0, 0); acc0 = __builtin_amdgcn_mfma_f32_16x16x32_bf16(w0h, bxl, acc0, 0, 0, 0);
                    acc1 = __builtin_amdgcn_mfma_f32_16x16x32_bf16(w1h, bxh, acc1, 0, 0, 0); acc1 = __builtin_amdgcn_mfma_f32_16x16x32_bf16(w1l, bxh, acc1, 0, 0, 0); acc1 = __builtin_amdgcn_mfma_f32_16x16x32_bf16(w1h, bxl, acc1, 0, 0, 0); }
                *(LAS f32x4*)(PART + (wave * 16 + tcol) * 32 + 4 * kq) = acc0; *(LAS f32x4*)(PART + (wave * 16 + tcol) * 32 + 16 + 4 * kq) = acc1;
            }
            __syncthreads();
            {
                float tvv[2][4]; int tii[2][4];
#pragma unroll
                for (int r = 0; r < 2; ++r) { const int tl = 2 * wave + r;
                    const LAS f32x4* hp = (const LAS f32x4*)(X1L + tl * XP + 32 * lane); float ss = 0.f;
#pragma unroll
                    for (int j = 0; j < 8; ++j) { const f32x4 a = hp[j]; ss += (a.x * a.x + a.y * a.y) + (a.z * a.z + a.w * a.w); }
                    const float rstd = 1.0f / sqrtf(wave_sum(ss) * (1.0f / DM) + EPS); if (lane == 0) RS[step * 16 + tl] = rstd;
                    float lg = -INFINITY;
                    if (lane < 32) { float s = 0.f;
#pragma unroll
                        for (int w = 0; w < 8; ++w) s += PART[(w * 16 + tl) * 32 + lane]; lg = s * rstd + b_router[lane]; }
                    int rank = 0; const int lgb = __float_as_int(lg);
#pragma unroll
                    for (int j = 0; j < 32; ++j) { const float vj = __int_as_float(__builtin_amdgcn_readlane(lgb, j)); rank += (vj > lg || (vj == lg && j < lane)) ? 1 : 0; }
#pragma unroll
                    for (int k = 0; k < 4; ++k) { const unsigned long long mk = __builtin_amdgcn_ballot_w64(lane < 32 && rank == k); const int idx = (int)__builtin_ctzll(mk);
                        tii[r][k] = idx; tvv[r][k] = __int_as_float(__builtin_amdgcn_readlane(lgb, idx)); } }
                if (lane < 8) { const int r = lane >> 2, k = lane & 3;
                    const float t0 = r ? tvv[1][0] : tvv[0][0], t1 = r ? tvv[1][1] : tvv[0][1], t2 = r ? tvv[1][2] : tvv[0][2], t3 = r ? tvv[1][3] : tvv[0][3];
                    const float e1 = __expf(t1 - t0), e2 = __expf(t2 - t0), e3 = __expf(t3 - t0); const float den = 1.0f / (1.0f + e1 + e2 + e3);
                    const int i0 = r ? tii[1][0] : tii[0][0], i1 = r ? tii[1][1] : tii[0][1], i2 = r ? tii[1][2] : tii[0][2], i3 = r ? tii[1][3] : tii[0][3];
                    const int ee = k == 0 ? i0 : k == 1 ? i1 : k == 2 ? i2 : i3; const float gg = (k == 0 ? 1.0f : k == 1 ? e1 : k == 2 ? e2 : e3) * den;
                    const int ai = (step * 16 + 2 * wave + r) * 4 + k;
                    AE[ai] = ee; ALR[ai] = __hip_atomic_fetch_add(LC + ee, 1, __ATOMIC_RELAXED, __HIP_MEMORY_SCOPE_WORKGROUP); AG[ai] = gg; }
            }
            __syncthreads();
            if (tid < 32) { const int c = LC[tid]; LB[tid] = c ? (int)__hip_atomic_fetch_add(ctl + cwc + 64 * tid, (unsigned)c, __ATOMIC_RELAXED, __HIP_MEMORY_SCOPE_AGENT) : 0; }
            __syncthreads();
#pragma unroll
            for (int r = 0; r < 2; ++r) { const int tl = 2 * wave + r; const int tok = (grp0 + step) * 16 + tl; v4u w0, w1;
                { const float sc = 16.f * RS[step * 16 + tl]; const LAS f32x4* hp = (const LAS f32x4*)(X1L + tl * XP + 32 * lane); const f32x4* gp = (const f32x4*)(ffn_g + 32 * lane);
                    { const f32x4 a = hp[0] * gp[0] * sc, c = hp[1] * gp[1] * sc, d = hp[2] * gp[2] * sc, f = hp[3] * gp[3] * sc;
                      w0.x = pg8::pk4_fp8(a.x, a.y, a.z, a.w); w0.y = pg8::pk4_fp8(c.x, c.y, c.z, c.w); w0.z = pg8::pk4_fp8(d.x, d.y, d.z, d.w); w0.w = pg8::pk4_fp8(f.x, f.y, f.z, f.w); }
                    { const f32x4 a = hp[4] * gp[4] * sc, c = hp[5] * gp[5] * sc, d = hp[6] * gp[6] * sc, f = hp[7] * gp[7] * sc;
                      w1.x = pg8::pk4_fp8(a.x, a.y, a.z, a.w); w1.y = pg8::pk4_fp8(c.x, c.y, c.z, c.w); w1.z = pg8::pk4_fp8(d.x, d.y, d.z, d.w); w1.w = pg8::pk4_fp8(f.x, f.y, f.z, f.w); } }
#pragma unroll
                for (int k = 0; k < 4; ++k) { const int ai = (step * 16 + tl) * 4 + k; const int ee = AE[ai], rank = LB[ee] + ALR[ai];
                    GAS v4u* dst = (GAS v4u*)(XS_ + ((size_t)ee * NTOK + rank) * DM + 32 * lane); dst[0] = w0; dst[1] = w1;
                    if (lane == 0) { TOKE_[tok * 4 + k] = ee; TOKR_[tok * 4 + k] = rank; TOKG_[tok * 4 + k] = AG[ai]; } } }
        }
        __syncthreads();
        }
#undef P5_DMA
        if (BOTH(5)) GRID_BAR();
    }

    LAS int* TS = (LAS int*)(L + TAB_TS); LAS int* CN = (LAS int*)(L + TAB_CN);
    if (hi > 6) {
        if (tid == 0) { int acc = 0, acch = 0; for (int e = 0; e < NE; ++e) { const int c = (int)__hip_atomic_load(ctl + CW_CNT + 64 * e, __ATOMIC_RELAXED, __HIP_MEMORY_SCOPE_AGENT); CN[e] = c; TS[e] = acc; TS[33 + e] = acch;
            const int ntl = (c + 255) >> 8, hf = (c > 0 && c - ((ntl - 1) << 8) <= 128) ? 1 : 0; acc += ntl - hf; acch += hf; } TS[NE] = acc; TS[33 + NE] = acch; }
        __syncthreads();
    }


    if (IN(7)) for (int rep = 0; rep < REPS(7); ++rep) {
        {
        pg8::GroupedOrder S{(const PG8_LAS int*)TS, (const PG8_LAS int*)CN, 16, G, vcu, (long)1024 * 4096 * 2, 128 * 2};
        pg8::EpiSwiGLU E{ACT, b_gu};
        pg8::Gemm g{(const pg8::bf16_t*)XS, (const pg8::bf16_t*)WGU, MAXSLOT, NE * 4096, DM / 2, 4096, 2048 * 2};
        if (side_on && (SIDE_CONV & 2)) { pg8::SideConv SD{w_dn, WDN, 2048, 128 * bx, 128, (unsigned)PART_OFF}; pg8::gemm_phase<pg8::EpiSwiGLU, pg8::GroupedOrder, true, true, true, true, pg8::SideConv>(L, g, S, E, SD); }
        else pg8::gemm_phase<pg8::EpiSwiGLU, pg8::GroupedOrder, true, true, true, true>(L, g, S, E); }
        if (BOTH(7)) GRID_BAR();
    }

    if (IN(8)) for (int rep = 0; rep < REPS(8); ++rep) {
        {
        pg8::GroupedOrder S{(const PG8_LAS int*)TS, (const PG8_LAS int*)CN, 8, G, vcu, (long)1024 * 2048 * 2, 256 * 2};
        pg8::EpiFp8Y E{(unsigned char*)YB, 1.0f / (pg8::FP8_W_SCALE * pg8::FP8_ACT_SCALE), b_dn};
        pg8::Gemm g{(const pg8::bf16_t*)ACT, (const pg8::bf16_t*)WDN, MAXSLOT, NE * 2048, DE / 2, 2048, 128 * 2};
        pg8::gemm_phase<pg8::EpiFp8Y, pg8::GroupedOrder, true, true, true, true>(L, g, S, E); }
        if (BOTH(8)) GRID_BAR();
    }

    if (IN(9)) for (int rep = 0; rep < REPS(9); ++rep) {
        unsigned poison = __hip_atomic_load(ctl + CW_BAR + XB_TMO, RLX_AGENT) != 0u;
        const f32x4 g8[8] = {((const GAS f32x4*)fin_g + lane)[0], ((const GAS f32x4*)fin_g + lane)[64], ((const GAS f32x4*)fin_g + lane)[128], ((const GAS f32x4*)fin_g + lane)[192], ((const GAS f32x4*)fin_g + lane)[256], ((const GAS f32x4*)fin_g + lane)[320], ((const GAS f32x4*)fin_g + lane)[384], ((const GAS f32x4*)fin_g + lane)[448]};
#define P9_IDX(TE, TR, TG, mm) do { TE = *(const int4*)(TOKE + (mm) * 4); TR = *(const int4*)(TOKR + (mm) * 4); TG = *(const f32x4*)(TOKG + (mm) * 4); } while (0)
#define P9_ROWS(V, YY, TE, TR, mm) do { const GAS f32x4* xr_ = (const GAS f32x4*)(X1 + (size_t)(mm) * DM) + lane; _Pragma("unroll") for (int j = 0; j < 8; ++j) V[j] = __builtin_nontemporal_load(xr_ + 64 * j); \
            const int ee_[4] = {TE.x, TE.y, TE.z, TE.w}, rr_[4] = {TR.x, TR.y, TR.z, TR.w}; \
            _Pragma("unroll") for (int k = 0; k < TOPK; ++k) { const GAS unsigned* yr_ = (const GAS unsigned*)((const unsigned char*)YB + ((size_t)ee_[k] * NTOK + rr_[k]) * DM) + lane; \
                _Pragma("unroll") for (int j = 0; j < 8; ++j) YY[k][j] = __builtin_nontemporal_load(yr_ + 64 * j); } } while (0)
        int4 te0, tr0, te1, tr1; f32x4 tg0, tg1; f32x4 v[8]; unsigned yy[4][8];
        if (gw < NTOK) { P9_IDX(te0, tr0, tg0, gw); const int m1 = (gw + NGW < NTOK) ? gw + NGW : gw; P9_IDX(te1, tr1, tg1, m1); P9_ROWS(v, yy, te0, tr0, gw); }
        for (int m = gw; m < NTOK; m += NGW) {
            const int mn = (m + NGW < NTOK) ? m + NGW : m, mnn = (m + 2 * NGW < NTOK) ? m + 2 * NGW : mn;
            int4 te2, tr2; f32x4 tg2; P9_IDX(te2, tr2, tg2, mnn);
            f32x4 nv[8]; unsigned nyy[4][8]; P9_ROWS(nv, nyy, te1, tr1, mn);
            const f32x4 tg = tg0;
#pragma unroll
            for (int k = 0; k < TOPK; ++k) { const float gt = tg[k] * (1.0f / 16.0f);
#pragma unroll
                for (int j = 0; j < 8; ++j) { typedef float f32x2y __attribute__((ext_vector_type(2))); const f32x2y lo = __builtin_amdgcn_cvt_pk_f32_fp8((int)yy[k][j], false), hi = __builtin_amdgcn_cvt_pk_f32_fp8((int)yy[k][j], true);
                    v[j].x += gt * lo.x; v[j].y += gt * lo.y; v[j].z += gt * hi.x; v[j].w += gt * hi.y; } }
            float s = 0.f;
#pragma unroll
            for (int j = 0; j < 8; ++j) s += (v[j].x * v[j].x + v[j].y * v[j].y) + (v[j].z * v[j].z + v[j].w * v[j].w);
            float rstd = 1.0f / sqrtf(wave_sum(s) * (1.0f / DM) + EPS);
            if (poison) rstd = __builtin_nanf("");
            GAS f32x4* orow = (GAS f32x4*)(out + (size_t)m * DM) + lane;
#pragma unroll
            for (int j = 0; j < 8; ++j) { const f32x4 gg = g8[j]; f32x4 o; o.x = v[j].x * rstd * gg.x; o.y = v[j].y * rstd * gg.y; o.z = v[j].z * rstd * gg.z; o.w = v[j].w * rstd * gg.w; __builtin_nontemporal_store(o, orow + 64 * j); }
#pragma unroll
            for (int j = 0; j < 8; ++j) { v[j] = nv[j];
#pragma unroll
                for (int k = 0; k < TOPK; ++k) yy[k][j] = nyy[k][j]; }
            te0 = te1; tr0 = tr1; tg0 = tg1; te1 = te2; tr1 = tr2; tg1 = tg2;
        }
#undef P9_IDX
#undef P9_ROWS
    }
#undef IN
#undef BOTH
#undef GRID_BAR
}

extern "C" void kernel_launch(void* const* d_in, const int* in_sizes, int n_in, void* d_out, int out_size, void* d_ws, size_t ws_size, hipStream_t stream) {
    static int grid = 0;
    if (grid == 0) {
        if (n_in != 15 || in_sizes[0] != NTOK * DM || out_size != NTOK * DM || ws_size < WS_END) { fprintf(stderr, "kernel_launch: unexpected shapes / workspace (n_in %d, ws %zu)\n", n_in, ws_size); grid = -1; return; }
        int dev = 0, cus = 0, per_cu = 0;
        if (hipGetDevice(&dev) != hipSuccess || hipDeviceGetAttribute(&cus, hipDeviceAttributeMultiprocessorCount, dev) != hipSuccess) { grid = -1; return; }
        if (hipFuncSetAttribute((const void*)fwd, hipFuncAttributeMaxDynamicSharedMemorySize, LDS_BYTES) != hipSuccess) { fprintf(stderr, "kernel_launch: hipFuncSetAttribute failed\n"); grid = -1; return; }
        if (hipOccupancyMaxActiveBlocksPerMultiprocessor(&per_cu, (const void*)fwd, NWAVES * 64, LDS_BYTES) != hipSuccess || per_cu < 1) fprintf(stderr, "kernel_launch: occupancy query says %d\n", per_cu);
        (void)hipGetLastError();
        grid = cus;
    }
    if (grid < 0) return;
    if (hipMemsetAsync((char*)d_ws + WS_CTL, 0, CTL_ZERO_BYTES, stream) != hipSuccess) return;
    Args a{};
    for (int i = 0; i < 15; ++i) a.in[i] = (const float*)d_in[i];
    a.out = (float*)d_out; a.ws = (unsigned char*)d_ws;
    if (MK_N_LAUNCHES == 1) { a.ph_lo = 0; a.ph_hi = NPH; hipLaunchKernelGGL(fwd, dim3(grid), dim3(NWAVES * 64), LDS_BYTES, stream, a); }
    else { for (int p = 0; p < NPH; ++p) { a.ph_lo = p; a.ph_hi = p + 1; hipLaunchKernelGGL(fwd, dim3(grid), dim3(NWAVES * 64), LDS_BYTES, stream, a); } }
    const hipError_t le = hipPeekAtLastError();
    if (le != hipSuccess) fprintf(stderr, "kernel_launch: launch failed: %s\n", hipGetErrorName(le));
}
```

```cpp
#include <hip/hip_runtime.h>
#include <cstdio>
#include <cstdint>
namespace pg8 {
#define PG8_LAS __attribute__((address_space(3)))
typedef unsigned short bf16_t;
typedef short bf16x8 __attribute__((ext_vector_type(8)));
typedef float f32x4 __attribute__((ext_vector_type(4)));
typedef unsigned u32x4 __attribute__((ext_vector_type(4)));
constexpr int BM = 256, BK = 64, HALF = 128, HTB = HALF * BK * 2  , STAGE_BYTES = 8 * HTB, NXCD = 8, WGM = 8;

__host__ __device__ __forceinline__ int lds_byte(int r, int c) { const int st = (r >> 4) * 2 + (c >> 5), rr = r & 15, cc = c & 31, ob = rr * 64 + cc * 2; return st * 1024 + (ob ^ (((ob >> 9) & 1) << 5)); }
__host__ __device__ __forceinline__ void stage_rc(int b, int& R, int& C) { const int st = b / 1024, sb = b % 1024, swz = sb ^ (((sb >> 9) & 1) << 5); R = (st >> 1) * 16 + swz / 64; C = (st & 1) * 32 + (swz % 64) / 2; }
__host__ __device__ __forceinline__ int perm32(int rho) { const int n = rho >> 4, i = rho & 15; return 8 * (i >> 2) + 4 * n + (i & 3); }

struct Unit { int pm, pn, e, cn, rows; long boff; };
struct Gemm { const bf16_t* A; const bf16_t* Bt; int M, N, K; int b_ntot, b_hstep; };

struct StaticOrder {
    int nM, nN, nwg, G, c;
    __host__ __device__ void init(int M, int N, int G_, int c_) { nM = M / BM; nN = N / BM; nwg = nM * nN; G = G_; c = c_; }
    __host__ __device__ bool next(int i, Unit& u) const {
        const long L = (long)i * G + c; if (L >= nwg) return false;
        int wgid = (int)L; { const int q = nwg / NXCD, r = nwg % NXCD, xcd = wgid % NXCD, off = wgid / NXCD; wgid = (xcd < r ? xcd * (q + 1) : r * (q + 1) + (xcd - r) * q) + off; }
        const int nig = WGM * nN, gid = wgid / nig, fm = gid * WGM, gsz = (nM - fm) < WGM ? (nM - fm) : WGM;
        u.pm = fm + ((wgid % nig) % gsz); u.pn = (wgid % nig) / gsz; u.e = 0; u.cn = u.pn; u.rows = BM; u.boff = 0; return true;
    }
    __device__ __forceinline__ void a_ready(const Unit&) const {}
    __device__ __forceinline__ void done(const Unit&) const {}
};
struct GroupedOrder {
    const PG8_LAS int* TS; const PG8_LAS int* CN; int nN, G, v; long b_estride; int b_cnstep;
    __device__ __forceinline__ bool next(int i, Unit& u) const {
        const PG8_LAS int* TH = TS + 33;
        const int U = i * G + v; const int FT = __builtin_amdgcn_readfirstlane(TS[32] * nN), total = FT + __builtin_amdgcn_readfirstlane(TH[32] * nN); if (U >= total) return false;
        int e = 0, pn, rt;
        if (U < FT) {
#pragma unroll 1
            for (int j = 1; j < 32; ++j) e += (TS[j] * nN <= U) ? 1 : 0;
            const int t0 = TS[e], nt = TS[e + 1] - t0, loc = U - t0 * nN; pn = loc / nt; rt = loc - pn * nt;
        } else { const int U2 = U - FT;
#pragma unroll 1
            for (int j = 1; j < 32; ++j) e += (TH[j] * nN <= U2) ? 1 : 0;
            pn = U2 - TH[e] * nN; rt = TS[e + 1] - TS[e]; }
        const int left = CN[e] - rt * BM;
        u.pm = __builtin_amdgcn_readfirstlane(e * 32 + rt); u.pn = __builtin_amdgcn_readfirstlane(e * nN + pn); u.e = __builtin_amdgcn_readfirstlane(e); u.cn = __builtin_amdgcn_readfirstlane(pn);
        u.rows = __builtin_amdgcn_readfirstlane(left < BM ? left : BM); u.boff = (long)u.e * b_estride + (long)u.cn * b_cnstep; return true;
    }
    __device__ __forceinline__ void a_ready(const Unit&) const {}
    __device__ __forceinline__ void done(const Unit&) const {}
};

__device__ __forceinline__ unsigned cvt_pk_bf16(float lo, float hi) { unsigned r; asm volatile("v_cvt_pk_bf16_f32 %0, %1, %2" : "=v"(r) : "v"(lo), "v"(hi)); return r; }

struct EpiBf16Plain {
    static constexpr bool PERM = true, AFTER_DRAIN = false;
    bf16_t* O; int ldc; float sc; const float* bias;
    __device__ __forceinline__ void operator()(const f32x4 (&acc)[2][2][4][2], const Unit& u, int wr, int wc, int fr, int fq) const {
        const int row0 = u.pm * BM + wr * 64 + fr, col0 = u.cn * BM + wc * 32 + 8 * fq;
        f32x4 bv[2][2];
#pragma unroll
        for (int bj = 0; bj < 2; ++bj)
#pragma unroll
            for (int n = 0; n < 2; ++n) bv[bj][n] = bias ? *(const f32x4*)(bias + (size_t)u.e * ldc + col0 + bj * HALF + 4 * n) : (f32x4){0.f, 0.f, 0.f, 0.f};
#pragma unroll
        for (int ai = 0; ai < 2; ++ai) { if (ai == 1 && u.rows <= HALF) break;
#pragma unroll
            for (int m = 0; m < 4; ++m) { bf16_t* rowp = O + (size_t)(row0 + ai * HALF + m * 16) * ldc + col0;
#pragma unroll
                for (int bj = 0; bj < 2; ++bj) { const f32x4 v0 = acc[ai][bj][m][0] * sc + bv[bj][0], v1 = acc[ai][bj][m][1] * sc + bv[bj][1];
                    u32x4 w; w.x = cvt_pk_bf16(v0[0], v0[1]); w.y = cvt_pk_bf16(v0[2], v0[3]); w.z = cvt_pk_bf16(v1[0], v1[1]); w.w = cvt_pk_bf16(v1[2], v1[3]);
                    *(u32x4*)(rowp + bj * HALF) = w; } } }
    }
};
struct EpiProj {
    static constexpr bool PERM = true, AFTER_DRAIN = false;
    bf16_t* O; const float* rope; float qscale;
    __device__ __forceinline__ void operator()(const f32x4 (&acc)[2][2][4][2], const Unit& u, int wr, int wc, int fr, int fq) const {
        const int row0 = u.pm * BM + wr * 64 + fr, col0 = u.cn * BM + wc * 32 + 8 * fq;
        const bool isq = (u.cn >= 6 && u.cn < 12), isk = (u.cn >= 12 && u.cn < 18);
        const bool rot = (isq || isk) && ((wc & 1) == 0);
        const float sc = isq ? qscale : 1.0f;
        const float sg = (fq == 0) ? -1.0f : 1.0f;
        const bool act = fq < 2;
#pragma unroll
        for (int ai = 0; ai < 2; ++ai)
#pragma unroll
            for (int m = 0; m < 4; ++m) { const int row = row0 + ai * HALF + m * 16; bf16_t* rowp = O + (size_t)row * 6144 + col0;
                f32x4 c0 = {1.f, 1.f, 1.f, 1.f}, c1 = c0, s0 = {0.f, 0.f, 0.f, 0.f}, s1 = s0;
                if (rot) { const float* rp = rope + (row & 2047) * 16; c0 = *(const f32x4*)rp; c1 = *(const f32x4*)(rp + 4); s0 = *(const f32x4*)(rp + 8); s1 = *(const f32x4*)(rp + 12); }
#pragma unroll
                for (int bj = 0; bj < 2; ++bj) { f32x4 v0 = acc[ai][bj][m][0], v1 = acc[ai][bj][m][1];
                    if (rot) { f32x4 o0, o1;
#pragma unroll
                        for (int i = 0; i < 4; ++i) { o0[i] = __shfl_xor(v0[i], 16); o1[i] = __shfl_xor(v1[i], 16); }
                        const f32x4 r0 = v0 * c0 + (o0 * s0) * sg, r1 = v1 * c1 + (o1 * s1) * sg;
                        v0 = act ? r0 : v0; v1 = act ? r1 : v1; }
                    v0 = v0 * sc; v1 = v1 * sc;
                    u32x4 w; w.x = cvt_pk_bf16(v0[0], v0[1]); w.y = cvt_pk_bf16(v0[2], v0[3]); w.z = cvt_pk_bf16(v1[0], v1[1]); w.w = cvt_pk_bf16(v1[2], v1[3]);
                    *(u32x4*)(rowp + bj * HALF) = w; } }
    }
};
struct EpiResF32 {
    static constexpr bool PERM = false, AFTER_DRAIN = false;
    const float* base; float* out; int ldc;
    __device__ __forceinline__ void operator()(const f32x4 (&acc)[2][2][4][2], const Unit& u, int wr, int wc, int fr, int fq) const {
        const int row0 = u.pm * BM + wr * 64 + fr, col0 = u.cn * BM + wc * 32 + 4 * fq;
#pragma unroll
        for (int ai = 0; ai < 2; ++ai)
#pragma unroll
            for (int m = 0; m < 4; ++m) { const size_t off = (size_t)(row0 + ai * HALF + m * 16) * ldc + col0;
#pragma unroll
                for (int bj = 0; bj < 2; ++bj)
#pragma unroll
                    for (int n = 0; n < 2; ++n) { const f32x4 b = *(const f32x4*)(base + off + bj * HALF + n * 16); *(f32x4*)(out + off + bj * HALF + n * 16) = acc[ai][bj][m][n] + b; } }
    }
};
__device__ __forceinline__ float swiglu1(float g, float up) {
    g = fminf(g, 7.0f); up = fminf(fmaxf(up, -7.0f), 7.0f);
    const float e = __builtin_amdgcn_exp2f(g * (-1.702f * 1.4426950408889634f));
    return (up + 1.0f) * g * __builtin_amdgcn_rcpf(1.0f + e);
}
__device__ __forceinline__ unsigned pk4_fp8(float a, float b, float c, float d) {
    a = fminf(fmaxf(a, -448.f), 448.f); b = fminf(fmaxf(b, -448.f), 448.f); c = fminf(fmaxf(c, -448.f), 448.f); d = fminf(fmaxf(d, -448.f), 448.f);
    int w = 0; w = __builtin_amdgcn_cvt_pk_fp8_f32(a, b, w, false); w = __builtin_amdgcn_cvt_pk_fp8_f32(c, d, w, true); return (unsigned)w; }
constexpr float FP8_W_SCALE = 64.f, FP8_X_SCALE = 16.f, FP8_ACT_SCALE = 4.f;
struct EpiFp8Y {
    static constexpr bool PERM = true, AFTER_DRAIN = false;
    unsigned char* O; float sc; const float* bias;
    __device__ __forceinline__ void operator()(const f32x4 (&acc)[2][2][4][2], const Unit& u, int wr, int wc, int fr, int fq) const {
        const int row0 = u.pm * BM + wr * 64 + fr, col0 = u.cn * BM + wc * 32 + 8 * fq;
        f32x4 bv[2][2];
#pragma unroll
        for (int bj = 0; bj < 2; ++bj)
#pragma unroll
            for (int n = 0; n < 2; ++n) bv[bj][n] = *(const f32x4*)(bias + (size_t)u.e * 2048 + col0 + bj * HALF + 4 * n);
#pragma unroll
        for (int ai = 0; ai < 2; ++ai) { if (ai == 1 && u.rows <= HALF) break;
#pragma unroll
            for (int m = 0; m < 4; ++m) { unsigned char* rowp = O + (size_t)(row0 + ai * HALF + m * 16) * 2048 + col0;
#pragma unroll
                for (int bj = 0; bj < 2; ++bj) { const f32x4 v0 = (acc[ai][bj][m][0] * sc + bv[bj][0]) * 16.f, v1 = (acc[ai][bj][m][1] * sc + bv[bj][1]) * 16.f;
                    typedef unsigned u32x2y __attribute__((ext_vector_type(2))); u32x2y w; w.x = pk4_fp8(v0[0], v0[1], v0[2], v0[3]); w.y = pk4_fp8(v1[0], v1[1], v1[2], v1[3]);
                    *(u32x2y*)(rowp + bj * HALF) = w; } } }
    }
};
struct EpiSwiGLU {
    static constexpr bool PERM = true, AFTER_DRAIN = false;
    unsigned char* O; const float* bias;
    __device__ __forceinline__ void operator()(const f32x4 (&acc)[2][2][4][2], const Unit& u, int wr, int wc, int fr, int fq) const {
        const int row0 = u.pm * BM + wr * 64 + fr, colj = u.cn * HALF + wc * 32 + 8 * fq;
        const float* bg = bias + (size_t)u.e * 4096 + colj; const float isc = 1.0f / (FP8_W_SCALE * FP8_X_SCALE);
        const f32x4 bg0 = *(const f32x4*)(bg), bg1 = *(const f32x4*)(bg + 4), bu0 = *(const f32x4*)(bg + 2048), bu1 = *(const f32x4*)(bg + 2048 + 4);
#pragma unroll
        for (int ai = 0; ai < 2; ++ai) { if (ai == 1 && u.rows <= HALF) break;
#pragma unroll
            for (int m = 0; m < 4; ++m) { unsigned char* rowp = O + (size_t)(row0 + ai * HALF + m * 16) * 2048 + colj;
                const f32x4 g0 = acc[ai][0][m][0] * isc + bg0, g1 = acc[ai][0][m][1] * isc + bg1, u0 = acc[ai][1][m][0] * isc + bu0, u1 = acc[ai][1][m][1] * isc + bu1;
                typedef unsigned u32x2e __attribute__((ext_vector_type(2))); u32x2e w;
                w.x = pk4_fp8(FP8_ACT_SCALE * swiglu1(g0[0], u0[0]), FP8_ACT_SCALE * swiglu1(g0[1], u0[1]), FP8_ACT_SCALE * swiglu1(g0[2], u0[2]), FP8_ACT_SCALE * swiglu1(g0[3], u0[3]));
                w.y = pk4_fp8(FP8_ACT_SCALE * swiglu1(g1[0], u1[0]), FP8_ACT_SCALE * swiglu1(g1[1], u1[1]), FP8_ACT_SCALE * swiglu1(g1[2], u1[2]), FP8_ACT_SCALE * swiglu1(g1[3], u1[3]));
                *(u32x2e*)rowp = w; } }
    }
};
typedef short v4i16p_t __attribute__((ext_vector_type(4)));
typedef int v2i_t __attribute__((ext_vector_type(2)));
__device__ __forceinline__ v2i_t trb(PG8_LAS const unsigned char* p) { return __builtin_bit_cast(v2i_t, __builtin_amdgcn_ds_read_tr16_b64_v4i16((PG8_LAS v4i16p_t*)p)); }
typedef int v8i_t __attribute__((ext_vector_type(8)));
typedef int v4i_t __attribute__((ext_vector_type(4)));
__device__ __forceinline__ v8i_t cat8(bf16x8 a, bf16x8 b) { const v4i_t x = __builtin_bit_cast(v4i_t, a), y = __builtin_bit_cast(v4i_t, b); return __builtin_shufflevector(x, y, 0, 1, 2, 3, 4, 5, 6, 7); }
__device__ __forceinline__ void mfma_fp8(f32x4& c, v8i_t a, v8i_t b, int sc) { asm volatile("v_mfma_scale_f32_16x16x128_f8f6f4 %0, %1, %2, %0, %3, %3 op_sel_hi:[0,0,0]" : "+v"(c) : "v"(a), "v"(b), "v"(sc)); }
struct NoSide { static constexpr bool ON = false, TWO = false; int njobs; };
struct SideConv {
    static constexpr bool ON = true, TWO = true;
    const float* W; unsigned char* OUT; int ntot; int c0, njobs; unsigned stage;
    __device__ __forceinline__ void addr(int j, int tid, const float*& s0, unsigned char*& d) const {
        const int c = c0 + j, cpk = ntot >> 11, kpg = c / cpk, half = c - kpg * cpk, e = kpg >> 10, kp = kpg & 1023;
        s0 = W + (size_t)e * 2048 * ntot + (size_t)(2 * kp) * ntot + half * 2048 + 4 * tid;
        d = OUT + ((size_t)e * 1024 + kp) * ntot * 2 + (size_t)(half * 2048 + 4 * tid) * 2;
    }
    __device__ __forceinline__ void issue(PG8_LAS unsigned char* lds0, int j, int tid, int wid) const {
        const float* s0; unsigned char* d; addr(j, tid, s0, d);
        __builtin_amdgcn_global_load_lds((const unsigned*)s0, (PG8_LAS unsigned*)(lds0 + stage + wid * 1024), 16, 0, 2);
        __builtin_amdgcn_global_load_lds((const unsigned*)(s0 + ntot), (PG8_LAS unsigned*)(lds0 + stage + 8192 + wid * 1024), 16, 0, 2);
    }
    __device__ __forceinline__ void read(v4i_t& t0, v4i_t& t1, int tid, unsigned ldsb) const {
        asm volatile("ds_read_b128 %0, %1" : "=&v"(t0) : "v"(ldsb + stage + 16u * (unsigned)tid) : "memory");
        asm volatile("ds_read_b128 %0, %1" : "=&v"(t1) : "v"(ldsb + stage + 8192u + 16u * (unsigned)tid) : "memory");
    }
    __device__ __forceinline__ void finish(v4i_t& t0, v4i_t& t1, int j, int tid) const {
        asm volatile("" : "+v"(t0), "+v"(t1));
        const float* s0; unsigned char* d; addr(j, tid, s0, d);
        const f32x4 r0 = __builtin_bit_cast(f32x4, t0) * 64.f, r1 = __builtin_bit_cast(f32x4, t1) * 64.f;
        int w0 = 0, w1 = 0; w0 = __builtin_amdgcn_cvt_pk_fp8_f32(r0[0], r1[0], w0, false); w0 = __builtin_amdgcn_cvt_pk_fp8_f32(r0[1], r1[1], w0, true);
        w1 = __builtin_amdgcn_cvt_pk_fp8_f32(r0[2], r1[2], w1, false); w1 = __builtin_amdgcn_cvt_pk_fp8_f32(r0[3], r1[3], w1, true);
        typedef int v2is __attribute__((ext_vector_type(2))); __builtin_nontemporal_store((v2is){w0, w1}, (v2is*)d);
    }
};
template <class Epi, class Sched, bool ALIGN_EPI = false, bool SP2 = false, bool FP8 = false, bool BPAIR = false, class Side = NoSide>
__device__ __forceinline__ void gemm_phase(PG8_LAS unsigned char* lds, const Gemm g, const Sched& S, const Epi& E, const Side SD = Side{}) {
    const int tid = threadIdx.x, wid = __builtin_amdgcn_readfirstlane(tid >> 6), lane = tid & 63, wr = wid >> 2, wc = wid & 3, fr = lane & 15, fq = lane >> 4;
    const int K = g.K, nt = K / BK;
    int fp8_scale1 = 0x7f7f7f7f; if constexpr (FP8) asm volatile("" : "+v"(fp8_scale1));
    unsigned voffA[2], voffB[2];
#pragma unroll
    for (int i = 0; i < 2; ++i) { int R, C; stage_rc(tid * 16 + i * 8192, R, C); const int Rb = Epi::PERM ? ((R & ~31) + perm32(R & 31)) : R;
        voffA[i] = (unsigned)(R * K + C) * 2u; voffB[i] = (unsigned)(Rb * K + C) * 2u;
        if constexpr (BPAIR) { const int b_ = tid * 16 + i * 8192, kp_ = b_ >> 8, sl_ = (b_ & 255) >> 4, pc_ = sl_ ^ (2 * ((kp_ & 3) | (((kp_ >> 3) & 1) << 2))); voffB[i] = (unsigned)(kp_ * g.b_ntot + 8 * pc_) * 2u; } }
    const size_t kstep = (size_t)(BK * 2);
    const size_t hstep = (size_t)HALF * K * 2;
    const size_t tstep = 2 * hstep;
    const size_t kstepB = BPAIR ? (size_t)64 * g.b_ntot * 2 : kstep, hstepB = BPAIR ? (size_t)g.b_hstep : hstep;
    const unsigned ldsw = (unsigned)wid * 1024u;
    const int aoff = lds_byte(wr * 64 + fr, fq * 8), boff = lds_byte(wc * 32 + fr, fq * 8);
    const int boffP = (8 * fq + ((lane & 15) >> 2)) * 256 + 16 * ((4 * wc + (lane & 3)) ^ (2 * (((lane & 15) >> 2) | ((fq & 1) << 2))));
#define PG8_SA(b, h) (((b) * 2 + (h)) * HTB)
#define PG8_SB(b, h) ((4 + (b) * 2 + (h)) * HTB)
#define PG8_STAGE(bufoff, gbase, voff) do { _Pragma("unroll") for (int _i = 0; _i < 2; ++_i) \
        __builtin_amdgcn_global_load_lds((const unsigned*)((const char*)(gbase) + (voff)[_i]), (PG8_LAS unsigned*)(lds + (bufoff) + ldsw + _i * 8192), 16, 0, 0); } while (0)
#define PG8_LDA(dst, b, h) do { _Pragma("unroll") for (int m = 0; m < 4; ++m) _Pragma("unroll") for (int k = 0; k < 2; ++k) dst[m][k] = *(const PG8_LAS bf16x8*)(lds + PG8_SA(b, h) + aoff + m * 2048 + k * 1024); } while (0)
#define PG8_TRA(dstv, addr, off) asm volatile("ds_read_b64_tr_b16 %0, %1 offset:%c2" : "=&v"(dstv) : "v"(addr), "i"(off) : "memory")
#define PG8_LDB(dst, b, h) do { if constexpr (BPAIR) { _Pragma("unroll") for (int n = 0; n < 2; ++n) { const unsigned a_ = ldsb32 + (unsigned)(PG8_SB(b, h) + boffP + 8 * n); \
            PG8_TRA(dst##r[n][0], a_, 0); PG8_TRA(dst##r[n][1], a_, 1024); PG8_TRA(dst##r[n][2], a_, 8192); PG8_TRA(dst##r[n][3], a_, 9216); } } \
        else { _Pragma("unroll") for (int n = 0; n < 2; ++n) _Pragma("unroll") for (int k = 0; k < 2; ++k) dst[n][k] = *(const PG8_LAS bf16x8*)(lds + PG8_SB(b, h) + boff + n * 2048 + k * 1024); } } while (0)
#define PG8_FIXB(dst) do { if constexpr (BPAIR) { _Pragma("unroll") for (int n = 0; n < 2; ++n) { \
            asm volatile("" : "+v"(dst##r[n][0]), "+v"(dst##r[n][1]), "+v"(dst##r[n][2]), "+v"(dst##r[n][3])); \
            dst[n][0] = __builtin_bit_cast(bf16x8, (v4i_t){dst##r[n][0][0], dst##r[n][0][1], dst##r[n][1][0], dst##r[n][1][1]}); dst[n][1] = __builtin_bit_cast(bf16x8, (v4i_t){dst##r[n][2][0], dst##r[n][2][1], dst##r[n][3][0], dst##r[n][3][1]}); } } } while (0)
#define PG8_MMA(ai, bj, At, Bt) do { __builtin_amdgcn_s_setprio(1); _Pragma("unroll") for (int m = 0; m < 4; ++m) _Pragma("unroll") for (int n = 0; n < 2; ++n) { \
        if constexpr (FP8) { mfma_fp8(acc[ai][bj][m][n], cat8(Bt[n][0], Bt[n][1]), cat8(At[m][0], At[m][1]), fp8_scale1); } \
        else { _Pragma("unroll") for (int k = 0; k < 2; ++k) acc[ai][bj][m][n] = __builtin_amdgcn_mfma_f32_16x16x32_bf16(Bt[n][k], At[m][k], acc[ai][bj][m][n], 0, 0, 0); } } \
        __builtin_amdgcn_s_setprio(0); } while (0)
#define PG8_WAIT_V(n) asm volatile("s_waitcnt vmcnt(" #n ")" ::: "memory")
#define PG8_WAIT_L(n) asm volatile("s_waitcnt lgkmcnt(" #n ")" ::: "memory")
#define PG8_BAR __builtin_amdgcn_s_barrier()
#define PG8_SCHED __builtin_amdgcn_sched_barrier(0)
    Unit cur, nxt; int ui = 0;
    if (!S.next(0, cur)) return;
    f32x4 acc[2][2][4][2];
#pragma unroll
    for (int a = 0; a < 2; ++a)
#pragma unroll
        for (int b = 0; b < 2; ++b)
#pragma unroll
            for (int m = 0; m < 4; ++m)
#pragma unroll
                for (int n = 0; n < 2; ++n) acc[a][b][m][n] = (f32x4){0.f, 0.f, 0.f, 0.f};
    bf16x8 At[4][2], B0[2][2], B1[2][2];
    int sj = 0; bool spend = false; v4i_t st0 = {0, 0, 0, 0}, st1 = st0; PG8_LAS unsigned char* const lds0 = lds;
    v2i_t B0r[2][4], B1r[2][4]; const unsigned ldsb32 = (unsigned)(size_t)lds;
    const char* cA = (const char*)g.A + (size_t)cur.pm * tstep; const char* cB = (const char*)g.Bt + (BPAIR ? (size_t)cur.boff : (size_t)cur.pn * tstep);
    S.a_ready(cur);
    if constexpr (SP2) {
        PG8_STAGE(PG8_SB(0, 0), cB, voffB); PG8_STAGE(PG8_SB(0, 1), cB + hstepB, voffB); PG8_STAGE(PG8_SA(0, 0), cA, voffA); PG8_STAGE(PG8_SA(0, 1), cA + hstep, voffA);
        if (wr == 1) PG8_BAR;
        PG8_WAIT_V(2); PG8_BAR;
        PG8_STAGE(PG8_SB(1, 0), cB + kstepB, voffB); PG8_STAGE(PG8_SA(1, 0), cA + kstep, voffA); PG8_STAGE(PG8_SB(1, 1), cB + hstepB + kstepB, voffB);
        PG8_WAIT_V(6); PG8_BAR;
    } else {
        PG8_STAGE(PG8_SB(0, 0), cB, voffB); PG8_STAGE(PG8_SA(0, 0), cA, voffA); PG8_STAGE(PG8_SB(0, 1), cB + hstepB, voffB); PG8_STAGE(PG8_SA(0, 1), cA + hstep, voffA);
        if (wr == 1) PG8_BAR;
        PG8_WAIT_V(4); PG8_BAR;
        PG8_STAGE(PG8_SB(1, 0), cB + kstepB, voffB); PG8_STAGE(PG8_SA(1, 0), cA + kstep, voffA); PG8_STAGE(PG8_SB(1, 1), cB + hstepB + kstepB, voffB);
        PG8_WAIT_V(6); PG8_BAR;
    }
    for (;;) {
        const bool has_next = S.next(ui + 1, nxt);
        const char* nA = has_next ? (const char*)g.A + (size_t)nxt.pm * tstep : cA; const char* nB = has_next ? (const char*)g.Bt + (BPAIR ? (size_t)nxt.boff : (size_t)nxt.pn * tstep) : cB;
        for (int t = 0; t < nt; t += 2) {
            const bool last = (t == nt - 2);
            const char* a1 = cA + (size_t)(t + 1) * kstep;
            const char* a2 = last ? nA : cA + (size_t)(t + 2) * kstep; const char* b2 = last ? nB : cB + (size_t)(t + 2) * kstepB;
            const char* a3 = a2 + kstep; const char* b3 = b2 + kstepB;
            if (last && has_next) S.a_ready(nxt);
            if constexpr (SP2) {
            PG8_LDB(B0, 0, 0); PG8_LDB(B1, 0, 1); PG8_SCHED; PG8_LDA(At, 0, 0); PG8_STAGE(PG8_SA(1, 1), a1 + hstep, voffA);
            PG8_WAIT_V(8);
            if constexpr (Side::ON) { if (spend) SD.read(st0, st1, tid, (unsigned)(size_t)lds); }
            PG8_WAIT_L(0); PG8_FIXB(B0); PG8_FIXB(B1);
            if constexpr (Side::ON) { if (spend) { SD.finish(st0, st1, sj - 1, tid); spend = false; } if (sj < SD.njobs) { SD.issue(lds0, sj, tid, wid); ++sj; spend = true; } }
            PG8_BAR; PG8_MMA(0, 0, At, B0); PG8_MMA(0, 1, At, B1); PG8_BAR; PG8_SCHED;
            PG8_LDA(At, 0, 1); PG8_STAGE(PG8_SB(0, 0), b2, voffB); PG8_STAGE(PG8_SB(0, 1), b2 + hstepB, voffB); PG8_STAGE(PG8_SA(0, 0), a2, voffA);
            PG8_WAIT_V(8); PG8_WAIT_L(0); PG8_BAR; if (!(FP8 && cur.rows <= HALF)) { PG8_MMA(1, 0, At, B0); PG8_MMA(1, 1, At, B1); } PG8_BAR; PG8_SCHED;
            PG8_LDB(B0, 1, 0); PG8_LDB(B1, 1, 1); PG8_SCHED; PG8_LDA(At, 1, 0); PG8_STAGE(PG8_SA(0, 1), a2 + hstep, voffA);
            PG8_WAIT_V(8);
            if constexpr (Side::ON) { if (Side::TWO && spend) SD.read(st0, st1, tid, (unsigned)(size_t)lds); }
            PG8_WAIT_L(0); PG8_FIXB(B0); PG8_FIXB(B1);
            if constexpr (Side::ON) { if (Side::TWO) { if (spend) { SD.finish(st0, st1, sj - 1, tid); spend = false; } if (sj < SD.njobs) { SD.issue(lds0, sj, tid, wid); ++sj; spend = true; } } }
            PG8_BAR; PG8_MMA(0, 0, At, B0); PG8_MMA(0, 1, At, B1); PG8_BAR; PG8_SCHED;
            PG8_LDA(At, 1, 1); PG8_STAGE(PG8_SB(1, 0), b3, voffB); PG8_STAGE(PG8_SB(1, 1), b3 + hstepB, voffB); PG8_STAGE(PG8_SA(1, 0), a3, voffA);
            PG8_WAIT_V(8); PG8_WAIT_L(0); PG8_BAR; if (!(FP8 && cur.rows <= HALF)) { PG8_MMA(1, 0, At, B0); PG8_MMA(1, 1, At, B1); } PG8_BAR; PG8_SCHED;
            } else {
            PG8_LDB(B0, 0, 0); PG8_SCHED; PG8_LDA(At, 0, 0); PG8_STAGE(PG8_SA(1, 1), a1 + hstep, voffA);
            PG8_WAIT_L(8); PG8_BAR; PG8_WAIT_L(0); PG8_MMA(0, 0, At, B0); PG8_BAR; PG8_SCHED;
            PG8_LDB(B1, 0, 1); PG8_STAGE(PG8_SB(0, 0), b2, voffB);
            PG8_BAR; PG8_WAIT_L(0); PG8_MMA(0, 1, At, B1); PG8_BAR;
            PG8_LDA(At, 0, 1); PG8_STAGE(PG8_SA(0, 0), a2, voffA);
            PG8_BAR; PG8_WAIT_L(0); PG8_MMA(1, 0, At, B0); PG8_BAR; PG8_SCHED;
            PG8_STAGE(PG8_SB(0, 1), b2 + hstepB, voffB);
            PG8_WAIT_V(6); PG8_BAR; PG8_MMA(1, 1, At, B1); PG8_BAR;
            PG8_LDB(B0, 1, 0); PG8_SCHED; PG8_LDA(At, 1, 0); PG8_STAGE(PG8_SA(0, 1), a2 + hstep, voffA);
            PG8_WAIT_L(8); PG8_BAR; PG8_WAIT_L(0); PG8_MMA(0, 0, At, B0); PG8_BAR; PG8_SCHED;
            PG8_LDB(B1, 1, 1); PG8_STAGE(PG8_SB(1, 0), b3, voffB);
            PG8_BAR; PG8_WAIT_L(0); PG8_MMA(0, 1, At, B1); PG8_BAR;
            PG8_LDA(At, 1, 1); PG8_STAGE(PG8_SA(1, 0), a3, voffA);
            PG8_BAR; PG8_WAIT_L(0); PG8_MMA(1, 0, At, B0); PG8_BAR; PG8_SCHED;
            PG8_STAGE(PG8_SB(1, 1), b3 + hstepB, voffB);
            PG8_WAIT_V(6); PG8_BAR; PG8_MMA(1, 1, At, B1); PG8_BAR;
            }
        }
        if constexpr (ALIGN_EPI) { if (wr == 0) PG8_BAR; }
        if constexpr (FP8) asm volatile("s_nop 15\n\ts_nop 15" ::: "memory");
        if constexpr (!Epi::AFTER_DRAIN) { int tz = threadIdx.x; asm volatile("" : "+v"(tz));
            const int wz = __builtin_amdgcn_readfirstlane(tz >> 6), lz = tz & 63; E(acc, cur, wz >> 2, wz & 3, lz & 15, lz >> 4); S.done(cur); }
        if (!has_next) break;
#pragma unroll
        for (int a = 0; a < 2; ++a)
#pragma unroll
            for (int b = 0; b < 2; ++b)
#pragma unroll
                for (int m = 0; m < 4; ++m)
#pragma unroll
                    for (int n = 0; n < 2; ++n) acc[a][b][m][n] = (f32x4){0.f, 0.f, 0.f, 0.f};
        cur = nxt; cA = nA; cB = nB; ++ui;
        if constexpr (ALIGN_EPI) { if (wr == 1) PG8_BAR; }
    }
    PG8_WAIT_V(0);
    if constexpr (!ALIGN_EPI) { if (wr == 0) PG8_BAR; }
    PG8_BAR;
    if constexpr (Side::ON) { if (spend) { SD.read(st0, st1, tid, (unsigned)(size_t)lds); PG8_WAIT_L(0); SD.finish(st0, st1, sj - 1, tid); spend = false; } }
    if constexpr (Epi::AFTER_DRAIN) { E.fused(acc, cur, wr, wc, fr, fq, lds, wid, lane); S.done(cur); }
#undef PG8_SA
#undef PG8_SB
#undef PG8_STAGE
#undef PG8_LDA
#undef PG8_LDB
#undef PG8_TRA
#undef PG8_FIXB
#undef PG8_MMA
#undef PG8_WAIT_V
#undef PG8_WAIT_L
#undef PG8_BAR
#undef PG8_SCHED
}
}
#define GAS __attribute__((address_space(1)))
#define LAS __attribute__((address_space(3)))
typedef unsigned short bf16;
typedef unsigned v4u __attribute__((ext_vector_type(4)));
typedef float f32x4 __attribute__((ext_vector_type(4)));
typedef short bf16x8 __attribute__((ext_vector_type(8)));
typedef GAS unsigned gu32;
typedef GAS unsigned long long gu64;
#define RLX_AGENT __ATOMIC_RELAXED, __HIP_MEMORY_SCOPE_AGENT
#define LDS_WAIT() asm volatile("s_waitcnt lgkmcnt(0)" ::: "memory")
#define VM_WAIT() asm volatile("s_waitcnt vmcnt(0)" ::: "memory")
__device__ __forceinline__ unsigned long long rt() { return __builtin_amdgcn_s_memrealtime(); }
__device__ __forceinline__ unsigned f2bf(float f) { unsigned u = __builtin_bit_cast(unsigned, f); return (u + 0x7fffu + ((u >> 16) & 1u)) >> 16; }
__device__ __forceinline__ unsigned pk2(float lo, float hi) { return f2bf(lo) | (f2bf(hi) << 16); }

#define XB_TMO      128
#define XB_XCNT(j)  (256  + 64 * (j))
#define XB_XSUB(j)  (1280 + 64 * (j))
#define XB_XGEN(j)  (2304 + 64 * (j))
#define XB_TOP      3328
#define XB_TOPGEN   3392
#define XCD_BAR_WORDS 3456
#define XB_SPIN_CAP (1u << 18)

__device__ __forceinline__ unsigned xb_ld(unsigned* p)              { return __hip_atomic_load(p, __ATOMIC_RELAXED, __HIP_MEMORY_SCOPE_AGENT); }
__device__ __forceinline__ unsigned xb_add(unsigned* p, unsigned v) { return __hip_atomic_fetch_add(p, v, __ATOMIC_RELAXED, __HIP_MEMORY_SCOPE_AGENT); }
__device__ __forceinline__ unsigned xb_xcc_id() { return (unsigned)__builtin_amdgcn_s_getreg((3 << 11) | 20) & 0xFu; }
#define XB_SPIN(cond, bar) do { unsigned _sp = 0; while (cond) { __builtin_amdgcn_s_sleep(1); \
    if ((++_sp & 255u) == 0u) { if (xb_ld(&(bar)[XB_TMO])) break; if (_sp > XB_SPIN_CAP) { atomicAdd(&(bar)[XB_TMO], 1u); break; } } } } while (0)

struct XcdBarrier {
    unsigned* bar; unsigned x;
    volatile LAS unsigned* st;
};

__device__ __forceinline__ XcdBarrier xcd_barrier_post(unsigned* bar, volatile LAS unsigned* st) {
    XcdBarrier b; b.bar = bar; b.x = xb_xcc_id(); b.st = st;
    if (threadIdx.x == 0) (void)xb_add(&bar[XB_XCNT(b.x)], 1u);
    return b;
}
__device__ __forceinline__ void xcd_barrier_complete(unsigned* bar, unsigned x, unsigned& nloc, unsigned& nx) {
    const unsigned G = gridDim.x * gridDim.y * gridDim.z;
    unsigned sum, cnt, mine, sp = 0u;
    for (;;) {
        sum = 0u; cnt = 0u; mine = 0u;
#pragma unroll
        for (unsigned j = 0; j < 16; ++j) { const unsigned c = xb_ld(&bar[XB_XCNT(j)]); sum += c; cnt += (c > 0u) ? 1u : 0u; mine = (j == x) ? c : mine; }
        if (sum == G) break;
        __builtin_amdgcn_s_sleep(1);
        if ((++sp & 255u) == 0u) { if (xb_ld(&bar[XB_TMO])) break; if (sp > XB_SPIN_CAP) { atomicAdd(&bar[XB_TMO], 1u); break; } }
    }
    nloc = mine > 0u ? mine : 1u; nx = cnt > 0u ? cnt : 1u;
}

__device__ __forceinline__ void xcd_barrier(const XcdBarrier& b) {
    asm volatile("s_waitcnt vmcnt(0)" ::: "memory");
    __syncthreads();
    if (threadIdx.x == 0) {
        unsigned* bar = b.bar;
        __builtin_amdgcn_s_waitcnt(0);
        unsigned nloc = b.st[0], nx = b.st[1];
        if (nloc == 0u) { xcd_barrier_complete(bar, b.x, nloc, nx); b.st[0] = nloc; b.st[1] = nx; }
        const unsigned old = xb_add(&bar[XB_XSUB(b.x)], 1u);
        const unsigned gen = old / nloc;
        if (old + 1u == (gen + 1u) * nloc) {
            __builtin_amdgcn_fence(__ATOMIC_RELEASE, "agent");
            asm volatile("s_waitcnt vmcnt(0)" ::: "memory");
            const unsigned og = xb_add(&bar[XB_TOP], 1u);
            const unsigned tg = og / nx;
            if (og + 1u == (tg + 1u) * nx) xb_add(&bar[XB_TOPGEN], 1u);
            else XB_SPIN(xb_ld(&bar[XB_TOPGEN]) == tg, bar);
            __builtin_amdgcn_fence(__ATOMIC_ACQUIRE, "agent");
            xb_add(&bar[XB_XGEN(b.x)], 1u);
            asm volatile("s_waitcnt vmcnt(0)" ::: "memory");
        } else {
            XB_SPIN(xb_ld(&bar[XB_XGEN(b.x)]) == gen, bar);
            __builtin_amdgcn_fence(__ATOMIC_ACQUIRE, "agent");
            asm volatile("s_waitcnt vmcnt(0)" ::: "memory");
        }
    }
    __syncthreads();
}

constexpr int NB = 4, SEQ = 2048, DM = 2048, NTOK = NB * SEQ, INC = 6144, CW = 512, AW = 1536, NH = 24, HD = 64, NE = 32, TOPK = 4, DE = 2048;
constexpr int QOFF = 1536, KOFF = 3072, VOFF = 4608;
constexpr int MAXSLOT = NE * NTOK;
constexpr float EPS = 1e-5f;
typedef unsigned u32x2v __attribute__((ext_vector_type(2)));
constexpr int NWAVES = 8;
#ifndef MK_N_LAUNCHES
#define MK_N_LAUNCHES 1
#endif
#ifndef PROBE_MASK
#define PROBE_MASK 0
#endif
#ifndef PROBE_N
#define PROBE_N 2
#endif
#define REPS(k) (((PROBE_MASK >> (k)) & 1) ? PROBE_N : 1)
#ifndef PROBE_AMP
#define PROBE_AMP 0
#endif
#ifndef PROBE_AMP_N
#define PROBE_AMP_N 3
#endif
#define AMP_BEGIN(k) unsigned long long amp_t0_ = 0; if ((PROBE_AMP >> (k)) & 1) amp_t0_ = __builtin_amdgcn_s_memrealtime()
#define AMP_END(k) do { if ((PROBE_AMP >> (k)) & 1) { const unsigned long long t1_ = __builtin_amdgcn_s_memrealtime(); const unsigned long long tg_ = t1_ + (unsigned long long)PROBE_AMP_N * (t1_ - amp_t0_); while (__builtin_amdgcn_s_memrealtime() < tg_) __builtin_amdgcn_s_sleep(16); } } while (0)
constexpr int NPH = 10;

constexpr size_t MiB = 1u << 20;
constexpr size_t WS_CTL = 0, CTL_ZERO_BYTES = 1 * MiB;
constexpr size_t WS_ROPE = 1 * MiB;
constexpr size_t WS_TOKE = 2 * MiB, WS_TOKR = WS_TOKE + 128 * 1024, WS_TOKG = WS_TOKR + 128 * 1024;
constexpr size_t WS_LIST = 3 * MiB;
constexpr size_t WS_WIN = 8 * MiB;
constexpr size_t WS_WO = 32 * MiB;
constexpr size_t WS_XN = 40 * MiB;
constexpr size_t WS_PROJ = 72 * MiB;
constexpr size_t WS_YATT = 168 * MiB;
constexpr size_t WS_MIXED = 192 * MiB;
constexpr size_t WS_X1 = 224 * MiB;
constexpr size_t WS_XN2 = 288 * MiB;
constexpr size_t WS_XS = 320 * MiB;
constexpr size_t WS_ACT = 832 * MiB;
constexpr size_t WS_Y = 1344 * MiB;
constexpr size_t WS_WGU = 2368 * MiB;
constexpr size_t WS_WDN = 2624 * MiB;
constexpr size_t WS_END = 2752 * MiB;
constexpr int CW_TMO = 0, CW_CODE = 1;
constexpr int CW_BAR = 4096;
constexpr int CW_CNT = 8192;
constexpr int CW_ATTQ = 12288;
constexpr int CW_CONVQ = 12288 + 4096;
constexpr int CW_P1DONE = 12288 + 8192;
#ifndef ATT_ITEM
#define ATT_ITEM item2
#endif
#ifndef ATT_NOFALL
#define ATT_NOFALL 1
#endif
#ifndef ATT_JOIN
#define ATT_JOIN 0
#endif
#ifndef SIDE_CONV
#define SIDE_CONV 3
#endif
#ifndef SPLIT_P1
#define SPLIT_P1 0
#endif
#ifndef FUSED2
#define FUSED2 0
#endif
#ifndef FUSED_CONV
#define FUSED_CONV 0
#endif
#ifndef ATT_WAVES
#define ATT_WAVES 6
#endif
constexpr int RING_BYTES = 131072;
constexpr int LDSCTL_OFF = RING_BYTES;
constexpr int MISC_OFF = LDSCTL_OFF + 320;
constexpr int TAB_TS = LDSCTL_OFF + 1024;
constexpr int TAB_CN = LDSCTL_OFF + 1024 + 512;
constexpr int PART_OFF = RING_BYTES + 16384;
constexpr int LDS_BYTES = 163840;

__device__ __forceinline__ float wave_sum(float v) {
#pragma unroll
    for (int o = 1; o < 64; o <<= 1) v += __shfl_xor(v, o);
    return v;
}
__device__ __forceinline__ float bf_lo(unsigned w) { return __uint_as_float(w << 16); }
__device__ __forceinline__ float bf_hi(unsigned w) { return __uint_as_float(w & 0xffff0000u); }

__device__ __forceinline__ void p0_transpose_item(const float* W, int N, int K, bf16* WT, int k0, int n0, int out_row0, LAS float* scr, int lane) {
#pragma unroll 8
    for (int i = 0; i < 32; ++i) { const int kk = 2 * i + (lane >> 5); scr[kk * 33 + (lane & 31)] = __builtin_nontemporal_load(W + (size_t)(k0 + kk) * N + n0 + (lane & 31)); }
    LDS_WAIT(); asm volatile("" ::: "memory");
    const int c = lane & 7;
#pragma unroll
    for (int j = 0; j < 4; ++j) { const int n = (lane >> 3) + 8 * j; const LAS float* s = scr + (8 * c) * 33 + n;
        v4u o; o.x = pk2(s[0 * 33], s[1 * 33]); o.y = pk2(s[2 * 33], s[3 * 33]); o.z = pk2(s[4 * 33], s[5 * 33]); o.w = pk2(s[6 * 33], s[7 * 33]);
        *(GAS v4u*)(WT + (size_t)(out_row0 + n) * K + k0 + 8 * c) = o; }
    LDS_WAIT(); asm volatile("" ::: "memory");
}

__device__ __forceinline__ void p0_transpose_item_fp8(const float* W, int N, int K, unsigned char* WT, int k0, int n0, int out_row0, float scale, LAS float* scr, int lane) {
#pragma unroll 8
    for (int i = 0; i < 32; ++i) { const int kk = 2 * i + (lane >> 5); scr[kk * 33 + (lane & 31)] = W[(size_t)(k0 + kk) * N + n0 + (lane & 31)]; }
    LDS_WAIT(); asm volatile("" ::: "memory");
    const int c = lane & 3;
#pragma unroll
    for (int j = 0; j < 2; ++j) { const int n = (lane >> 2) + 16 * j; const LAS float* s = scr + (16 * c) * 33 + n;
        v4u o;
        o.x = pg8::pk4_fp8(scale * s[0 * 33], scale * s[1 * 33], scale * s[2 * 33], scale * s[3 * 33]);
        o.y = pg8::pk4_fp8(scale * s[4 * 33], scale * s[5 * 33], scale * s[6 * 33], scale * s[7 * 33]);
        o.z = pg8::pk4_fp8(scale * s[8 * 33], scale * s[9 * 33], scale * s[10 * 33], scale * s[11 * 33]);
        o.w = pg8::pk4_fp8(scale * s[12 * 33], scale * s[13 * 33], scale * s[14 * 33], scale * s[15 * 33]);
        *(GAS v4u*)(WT + (size_t)(out_row0 + n) * K + k0 + 16 * c) = o; }
    LDS_WAIT(); asm volatile("" ::: "memory");
}

__device__ __forceinline__ unsigned pk4_fp8_nc(float a, float b, float c, float d) { int w = 0; w = __builtin_amdgcn_cvt_pk_fp8_f32(a, b, w, false); w = __builtin_amdgcn_cvt_pk_fp8_f32(c, d, w, true); return (unsigned)w; }
struct ConvDesc { const float* src; unsigned char* dstb; int N, isdn; };
constexpr int CV_NG = 16, PER_E = 256 + 128, NCONV = 32 * PER_E;
__device__ __forceinline__ ConvDesc conv_decode(int it, const float* w_gu, const float* w_dn, unsigned char* WGU, unsigned char* WDN, int lane) {
    const int e = it / PER_E, r = it - e * PER_E; ConvDesc d;
    if (r < 256) { const int kp0 = 4 * r; d.N = 4096; d.isdn = 0; d.src = w_gu + (size_t)e * 2048 * 4096 + (size_t)(2 * kp0) * 4096 + 4 * lane; d.dstb = WGU + (size_t)e * 1024 * 8192 + (size_t)kp0 * 8192 + 8 * lane; }
    else { const int kp0 = 8 * (r - 256); d.N = 2048; d.isdn = 1; d.src = w_dn + (size_t)e * 2048 * 2048 + (size_t)(2 * kp0) * 2048 + 4 * lane; d.dstb = WDN + (size_t)e * 1024 * 4096 + (size_t)kp0 * 4096 + 8 * lane; }
    return d;
}
#define CV_LOAD(R, D, g) do { const int ro_ = (D).isdn ? 4 * ((g) >> 3) : 0, co_ = (D).isdn ? 256 * ((g) & 7) : 256 * (g); \
        _Pragma("unroll") for (int t_ = 0; t_ < 4; ++t_) _Pragma("unroll") for (int i_ = 0; i_ < 2; ++i_) R[2 * t_ + i_] = __builtin_nontemporal_load((const GAS f32x4*)((D).src + (size_t)(2 * (ro_ + t_) + i_) * (D).N + co_)); } while (0)
#define CV_PROC(R, D, g) do { const int ro_ = (D).isdn ? 4 * ((g) >> 3) : 0, co_ = (D).isdn ? 256 * ((g) & 7) : 256 * (g); \
        _Pragma("unroll") for (int t_ = 0; t_ < 4; ++t_) { u32x2v o_; \
            o_.x = pk4_fp8_nc(pg8::FP8_W_SCALE * R[2 * t_][0], pg8::FP8_W_SCALE * R[2 * t_ + 1][0], pg8::FP8_W_SCALE * R[2 * t_][1], pg8::FP8_W_SCALE * R[2 * t_ + 1][1]); \
            o_.y = pk4_fp8_nc(pg8::FP8_W_SCALE * R[2 * t_][2], pg8::FP8_W_SCALE * R[2 * t_ + 1][2], pg8::FP8_W_SCALE * R[2 * t_][3], pg8::FP8_W_SCALE * R[2 * t_ + 1][3]); \
            __builtin_nontemporal_store(o_, (GAS u32x2v*)((D).dstb + (size_t)(ro_ + t_) * (D).N * 2 + 2 * co_)); } } while (0)

namespace att {
typedef short s16x8 __attribute__((ext_vector_type(8)));
typedef short s16x4 __attribute__((ext_vector_type(4)));
typedef float f32x16 __attribute__((ext_vector_type(16)));
typedef unsigned u32x4 __attribute__((ext_vector_type(4)));
constexpr int VP = 144;
constexpr int WAVE_LDS = 32 * VP;
constexpr float C2 = 0.125f * 1.4426950408889634f;
constexpr int NITEMS = 16 * NB * NH * 4;
typedef short v4i16_t __attribute__((ext_vector_type(4)));
__device__ __forceinline__ s16x4 vtr(LAS const char* p) { return __builtin_bit_cast(s16x4, __builtin_amdgcn_ds_read_tr16_b64_v4i16((LAS v4i16_t*)p)); }

struct TileD { int abase, kp_off, kp_mul, W, mod4, sel; };
__device__ __forceinline__ TileD tile_desc(int u, int n1, int n2, int first1, int first2, int m0, int r4) {
    TileD d;
    if (u < n1) { d.abase = 4 * m0 - 128 + 32 * (first1 + u); d.kp_off = 0; d.kp_mul = 1; d.W = 128; d.mod4 = 0; d.sel = 0; }
    else if (u < n1 + n2) { d.abase = m0 - 128 + 32 * (first2 + u - n1); d.kp_off = r4; d.kp_mul = 4; d.W = 128; d.mod4 = 0; d.sel = 1; }
    else { d.abase = 32 * (u - n1 - n2); d.kp_off = r4; d.kp_mul = 4; d.W = 0x7fffffff; d.mod4 = 1; d.sel = 1; }
    return d;
}
#define ATT_LOADT(KF, VF, D) do { _Pragma("unroll") for (int j_ = 0; j_ < 4; ++j_) { const int pos_ = (D).kp_off + (D).kp_mul * ((D).abase + 8 * j_ + (lane >> 3)); \
        KF[j_] = *(const GAS u32x4*)(Kb + (size_t)pos_ * INC + 8 * (lane & 7)); VF[j_] = *(const GAS u32x4*)(Vb + (size_t)pos_ * INC + 8 * (lane & 7)); } } while (0)

template <int PMODE = 0>
__device__ __forceinline__ void item(int it, const bf16* PROJ, bf16* YATT, LAS char* vl, int lane) {
    const int bh = it >> 6, jj = it & 63; const int b = bh / NH, head = bh - b * NH, mb = 15 - (jj >> 2), r4 = jj & 3;
    const int m0 = mb * 32, q = lane & 31, h = lane >> 5;
    const int qpos = r4 + 4 * (m0 + q);
    const bf16* base = PROJ + (size_t)b * SEQ * INC;
    const bf16* Kb = base + KOFF + head * HD; const bf16* Vb = base + VOFF + head * HD;
    const int first1 = (mb == 0) ? 4 : 0, first2 = (mb < 4) ? 4 - mb : 0, n1 = 8 - first1, n2 = 5 - first2, ntile = n1 + n2 + mb + 1;
    u32x4 kA[4], vA[4], kB[4], vB[4];
    { const TileD d0 = tile_desc(0, n1, n2, first1, first2, m0, r4); ATT_LOADT(kA, vA, d0); }
    s16x8 qf[4];
    { const bf16* qp = base + (size_t)qpos * INC + QOFF + head * HD + 8 * h;
#pragma unroll
      for (int d0 = 0; d0 < 4; ++d0) qf[d0] = __builtin_bit_cast(s16x8, *(const GAS u32x4*)(qp + 16 * d0)); }
    f32x16 o0 = {}, o1 = {}; float mrun = -1e30f, lrun = 0.f;
    const int g = lane >> 4, qq = (lane & 15) >> 2, pp = lane & 3;
    LAS const char* vb = vl + (4 * h + qq) * VP + (16 * (g & 1) + 4 * pp) * 2;
    LAS char* kl = vl + WAVE_LDS;
    LAS u32x4* vd = (LAS u32x4*)(vl + (lane >> 3) * VP + (lane & 7) * 16);
    LAS u32x4* kd = (LAS u32x4*)(kl + (lane >> 3) * VP + (lane & 7) * 16);
    LAS const char* kfp = kl + (lane & 31) * VP + h * 16;
#pragma unroll 1
    for (int u = 0; u < ntile; ++u) {
        const TileD d = tile_desc(u, n1, n2, first1, first2, m0, r4);
        if (PMODE != 1) { const int un = (u + 1 < ntile) ? u + 1 : u; const TileD dn = tile_desc(un, n1, n2, first1, first2, m0, r4); ATT_LOADT(kB, vB, dn); }
#pragma unroll
        for (int j = 0; j < 4; ++j) { *(LAS u32x4*)((LAS char*)kd + 8 * j * VP) = kA[j]; *(LAS u32x4*)((LAS char*)vd + 8 * j * VP) = vA[j]; }
        if (PMODE != 2) {
        f32x16 s = {};
#pragma unroll
        for (int d0 = 0; d0 < 4; ++d0) s = __builtin_amdgcn_mfma_f32_32x32x16_bf16(*(const LAS s16x8*)(kfp + 32 * d0), qf[d0], s, 0, 0, 0);
        const int bq = d.sel ? (m0 + q) : qpos;
        const int t0 = bq - d.abase - 4 * h; const unsigned W = (unsigned)d.W; const int m4 = d.mod4 ? 3 : 0;
        float mx = -INFINITY;
#pragma unroll
        for (int r = 0; r < 16; ++r) { const int dd = t0 - ((r & 3) + 8 * (r >> 2));
            const bool ok = ((unsigned)dd <= W) && ((dd & m4) == 0);
            s[r] = ok ? s[r] : -INFINITY; mx = fmaxf(mx, s[r]); }
        mx = fmaxf(mx, __shfl_xor(mx, 32));
        const float mnew = fmaxf(mrun, mx), alpha = __builtin_amdgcn_exp2f(mrun - mnew); mrun = mnew;
        float ps = 0.f;
#pragma unroll
        for (int r = 0; r < 16; ++r) { s[r] = __builtin_amdgcn_exp2f(s[r] - mnew); ps += s[r]; }
        lrun = lrun * alpha + ps;
#pragma unroll
        for (int r = 0; r < 16; ++r) { o0[r] *= alpha; o1[r] *= alpha; }
        u32x4 p0, p1;
        p0.x = pk2(s[0], s[1]); p0.y = pk2(s[2], s[3]); p0.z = pk2(s[4], s[5]); p0.w = pk2(s[6], s[7]);
        p1.x = pk2(s[8], s[9]); p1.y = pk2(s[10], s[11]); p1.z = pk2(s[12], s[13]); p1.w = pk2(s[14], s[15]);
        const s16x8 pf0 = __builtin_bit_cast(s16x8, p0), pf1 = __builtin_bit_cast(s16x8, p1);
#pragma unroll
        for (int sstep = 0; sstep < 2; ++sstep) {
#pragma unroll
            for (int dh = 0; dh < 2; ++dh) {
                const s16x4 lo = vtr(vb + (16 * sstep) * VP + dh * 64), hi = vtr(vb + (16 * sstep + 8) * VP + dh * 64);
                const s16x8 vf = (s16x8){lo[0], lo[1], lo[2], lo[3], hi[0], hi[1], hi[2], hi[3]};
                if (dh == 0) o0 = __builtin_amdgcn_mfma_f32_32x32x16_bf16(vf, sstep ? pf1 : pf0, o0, 0, 0, 0);
                else         o1 = __builtin_amdgcn_mfma_f32_32x32x16_bf16(vf, sstep ? pf1 : pf0, o1, 0, 0, 0);
            }
        }
        }
        if (PMODE == 1) continue;
#pragma unroll
        for (int c = 0; c < 4; ++c) { kA[c] = kB[c]; vA[c] = vB[c]; }
    }
    const float inv = 1.0f / (lrun + __shfl_xor(lrun, 32));
    bf16* orow = YATT + (size_t)(b * SEQ + qpos) * AW + head * HD + 4 * h;
#pragma unroll
    for (int gq = 0; gq < 4; ++gq) {
        u32x2v a, c; a.x = pk2(o0[4 * gq] * inv, o0[4 * gq + 1] * inv); a.y = pk2(o0[4 * gq + 2] * inv, o0[4 * gq + 3] * inv);
        c.x = pk2(o1[4 * gq] * inv, o1[4 * gq + 1] * inv); c.y = pk2(o1[4 * gq + 2] * inv, o1[4 * gq + 3] * inv);
        *(u32x2v*)(orow + 8 * gq) = a; *(u32x2v*)(orow + 32 + 8 * gq) = c; }
}

__device__ __forceinline__ int krp(int key) { return (key & 0x16) | ((key >> 3) & 1) | ((key & 1) << 3); }
__device__ __forceinline__ void item2(int it, const bf16* PROJ, bf16* YATT, LAS char* wl, int lane) {
    const int bh = it >> 6, jj = it & 63; const int b = bh / NH, head = bh - b * NH, mb = 15 - (jj >> 2), r4 = jj & 3;
    const int m0 = mb * 32, q = lane & 31, h = lane >> 5;
    const int qpos = r4 + 4 * (m0 + q), bq2 = m0 + q;
    const bf16* base = PROJ + (size_t)b * SEQ * INC;
    const bf16* Kb = base + KOFF + head * HD; const bf16* Vb = base + VOFF + head * HD;
    const int first1 = (mb == 0) ? 4 : 0, first2 = (mb < 4) ? 4 - mb : 0, n1 = 8 - first1, n2 = 5 - first2, ntile = n1 + n2 + mb + 1, npair = (ntile + 1) >> 1;
    u32x4 k0[4], v0[4], k1[4], v1[4];
    { const TileD d0 = tile_desc(0, n1, n2, first1, first2, m0, r4); ATT_LOADT(k0, v0, d0); }
    { const TileD d1 = tile_desc(ntile > 1 ? 1 : 0, n1, n2, first1, first2, m0, r4); ATT_LOADT(k1, v1, d1); }
    s16x8 qf[4];
    { const bf16* qp = base + (size_t)qpos * INC + QOFF + head * HD + 8 * h;
#pragma unroll
      for (int d0 = 0; d0 < 4; ++d0) qf[d0] = __builtin_bit_cast(s16x8, *(const GAS u32x4*)(qp + 16 * d0)); }
    f32x16 o0 = {}, o1 = {}; float mrun = -1e30f, lrun = 0.f;
    const int g = lane >> 4, qq = (lane & 15) >> 2, pp = lane & 3;
    int kws[4];
#pragma unroll
    for (int j = 0; j < 4; ++j) { const int key = 8 * j + (lane >> 3); kws[j] = krp(key) * 128 + (((lane & 7) ^ (key & 7)) << 4); }
    const int vws = (lane >> 3) * 128 + (lane & 7) * 16;
    const int kfr = krp(q) * 128, kx = q & 7;
    const int vfr = (4 * h + qq) * 128 + (16 * (g & 1) + 4 * pp) * 2;
#define ATT2_MASK(S, D, T0) do { if ((D).mod4) { _Pragma("unroll") for (int r = 0; r < 16; ++r) { const int dd = (T0) - ((r & 3) + 8 * (r >> 2)); S[r] = (dd >= 0 && (dd & 3) == 0) ? S[r] : -INFINITY; mx = fmaxf(mx, S[r]); } } \
        else { const unsigned W_ = (unsigned)(D).W; _Pragma("unroll") for (int r = 0; r < 16; ++r) { const int dd = (T0) - ((r & 3) + 8 * (r >> 2)); S[r] = ((unsigned)dd <= W_) ? S[r] : -INFINITY; mx = fmaxf(mx, S[r]); } } } while (0)
#pragma unroll 1
    for (int p = 0; p < npair; ++p) {
        const bool nul1 = (2 * p + 1 >= ntile);
        const TileD dA = tile_desc(2 * p, n1, n2, first1, first2, m0, r4), dB = tile_desc(nul1 ? 2 * p : 2 * p + 1, n1, n2, first1, first2, m0, r4);
#pragma unroll
        for (int j = 0; j < 4; ++j) { *(LAS u32x4*)(wl + kws[j]) = k0[j]; *(LAS u32x4*)(wl + 4096 + vws + 1024 * j) = v0[j]; *(LAS u32x4*)(wl + 8192 + kws[j]) = k1[j]; *(LAS u32x4*)(wl + 12288 + vws + 1024 * j) = v1[j]; }
        { const int ua = (2 * p + 2 < ntile) ? 2 * p + 2 : ntile - 1, ub = (2 * p + 3 < ntile) ? 2 * p + 3 : ntile - 1;
          const TileD na = tile_desc(ua, n1, n2, first1, first2, m0, r4), nb = tile_desc(ub, n1, n2, first1, first2, m0, r4); ATT_LOADT(k0, v0, na); ATT_LOADT(k1, v1, nb); }
        f32x16 sA = {}, sB = {};
#pragma unroll
        for (int d0 = 0; d0 < 4; ++d0) { const int co = ((2 * d0 + h) ^ kx) << 4;
            sA = __builtin_amdgcn_mfma_f32_32x32x16_bf16(*(const LAS s16x8*)(wl + kfr + co), qf[d0], sA, 0, 0, 0);
            sB = __builtin_amdgcn_mfma_f32_32x32x16_bf16(*(const LAS s16x8*)(wl + 8192 + kfr + co), qf[d0], sB, 0, 0, 0); }
        const int t0A = (dA.sel ? bq2 : qpos) - dA.abase - 4 * h; const int t0B = nul1 ? -(1 << 20) : ((dB.sel ? bq2 : qpos) - dB.abase - 4 * h);
        float mx = -INFINITY;
        ATT2_MASK(sA, dA, t0A); ATT2_MASK(sB, dB, t0B);
        mx = fmaxf(mx, __shfl_xor(mx, 32));
        const float mnew = fmaxf(mrun, mx), alpha = __builtin_amdgcn_exp2f(mrun - mnew); mrun = mnew;
        float ps = 0.f;
#pragma unroll
        for (int r = 0; r < 16; ++r) { sA[r] = __builtin_amdgcn_exp2f(sA[r] - mnew); sB[r] = __builtin_amdgcn_exp2f(sB[r] - mnew); ps += sA[r] + sB[r]; }
        lrun = lrun * alpha + ps;
#pragma unroll
        for (int r = 0; r < 16; ++r) { o0[r] *= alpha; o1[r] *= alpha; }
        u32x4 pa0, pa1, pb0, pb1;
        pa0.x = pk2(sA[0], sA[1]); pa0.y = pk2(sA[2], sA[3]); pa0.z = pk2(sA[4], sA[5]); pa0.w = pk2(sA[6], sA[7]);
        pa1.x = pk2(sA[8], sA[9]); pa1.y = pk2(sA[10], sA[11]); pa1.z = pk2(sA[12], sA[13]); pa1.w = pk2(sA[14], sA[15]);
        pb0.x = pk2(sB[0], sB[1]); pb0.y = pk2(sB[2], sB[3]); pb0.z = pk2(sB[4], sB[5]); pb0.w = pk2(sB[6], sB[7]);
        pb1.x = pk2(sB[8], sB[9]); pb1.y = pk2(sB[10], sB[11]); pb1.z = pk2(sB[12], sB[13]); pb1.w = pk2(sB[14], sB[15]);
#pragma unroll
        for (int tt = 0; tt < 2; ++tt) { LAS const char* vb = wl + 4096 + 8192 * tt + vfr;
#pragma unroll
            for (int sstep = 0; sstep < 2; ++sstep) { const s16x8 pf = __builtin_bit_cast(s16x8, tt ? (sstep ? pb1 : pb0) : (sstep ? pa1 : pa0));
#pragma unroll
                for (int dh = 0; dh < 2; ++dh) {
                    const s16x4 lo = vtr(vb + (16 * sstep) * 128 + dh * 64), hi = vtr(vb + (16 * sstep + 8) * 128 + dh * 64);
                    const s16x8 vf = (s16x8){lo[0], lo[1], lo[2], lo[3], hi[0], hi[1], hi[2], hi[3]};
                    if (dh == 0) o0 = __builtin_amdgcn_mfma_f32_32x32x16_bf16(vf, pf, o0, 0, 0, 0);
                    else         o1 = __builtin_amdgcn_mfma_f32_32x32x16_bf16(vf, pf, o1, 0, 0, 0); } } }
    }
#undef ATT2_MASK
    const float inv = 1.0f / (lrun + __shfl_xor(lrun, 32));
    bf16* orow = YATT + (size_t)(b * SEQ + qpos) * AW + head * HD + 4 * h;
#pragma unroll
    for (int gq = 0; gq < 4; ++gq) {
        u32x2v a, c; a.x = pk2(o0[4 * gq] * inv, o0[4 * gq + 1] * inv); a.y = pk2(o0[4 * gq + 2] * inv, o0[4 * gq + 3] * inv);
        c.x = pk2(o1[4 * gq] * inv, o1[4 * gq + 1] * inv); c.y = pk2(o1[4 * gq + 2] * inv, o1[4 * gq + 3] * inv);
        *(u32x2v*)(orow + 8 * gq) = a; *(u32x2v*)(orow + 32 + 8 * gq) = c; }
}
}

struct Args { const float* in[15]; float* out; unsigned char* ws; int ph_lo, ph_hi; };
static_assert(sizeof(Args) == 15 * 8 + 8 + 8 + 8, "Args has no padding");

__global__ void __launch_bounds__(NWAVES * 64, 2) fwd(Args args) {
    extern __shared__ __attribute__((aligned(16))) unsigned char lds[];
    LAS unsigned char* L = (LAS unsigned char*)lds;
    volatile LAS unsigned* MISC = (volatile LAS unsigned*)(L + MISC_OFF);
    const int tid = threadIdx.x, lane = tid & 63, wave = __builtin_amdgcn_readfirstlane(tid >> 6);
    const int G = gridDim.x; const int bx = blockIdx.x; const int vcu = (G % 8 == 0) ? (bx % 8) * (G / 8) + bx / 8 : bx;
    unsigned char* ws = args.ws;
    gu32* ctl = (gu32*)(ws + WS_CTL);
    const float* x = args.in[0]; const float* mix_g = args.in[1]; const float* w_in = args.in[2]; const float* conv_w = args.in[3]; const float* conv_g = args.in[4];
    const float* attn_g = args.in[5]; const float* w_out = args.in[6]; const float* ffn_g = args.in[7]; const float* w_router = args.in[8]; const float* b_router = args.in[9];
    const float* w_gu = args.in[10]; const float* b_gu = args.in[11]; const float* w_dn = args.in[12]; const float* b_dn = args.in[13]; const float* fin_g = args.in[14];
    float* out = args.out;
    float* ROPE = (float*)(ws + WS_ROPE); unsigned char* GWF = ws + WS_ROPE + 256 * 1024;
    int* TOKE = (int*)(ws + WS_TOKE); int* TOKR = (int*)(ws + WS_TOKR); float* TOKG = (float*)(ws + WS_TOKG); int* LIST = (int*)(ws + WS_LIST);
    bf16* WIN = (bf16*)(ws + WS_WIN); bf16* WO = (bf16*)(ws + WS_WO); bf16* XN = (bf16*)(ws + WS_XN); bf16* PROJ = (bf16*)(ws + WS_PROJ); bf16* YATT = (bf16*)(ws + WS_YATT);
    bf16* MIXED = (bf16*)(ws + WS_MIXED); float* X1 = (float*)(ws + WS_X1); unsigned char* XN2 = ws + WS_XN2; unsigned char* XS = ws + WS_XS; unsigned char* ACT = ws + WS_ACT;
    bf16* YB = (bf16*)(ws + WS_Y); unsigned char* WGU = ws + WS_WGU; unsigned char* WDN = ws + WS_WDN;

    for (int u = tid; u < (LDS_BYTES - LDSCTL_OFF) / 4; u += NWAVES * 64) ((LAS unsigned*)(L + LDSCTL_OFF))[u] = 0u;
    __syncthreads();
    XcdBarrier bar; bar.bar = (unsigned*)(ctl + CW_BAR); bar.x = 0; bar.st = nullptr;
    if (MK_N_LAUNCHES == 1) bar = xcd_barrier_post((unsigned*)(ctl + CW_BAR), MISC + 8);
    const int lo = args.ph_lo, hi = args.ph_hi;
#define IN(k) (lo <= (k) && (k) < hi)
#define BOTH(k) (IN(k) && IN((k) + 1))
#define GRID_BAR() do { if (MK_N_LAUNCHES == 1) xcd_barrier(bar); } while (0)
    const int gw = vcu * NWAVES + wave, NGW = G * NWAVES;
    const bool side_on = (MK_N_LAUNCHES == 1) && (G == 256) && (SIDE_CONV != 0);

    if (IN(0)) for (int rep = 0; rep < REPS(0); ++rep) {
        AMP_BEGIN(0);
        LAS float* scr = (LAS float*)(L + wave * 16384);
        constexpr int I_IN = 32 * (INC / 32), I_O = 32 * (DM / 32);
        constexpr int NIT = I_IN + I_O;
        for (int it = gw; it < NIT; it += NGW) {
            int r = it;
            if (r < I_IN) { const int nblk = INC / 32, kb = r / nblk, nb = r % nblk; p0_transpose_item(w_in, INC, DM, WIN, 64 * kb, 32 * nb, 32 * nb, scr, lane); continue; } r -= I_IN;
            { const int nblk = DM / 32, kb = r / nblk, nb = r % nblk; p0_transpose_item(w_out, DM, DM, WO, 64 * kb, 32 * nb, 32 * nb, scr, lane); }
        }
        for (int i = gw * 64 + lane; i < SEQ * 8; i += NGW * 64) { const int pos = i >> 3, f = i & 7;
            const float inv_freq = exp2f(-(float)f * 0.125f * 18.931568569324174f);
            const float ang = (float)pos * inv_freq;
            const double a = (double)ang; const double k = rint(a * 0.15915494309189535); const float red = (float)(a - k * 6.283185307179586);
            ROPE[pos * 16 + f] = cosf(red); ROPE[pos * 16 + 8 + f] = sinf(red); }
        for (int i = gw * 64 + lane; i < 64 * 2 * 64; i += NGW * 64) { const int ln = i & 63, eb = (i >> 6) & 1, ks = i >> 7; const int e = 16 * eb + (ln & 15), k0 = 32 * ks + 8 * (ln >> 4);
            unsigned hi[4], lo[4];
#pragma unroll
            for (int j = 0; j < 4; ++j) { const float v0 = w_router[(size_t)(k0 + 2 * j) * NE + e] * ffn_g[k0 + 2 * j], v1 = w_router[(size_t)(k0 + 2 * j + 1) * NE + e] * ffn_g[k0 + 2 * j + 1];
                const unsigned h0 = f2bf(v0), h1 = f2bf(v1); hi[j] = h0 | (h1 << 16); lo[j] = pk2(v0 - __uint_as_float(h0 << 16), v1 - __uint_as_float(h1 << 16)); }
            v4u* dst = (v4u*)GWF + ((size_t)(ks * 2 + eb) * 2) * 64 + ln; dst[0] = (v4u){hi[0], hi[1], hi[2], hi[3]}; dst[64] = (v4u){lo[0], lo[1], lo[2], lo[3]}; }
        for (int m = gw; m < NTOK; m += NGW) {
            const GAS f32x4* xr = (const GAS f32x4*)(x + (size_t)m * DM) + lane; const GAS f32x4* gr = (const GAS f32x4*)mix_g + lane;
            f32x4 v[8]; float s = 0.f;
#pragma unroll
            for (int j = 0; j < 8; ++j) { v[j] = xr[64 * j]; s += (v[j].x * v[j].x + v[j].y * v[j].y) + (v[j].z * v[j].z + v[j].w * v[j].w); }
            const float rstd = 1.0f / sqrtf(wave_sum(s) * (1.0f / DM) + EPS);
            GAS u32x2v* o8 = (GAS u32x2v*)(XN + (size_t)m * DM) + lane;
#pragma unroll
            for (int j = 0; j < 8; ++j) { const f32x4 gg = gr[64 * j]; u32x2v o; o.x = pk2(v[j].x * rstd * gg.x, v[j].y * rstd * gg.y); o.y = pk2(v[j].z * rstd * gg.z, v[j].w * rstd * gg.w); o8[64 * j] = o; }
        }
        AMP_END(0);
        if (BOTH(0)) GRID_BAR();
    }

    const int ga = (side_on && (SIDE_CONV & 1)) ? 16 : 0, gb = (side_on && (SIDE_CONV & 2)) ? 32 : 0;
    const int cv_lo = ga < gb ? ga : gb, cv_hi = ga < gb ? gb : ga, cv_pn = ga < gb ? 256 : 128, cv_po = ga < gb ? 0 : 256;
    const int nconv_eff = (cv_hi - cv_lo) * cv_pn + (NE - cv_hi) * PER_E;
#define CV_MAP(ci) ((ci) < (cv_hi - cv_lo) * cv_pn ? (cv_lo + (ci) / cv_pn) * PER_E + cv_po + (ci) % cv_pn : (cv_hi + ((ci) - (cv_hi - cv_lo) * cv_pn) / PER_E) * PER_E + ((ci) - (cv_hi - cv_lo) * cv_pn) % PER_E)
#define RUN_P2(ATTW, QA, QC, TRIED0, STOPW, STOPN) do { \
        LAS char* vl = (LAS char*)(L + wave * 16384); \
        LAS unsigned char* T = L + wave * 16384; \
        int mode = (wave < (ATTW)) ? 0 : 1, tried = (TRIED0), aq = 0; const int xcc = (int)xb_xcc_id() & 7; \
        while (tried < 2) { \
            if (mode == 0) { \
                  \
                bool got = false; \
                while (aq < 8) { const int qx = (xcc + aq) & 7; int idx = 0; if (lane == 0) idx = (int)__hip_atomic_fetch_add(ctl + (QA) + 16 * qx, 1u, __ATOMIC_RELAXED, __HIP_MEMORY_SCOPE_AGENT); \
                    idx = __builtin_amdgcn_readfirstlane(idx); \
                    if (idx < 768) { const int it = 64 * (qx + 8 * (idx >> 6)) + (idx & 63); __builtin_amdgcn_s_setprio(3); att::ATT_ITEM(it, PROJ, YATT, vl, lane); __builtin_amdgcn_s_setprio(0); got = true; break; } \
                    ++aq; } \
                if (got) continue; \
            } else { \
                 \
                int it = 0; if (lane == 0) it = (int)__hip_atomic_fetch_add(ctl + (QC), 1u, __ATOMIC_RELAXED, __HIP_MEMORY_SCOPE_AGENT); \
                it = __builtin_amdgcn_readfirstlane(it); \
                if (it < nconv_eff) { \
                    ConvDesc cur = conv_decode(CV_MAP(it), w_gu, w_dn, WGU, WDN, lane); \
                    f32x4 ra[8], rb[8]; \
                    CV_LOAD(ra, cur, 0); \
                    bool stop = false; \
                    for (;;) { \
                        int nx = nconv_eff; if (!stop && lane == 0) nx = (int)__hip_atomic_fetch_add(ctl + (QC), 1u, __ATOMIC_RELAXED, __HIP_MEMORY_SCOPE_AGENT); \
                        unsigned sv = 0u; if ((STOPW) >= 0) sv = __hip_atomic_load(ctl + ((STOPW) >= 0 ? (STOPW) : 0), __ATOMIC_RELAXED, __HIP_MEMORY_SCOPE_AGENT); \
_Pragma("unroll 1") \
                        for (int g = 0; g < CV_NG - 2; g += 2) { CV_LOAD(rb, cur, g + 1); CV_PROC(ra, cur, g); CV_LOAD(ra, cur, g + 2); CV_PROC(rb, cur, g + 1); } \
                        CV_LOAD(rb, cur, CV_NG - 1); CV_PROC(ra, cur, CV_NG - 2); \
                        nx = __builtin_amdgcn_readfirstlane(nx); const bool more = nx < nconv_eff; \
                        const ConvDesc nd = conv_decode(CV_MAP(more ? nx : it), w_gu, w_dn, WGU, WDN, lane); \
                        CV_LOAD(ra, nd, 0);                                   \
                        CV_PROC(rb, cur, CV_NG - 1); \
                        if ((STOPW) >= 0) stop = (unsigned)__builtin_amdgcn_readfirstlane((int)sv) >= (unsigned)(STOPN); \
                        if (!more) break; \
                        cur = nd; it = nx; \
                    } \
                } \
            } \
            if (mode == 0 && (ATTW) < 8 && (ATTW) > 0 && ATT_NOFALL && wave < (ATTW) - ATT_JOIN) break;     \
            mode ^= 1; ++tried; \
        } \
    } while (0)
    if (IN(1)) {
        AMP_BEGIN(1);
        const bool split = (MK_N_LAUNCHES == 1) && (G == 256) && (SPLIT_P1 != 0);
        const bool conv_wg = split && (((bx >> 3) & 1) == 1);
        if (!conv_wg) {
            pg8::Gemm g{XN, WIN, NTOK, INC, DM}; pg8::StaticOrder S; S.init(NTOK, INC, split ? 128 : G, split ? (((bx >> 4) << 3) | (bx & 7)) : bx);
            pg8::EpiProj E{PROJ, ROPE, att::C2};
            if (side_on && (SIDE_CONV & 1)) { pg8::SideConv SD{w_gu, WGU, 4096, 128 * bx, 96, (unsigned)PART_OFF}; pg8::gemm_phase<pg8::EpiProj, pg8::StaticOrder, true, true, false, false, pg8::SideConv>(L, g, S, E, SD); }
            else pg8::gemm_phase<pg8::EpiProj, pg8::StaticOrder, true, true>(L, g, S, E);
            __syncthreads();
            if (tid == 0) __hip_atomic_fetch_add(ctl + CW_P1DONE, 1u, __ATOMIC_RELAXED, __HIP_MEMORY_SCOPE_AGENT);
        } else {
            RUN_P2(0, CW_ATTQ, CW_CONVQ, 1, CW_P1DONE, 128);
        }
        AMP_END(1);
        if (BOTH(1)) GRID_BAR();
    }

    if (IN(2)) {
        AMP_BEGIN(2);
        RUN_P2(ATT_WAVES, CW_ATTQ, CW_CONVQ, 0, -1, 0);
        AMP_END(2);
        if (BOTH(2)) GRID_BAR();
        if ((PROBE_MASK >> 10) & 1) { RUN_P2(0, CW_ATTQ, CW_CONVQ + 64, 0, -1, 0); GRID_BAR(); }
        if ((PROBE_MASK >> 12) & 1) {
            unsigned char* SCR = ws + (size_t)2048 * MiB;
            for (int itp = gw; itp < 2 * NE * 1024; itp += NGW) {
                const int isdn = itp >= NE * 1024; const int r = isdn ? itp - NE * 1024 : itp; const int e = r >> 10, kp = r & 1023; const int N = isdn ? 2048 : 4096;
                const float* s0 = (isdn ? w_dn + (size_t)e * 2048 * 2048 : w_gu + (size_t)e * 2048 * 4096) + (size_t)(2 * kp) * N + 4 * lane; const float* s1 = s0 + N;
                unsigned char* d = SCR + (isdn ? (size_t)NE * 1024 * 8192 + ((size_t)e * 1024 + kp) * 4096 : ((size_t)e * 1024 + kp) * 8192) + 8 * lane;
                for (int i0 = 0; i0 < N / 256; i0 += 8) {
                    f32x4 a[8], c[8];
#pragma unroll
                    for (int i = 0; i < 8; ++i) { a[i] = *(const GAS f32x4*)(s0 + 256 * (i0 + i)); c[i] = *(const GAS f32x4*)(s1 + 256 * (i0 + i)); }
#pragma unroll
                    for (int i = 0; i < 8; ++i) { u32x2v o; o.x = pk4_fp8_nc(64.f * a[i][0], 64.f * c[i][0], 64.f * a[i][1], 64.f * c[i][1]); o.y = pk4_fp8_nc(64.f * a[i][2], 64.f * c[i][2], 64.f * a[i][3], 64.f * c[i][3]);
                        *(GAS u32x2v*)(d + 512 * (i0 + i)) = o; }
                }
            }
            GRID_BAR();
        }
        if ((PROBE_MASK >> 14) & 1) { RUN_P2(ATT_WAVES, CW_ATTQ + 2048, CW_CONVQ + 192, 0, -1, 0); GRID_BAR(); }
        if ((PROBE_MASK >> 13) & 1) { RUN_P2(4, CW_ATTQ, CW_CONVQ + 128, 1, -1, 0); GRID_BAR(); }
        if ((PROBE_MASK >> 15) & 1) { for (;;) { int it = 0; if (lane == 0) it = (int)__hip_atomic_fetch_add(ctl + CW_ATTQ + 256 + 64, 1u, __ATOMIC_RELAXED, __HIP_MEMORY_SCOPE_AGENT); it = __builtin_amdgcn_readfirstlane(it); if (it >= att::NITEMS) break;
            att::item<1>(it, PROJ, (bf16*)(ws + (size_t)3000 * MiB), (LAS char*)(L + wave * 16384), lane); } GRID_BAR(); }
        if ((PROBE_MASK >> 16) & 1) { for (;;) { int it = 0; if (lane == 0) it = (int)__hip_atomic_fetch_add(ctl + CW_ATTQ + 256 + 128, 1u, __ATOMIC_RELAXED, __HIP_MEMORY_SCOPE_AGENT); it = __builtin_amdgcn_readfirstlane(it); if (it >= att::NITEMS) break;
            att::item<2>(it, PROJ, (bf16*)(ws + (size_t)3000 * MiB), (LAS char*)(L + wave * 16384), lane); } GRID_BAR(); }
        if ((PROBE_MASK >> 11) & 1) { RUN_P2(8, CW_ATTQ + 1024, CW_CONVQ, 0, -1, 0); GRID_BAR(); }
    }

    if (IN(3)) for (int rep = 0; rep < REPS(3); ++rep) {
        AMP_BEGIN(3);
        float cw0[8], cw1[8], cw2[8], cgq[8], agq[3][8];
#pragma unroll
        for (int j = 0; j < 8; ++j) { const int c = 8 * lane + j; cw0[j] = conv_w[c]; cw1[j] = conv_w[CW + c]; cw2[j] = conv_w[2 * CW + c]; cgq[j] = conv_g[c]; agq[0][j] = attn_g[c]; agq[1][j] = attn_g[512 + c]; agq[2][j] = attn_g[1024 + c]; }
#define P3_LOAD(A, CX, CC, CB, mm) do { const int sp_ = (mm) & (SEQ - 1); const bf16* ya_ = YATT + (size_t)(mm) * AW + 8 * lane; const bf16* pr_ = PROJ + (size_t)(mm) * INC + 8 * lane; \
            _Pragma("unroll") for (int j = 0; j < 3; ++j) A[j] = *(const v4u*)(ya_ + 512 * j); \
            _Pragma("unroll") for (int d = 0; d < 3; ++d) { const int back = 2 - d; const bool ok_ = sp_ >= back; const bf16* q_ = ok_ ? pr_ - (size_t)back * INC : pr_; CX[d] = *(const v4u*)q_; CC[d] = *(const v4u*)(q_ + 2 * CW); \
                if (!ok_) { CX[d] = (v4u){0u, 0u, 0u, 0u}; } } \
            CB = *(const v4u*)(pr_ + CW); } while (0)
        v4u a[3], cx[3], cc[3], cb;
        if (gw < NTOK) P3_LOAD(a, cx, cc, cb, gw);
        for (int m = gw; m < NTOK; m += NGW) {
            v4u na[3], ncx[3], ncc[3], ncb; const int mn = (m + NGW < NTOK) ? m + NGW : m;
            P3_LOAD(na, ncx, ncc, ncb, mn);
            float u[3][8];
#pragma unroll
            for (int d = 0; d < 3; ++d) {
                u[d][0] = bf_lo(cx[d].x) * bf_lo(cc[d].x); u[d][1] = bf_hi(cx[d].x) * bf_hi(cc[d].x); u[d][2] = bf_lo(cx[d].y) * bf_lo(cc[d].y); u[d][3] = bf_hi(cx[d].y) * bf_hi(cc[d].y);
                u[d][4] = bf_lo(cx[d].z) * bf_lo(cc[d].z); u[d][5] = bf_hi(cx[d].z) * bf_hi(cc[d].z); u[d][6] = bf_lo(cx[d].w) * bf_lo(cc[d].w); u[d][7] = bf_hi(cx[d].w) * bf_hi(cc[d].w); }
            float bb[8] = {bf_lo(cb.x), bf_hi(cb.x), bf_lo(cb.y), bf_hi(cb.y), bf_lo(cb.z), bf_hi(cb.z), bf_lo(cb.w), bf_hi(cb.w)};
            float y[8]; float s = 0.f;
#pragma unroll
            for (int j = 0; j < 8; ++j) { const float acc = cw0[j] * u[0][j] + cw1[j] * u[1][j] + cw2[j] * u[2][j]; y[j] = bb[j] * acc; s += y[j] * y[j]; }
            float s2 = 0.f;
#pragma unroll
            for (int j = 0; j < 3; ++j) {
                const float f0 = bf_lo(a[j].x), f1 = bf_hi(a[j].x), f2 = bf_lo(a[j].y), f3 = bf_hi(a[j].y), f4 = bf_lo(a[j].z), f5 = bf_hi(a[j].z), f6 = bf_lo(a[j].w), f7 = bf_hi(a[j].w);
                s2 += (f0 * f0 + f1 * f1) + (f2 * f2 + f3 * f3) + (f4 * f4 + f5 * f5) + (f6 * f6 + f7 * f7); }
#pragma unroll
            for (int o = 1; o < 64; o <<= 1) { s += __shfl_xor(s, o); s2 += __shfl_xor(s2, o); }
            const float rc = 1.0f / sqrtf(s * (1.0f / CW) + EPS), ra = 1.0f / sqrtf(s2 * (1.0f / AW) + EPS);
            { v4u o;
              o.x = pk2(y[0] * rc * cgq[0], y[1] * rc * cgq[1]); o.y = pk2(y[2] * rc * cgq[2], y[3] * rc * cgq[3]); o.z = pk2(y[4] * rc * cgq[4], y[5] * rc * cgq[5]); o.w = pk2(y[6] * rc * cgq[6], y[7] * rc * cgq[7]);
              *(v4u*)(MIXED + (size_t)m * DM + 8 * lane) = o; }
#pragma unroll
            for (int j = 0; j < 3; ++j) { const float* gq = agq[j]; v4u o;
                o.x = pk2(bf_lo(a[j].x) * ra * gq[0], bf_hi(a[j].x) * ra * gq[1]); o.y = pk2(bf_lo(a[j].y) * ra * gq[2], bf_hi(a[j].y) * ra * gq[3]);
                o.z = pk2(bf_lo(a[j].z) * ra * gq[4], bf_hi(a[j].z) * ra * gq[5]); o.w = pk2(bf_lo(a[j].w) * ra * gq[6], bf_hi(a[j].w) * ra * gq[7]);
                *(v4u*)(MIXED + (size_t)m * DM + CW + 512 * j + 8 * lane) = o; }
#pragma unroll
            for (int j = 0; j < 3; ++j) { a[j] = na[j]; cx[j] = ncx[j]; cc[j] = ncc[j]; }
            cb = ncb;
        }
#undef P3_LOAD
        AMP_END(3);
        if (BOTH(3)) GRID_BAR();
    }

    if (IN(4)) for (int rep = 0; rep < REPS(4); ++rep) {
        AMP_BEGIN(4);
        pg8::Gemm g{MIXED, WO, NTOK, DM, DM}; pg8::StaticOrder S; S.init(NTOK, DM, G, (int)blockIdx.x);
        pg8::EpiResF32 E{x, X1, DM};
        if (side_on && (SIDE_CONV & 1)) { pg8::SideConv SD{w_gu, WGU, 4096, 128 * bx + 96, 32, (unsigned)PART_OFF}; pg8::gemm_phase<pg8::EpiResF32, pg8::StaticOrder, false, true, false, false, pg8::SideConv>(L, g, S, E, SD); }
        else pg8::gemm_phase<pg8::EpiResF32, pg8::StaticOrder, false, true>(L, g, S, E);
        AMP_END(4);
        if (BOTH(4)) GRID_BAR();
    }

    if (IN(5)) for (int rep = 0; rep < REPS(5); ++rep) {
        AMP_BEGIN(5);
        const int cwc = CW_CNT + 2048 * rep; int* TOKE_ = TOKE + rep * (1 << 20); int* TOKR_ = TOKR + rep * (1 << 20); float* TOKG_ = TOKG + rep * (1 << 20); unsigned char* XS_ = XS + (size_t)rep * ((size_t)2752 * MiB - WS_XS);
        LAS float* X1L = (LAS float*)L; constexpr int XP = 2052;
        LAS float* PART = (LAS float*)(L + PART_OFF);
        const int e_ = lane & 31, kbase = 256 * wave + 128 * (lane >> 5);
        LAS int* LC = (LAS int*)(L + LDSCTL_OFF + 2048); LAS int* LB = (LAS int*)(L + LDSCTL_OFF + 2304);
        LAS int* AE = (LAS int*)(L + LDSCTL_OFF + 4096); LAS int* ALR = AE + 128; LAS float* AG = (LAS float*)(AE + 256); LAS float* RS = (LAS float*)(AE + 384);
        for (int blk = vcu; blk < NTOK / 32; blk += G) {
        if (tid < 32) LC[tid] = 0;
        __syncthreads();
        const int grp0 = 2 * blk;
#define P5_DMA(step) do { _Pragma("unroll") for (int r = 0; r < 2; ++r) _Pragma("unroll") for (int c = 0; c < 8; ++c) \
            __builtin_amdgcn_global_load_lds((const unsigned*)(X1 + (size_t)((grp0 + (step)) * 16 + 2 * wave + r) * DM + c * 256 + lane * 4), (LAS unsigned*)(L + (2 * wave + r) * (XP * 4) + c * 1024), 16, 0, 0); \
            asm volatile("s_waitcnt vmcnt(0)" ::: "memory"); __syncthreads(); } while (0)
        for (int step = 0; step < 2; ++step) {
            if (step) __syncthreads();
            if (tid < 32) LC[tid] = 0;
            P5_DMA(step);
            {
                typedef short s16x8b __attribute__((ext_vector_type(8)));
                f32x4 acc0 = {0.f, 0.f, 0.f, 0.f}, acc1 = acc0;
                const int tcol = lane & 15, kq = lane >> 4;
#pragma unroll
                for (int s8 = 0; s8 < 8; ++s8) { const int ks = 8 * wave + s8;
                    const LAS f32x4* xp = (const LAS f32x4*)(X1L + tcol * XP + 32 * ks + 8 * kq); const f32x4 xa = xp[0], xb = xp[1];
                    unsigned xh[4], xl[4];
                    { const unsigned h0 = f2bf(xa.x), h1 = f2bf(xa.y), h2 = f2bf(xa.z), h3 = f2bf(xa.w), h4 = f2bf(xb.x), h5 = f2bf(xb.y), h6 = f2bf(xb.z), h7 = f2bf(xb.w);
                      xh[0] = h0 | (h1 << 16); xh[1] = h2 | (h3 << 16); xh[2] = h4 | (h5 << 16); xh[3] = h6 | (h7 << 16);
                      xl[0] = pk2(xa.x - __uint_as_float(h0 << 16), xa.y - __uint_as_float(h1 << 16)); xl[1] = pk2(xa.z - __uint_as_float(h2 << 16), xa.w - __uint_as_float(h3 << 16));
                      xl[2] = pk2(xb.x - __uint_as_float(h4 << 16), xb.y - __uint_as_float(h5 << 16)); xl[3] = pk2(xb.z - __uint_as_float(h6 << 16), xb.w - __uint_as_float(h7 << 16)); }
                    const s16x8b bxh = __builtin_bit_cast(s16x8b, (v4u){xh[0], xh[1], xh[2], xh[3]}), bxl = __builtin_bit_cast(s16x8b, (v4u){xl[0], xl[1], xl[2], xl[3]});
                    const v4u* wf = (const v4u*)GWF + (size_t)(ks * 4) * 64 + lane;
                    const s16x8b w0h = __builtin_bit_cast(s16x8b, wf[0]), w0l = __builtin_bit_cast(s16x8b, wf[64]), w1h = __builtin_bit_cast(s16x8b, wf[128]), w1l = __builtin_bit_cast(s16x8b, wf[192]);
                    acc0 = __builtin_amdgcn_mfma_f32_16x16x32_bf16(w0h, bxh, acc0, 0, 0, 0); acc0 = __builtin_amdgcn_mfma_f32_16x16x32_bf16(w0l, bxh, acc0, 0, 0, 0); acc0 = __builtin_amdgcn_mfma_f32_16x16x32_bf16(w0h, bxl, acc0, 0, 0, 0);
                    acc1 = __builtin_amdgcn_mfma_f32_16x16x32_bf16(w1h, bxh, acc1, 0, 0, 0); acc1 = __builtin_amdgcn_mfma_f32_16x16x32_bf16(w1l, bxh, acc1, 0, 0, 0); acc1 = __builtin_amdgcn_mfma_f32_16x16x32_bf16(w1h, bxl, acc1, 0, 0, 0); }
                *(LAS f32x4*)(PART + (wave * 16 + tcol) * 32 + 4 * kq) = acc0; *(LAS f32x4*)(PART + (wave * 16 + tcol) * 32 + 16 + 4 * kq) = acc1;
            }
            __syncthreads();
            {
                float tvv[2][4]; int tii[2][4];
#pragma unroll
                for (int r = 0; r < 2; ++r) { const int tl = 2 * wave + r;
                    const LAS f32x4* hp = (const LAS f32x4*)(X1L + tl * XP + 32 * lane); float ss = 0.f;
#pragma unroll
                    for (int j = 0; j < 8; ++j) { const f32x4 a = hp[j]; ss += (a.x * a.x + a.y * a.y) + (a.z * a.z + a.w * a.w); }
                    const float rstd = 1.0f / sqrtf(wave_sum(ss) * (1.0f / DM) + EPS); if (lane == 0) RS[step * 16 + tl] = rstd;
                    float lg = -INFINITY;
                    if (lane < 32) { float s = 0.f;
#pragma unroll
                        for (int w = 0; w < 8; ++w) s += PART[(w * 16 + tl) * 32 + lane]; lg = s * rstd + b_router[lane]; }
                    int rank = 0; const int lgb = __float_as_int(lg);
#pragma unroll
                    for (int j = 0; j < 32; ++j) { const float vj = __int_as_float(__builtin_amdgcn_readlane(lgb, j)); rank += (vj > lg || (vj == lg && j < lane)) ? 1 : 0; }
#pragma unroll
                    for (int k = 0; k < 4; ++k) { const unsigned long long mk = __builtin_amdgcn_ballot_w64(lane < 32 && rank == k); const int idx = (int)__builtin_ctzll(mk);
                        tii[r][k] = idx; tvv[r][k] = __int_as_float(__builtin_amdgcn_readlane(lgb, idx)); } }
                if (lane < 8) { const int r = lane >> 2, k = lane & 3;
                    const float t0 = r ? tvv[1][0] : tvv[0][0], t1 = r ? tvv[1][1] : tvv[0][1], t2 = r ? tvv[1][2] : tvv[0][2], t3 = r ? tvv[1][3] : tvv[0][3];
                    const float e1 = __expf(t1 - t0), e2 = __expf(t2 - t0), e3 = __expf(t3 - t0); const float den = 1.0f / (1.0f + e1 + e2 + e3);
                    const int i0 = r ? tii[1][0] : tii[0][0], i1 = r ? tii[1][1] : tii[0][1], i2 = r ? tii[1][2] : tii[0][2], i3 = r ? tii[1][3] : tii[0][3];
                    const int ee = k == 0 ? i0 : k == 1 ? i1 : k == 2 ? i2 : i3; const float gg = (k == 0 ? 1.0f : k == 1 ? e1 : k == 2 ? e2 : e3) * den;
                    const int ai = (step * 16 + 2 * wave + r) * 4 + k;
                    AE[ai] = ee; ALR[ai] = __hip_atomic_fetch_add(LC + ee, 1, __ATOMIC_RELAXED, __HIP_MEMORY_SCOPE_WORKGROUP); AG[ai] = gg; }
            }
            __syncthreads();
            if (tid < 32) { const int c = LC[tid]; LB[tid] = c ? (int)__hip_atomic_fetch_add(ctl + cwc + 64 * tid, (unsigned)c, __ATOMIC_RELAXED, __HIP_MEMORY_SCOPE_AGENT) : 0; }
            __syncthreads();
#pragma unroll
            for (int r = 0; r < 2; ++r) { const int tl = 2 * wave + r; const int tok = (grp0 + step) * 16 + tl; v4u w0, w1;
                { const float sc = 16.f * RS[step * 16 + tl]; const LAS f32x4* hp = (const LAS f32x4*)(X1L + tl * XP + 32 * lane); const f32x4* gp = (const f32x4*)(ffn_g + 32 * lane);
                    { const f32x4 a = hp[0] * gp[0] * sc, c = hp[1] * gp[1] * sc, d = hp[2] * gp[2] * sc, f = hp[3] * gp[3] * sc;
                      w0.x = pg8::pk4_fp8(a.x, a.y, a.z, a.w); w0.y = pg8::pk4_fp8(c.x, c.y, c.z, c.w); w0.z = pg8::pk4_fp8(d.x, d.y, d.z, d.w); w0.w = pg8::pk4_fp8(f.x, f.y, f.z, f.w); }
                    { const f32x4 a = hp[4] * gp[4] * sc, c = hp[5] * gp[5] * sc, d = hp[6] * gp[6] * sc, f = hp[7] * gp[7] * sc;
                      w1.x = pg8::pk4_fp8(a.x, a.y, a.z, a.w); w1.y = pg8::pk4_fp8(c.x, c.y, c.z, c.w); w1.z = pg8::pk4_fp8(d.x, d.y, d.z, d.w); w1.w = pg8::pk4_fp8(f.x, f.y, f.z, f.w); } }
#pragma unroll
                for (int k = 0; k < 4; ++k) { const int ai = (step * 16 + tl) * 4 + k; const int ee = AE[ai], rank = LB[ee] + ALR[ai];
                    GAS v4u* dst = (GAS v4u*)(XS_ + ((size_t)ee * NTOK + rank) * DM + 32 * lane); dst[0] = w0; dst[1] = w1;
                    if (lane == 0) { TOKE_[tok * 4 + k] = ee; TOKR_[tok * 4 + k] = rank; TOKG_[tok * 4 + k] = AG[ai]; } } }
        }
        __syncthreads();
        }
#undef P5_DMA
        AMP_END(5);
        if (BOTH(5)) GRID_BAR();
    }

    LAS int* TS = (LAS int*)(L + TAB_TS); LAS int* CN = (LAS int*)(L + TAB_CN);
    if (hi > 6) {
        if (tid < NE) CN[tid] = (int)__hip_atomic_load(ctl + CW_CNT + 64 * tid, __ATOMIC_RELAXED, __HIP_MEMORY_SCOPE_AGENT);
        __syncthreads();
        if (tid == 0) { int acc = 0, acch = 0; for (int e = 0; e < NE; ++e) { const int c = CN[e]; TS[e] = acc; TS[33 + e] = acch;
            const int ntl = (c + 255) >> 8, hf = (c > 0 && c - ((ntl - 1) << 8) <= 128) ? 1 : 0; acc += ntl - hf; acch += hf; } TS[NE] = acc; TS[33 + NE] = acch; }
        __syncthreads();
    }


    if (IN(7)) for (int rep = 0; rep < REPS(7); ++rep) {
        AMP_BEGIN(7);
        {
        pg8::GroupedOrder S{(const PG8_LAS int*)TS, (const PG8_LAS int*)CN, 16, G, vcu, (long)1024 * 4096 * 2, 128 * 2};
        pg8::EpiSwiGLU E{ACT, b_gu};
        pg8::Gemm g{(const pg8::bf16_t*)XS, (const pg8::bf16_t*)WGU, MAXSLOT, NE * 4096, DM / 2, 4096, 2048 * 2};
        if (side_on && (SIDE_CONV & 2)) { pg8::SideConv SD{w_dn, WDN, 2048, 128 * bx, 128, (unsigned)PART_OFF}; pg8::gemm_phase<pg8::EpiSwiGLU, pg8::GroupedOrder, true, true, true, true, pg8::SideConv>(L, g, S, E, SD); }
        else pg8::gemm_phase<pg8::EpiSwiGLU, pg8::GroupedOrder, true, true, true, true>(L, g, S, E); }
        AMP_END(7);
        if (BOTH(7)) GRID_BAR();
    }

    if (IN(8)) for (int rep = 0; rep < REPS(8); ++rep) {
        AMP_BEGIN(8);
        {
        pg8::GroupedOrder S{(const PG8_LAS int*)TS, (const PG8_LAS int*)CN, 8, G, vcu, (long)1024 * 2048 * 2, 256 * 2};
        pg8::EpiFp8Y E{(unsigned char*)YB, 1.0f / (pg8::FP8_W_SCALE * pg8::FP8_ACT_SCALE), b_dn};
        pg8::Gemm g{(const pg8::bf16_t*)ACT, (const pg8::bf16_t*)WDN, MAXSLOT, NE * 2048, DE / 2, 2048, 128 * 2};
        pg8::gemm_phase<pg8::EpiFp8Y, pg8::GroupedOrder, true, true, true, true>(L, g, S, E); }
        AMP_END(8);
        if (BOTH(8)) GRID_BAR();
    }

    if (IN(9)) for (int rep = 0; rep < REPS(9); ++rep) {
        AMP_BEGIN(9);
        unsigned poison = __hip_atomic_load(ctl + CW_BAR + XB_TMO, RLX_AGENT) != 0u;
        const f32x4 g8[8] = {((const GAS f32x4*)fin_g + lane)[0], ((const GAS f32x4*)fin_g + lane)[64], ((const GAS f32x4*)fin_g + lane)[128], ((const GAS f32x4*)fin_g + lane)[192], ((const GAS f32x4*)fin_g + lane)[256], ((const GAS f32x4*)fin_g + lane)[320], ((const GAS f32x4*)fin_g + lane)[384], ((const GAS f32x4*)fin_g + lane)[448]};
#define P9_IDX(TE, TR, TG, mm) do { TE = *(const int4*)(TOKE + (mm) * 4); TR = *(const int4*)(TOKR + (mm) * 4); TG = *(const f32x4*)(TOKG + (mm) * 4); } while (0)
#define P9_ROWS(V, YY, TE, TR, mm) do { const GAS f32x4* xr_ = (const GAS f32x4*)(X1 + (size_t)(mm) * DM) + lane; _Pragma("unroll") for (int j = 0; j < 8; ++j) V[j] = __builtin_nontemporal_load(xr_ + 64 * j); \
            const int ee_[4] = {TE.x, TE.y, TE.z, TE.w}, rr_[4] = {TR.x, TR.y, TR.z, TR.w}; \
            _Pragma("unroll") for (int k = 0; k < TOPK; ++k) { const GAS unsigned* yr_ = (const GAS unsigned*)((const unsigned char*)YB + ((size_t)ee_[k] * NTOK + rr_[k]) * DM) + lane; \
                _Pragma("unroll") for (int j = 0; j < 8; ++j) YY[k][j] = __builtin_nontemporal_load(yr_ + 64 * j); } } while (0)
        int4 te0, tr0, te1, tr1; f32x4 tg0, tg1; f32x4 v[8]; unsigned yy[4][8];
        if (gw < NTOK) { P9_IDX(te0, tr0, tg0, gw); const int m1 = (gw + NGW < NTOK) ? gw + NGW : gw; P9_IDX(te1, tr1, tg1, m1); P9_ROWS(v, yy, te0, tr0, gw); }
        for (int m = gw; m < NTOK; m += NGW) {
            const int mn = (m + NGW < NTOK) ? m + NGW : m, mnn = (m + 2 * NGW < NTOK) ? m + 2 * NGW : mn;
            int4 te2, tr2; f32x4 tg2; P9_IDX(te2, tr2, tg2, mnn);
            f32x4 nv[8]; unsigned nyy[4][8]; P9_ROWS(nv, nyy, te1, tr1, mn);
            const f32x4 tg = tg0;
#pragma unroll
            for (int k = 0; k < TOPK; ++k) { const float gt = tg[k] * (1.0f / 16.0f);
#pragma unroll
                for (int j = 0; j < 8; ++j) { typedef float f32x2y __attribute__((ext_vector_type(2))); const f32x2y lo = __builtin_amdgcn_cvt_pk_f32_fp8((int)yy[k][j], false), hi = __builtin_amdgcn_cvt_pk_f32_fp8((int)yy[k][j], true);
                    v[j].x += gt * lo.x; v[j].y += gt * lo.y; v[j].z += gt * hi.x; v[j].w += gt * hi.y; } }
            float s = 0.f;
#pragma unroll
            for (int j = 0; j < 8; ++j) s += (v[j].x * v[j].x + v[j].y * v[j].y) + (v[j].z * v[j].z + v[j].w * v[j].w);
            float rstd = 1.0f / sqrtf(wave_sum(s) * (1.0f / DM) + EPS);
            if (poison) rstd = __builtin_nanf("");
            GAS f32x4* orow = (GAS f32x4*)(out + (size_t)m * DM) + lane;
#pragma unroll
            for (int j = 0; j < 8; ++j) { const f32x4 gg = g8[j]; f32x4 o; o.x = v[j].x * rstd * gg.x; o.y = v[j].y * rstd * gg.y; o.z = v[j].z * rstd * gg.z; o.w = v[j].w * rstd * gg.w; __builtin_nontemporal_store(o, orow + 64 * j); }
#pragma unroll
            for (int j = 0; j < 8; ++j) { v[j] = nv[j];
#pragma unroll
                for (int k = 0; k < TOPK; ++k) yy[k][j] = nyy[k][j]; }
            te0 = te1; tr0 = tr1; tg0 = tg1; te1 = te2; tr1 = tr2; tg1 = tg2;
        }
#undef P9_IDX
#undef P9_ROWS
        AMP_END(9);
    }
#undef IN
#undef BOTH
#undef GRID_BAR
}

extern "C" void kernel_launch(void* const* d_in, const int* in_sizes, int n_in, void* d_out, int out_size, void* d_ws, size_t ws_size, hipStream_t stream) {
    static int grid = 0;
    if (grid == 0) {
        if (n_in != 15 || in_sizes[0] != NTOK * DM || out_size != NTOK * DM || ws_size < WS_END) { fprintf(stderr, "kernel_launch: unexpected shapes / workspace (n_in %d, ws %zu)\n", n_in, ws_size); grid = -1; return; }
        int dev = 0, cus = 0, per_cu = 0;
        if (hipGetDevice(&dev) != hipSuccess || hipDeviceGetAttribute(&cus, hipDeviceAttributeMultiprocessorCount, dev) != hipSuccess) { grid = -1; return; }
        if (hipFuncSetAttribute((const void*)fwd, hipFuncAttributeMaxDynamicSharedMemorySize, LDS_BYTES) != hipSuccess) { fprintf(stderr, "kernel_launch: hipFuncSetAttribute failed\n"); grid = -1; return; }
        if (hipOccupancyMaxActiveBlocksPerMultiprocessor(&per_cu, (const void*)fwd, NWAVES * 64, LDS_BYTES) != hipSuccess || per_cu < 1) fprintf(stderr, "kernel_launch: occupancy query says %d\n", per_cu);
        (void)hipGetLastError();
        grid = cus;
    }
    if (grid < 0) return;
    if (hipMemsetAsync((char*)d_ws + WS_CTL, 0, CTL_ZERO_BYTES, stream) != hipSuccess) return;
    Args a{};
    for (int i = 0; i < 15; ++i) a.in[i] = (const float*)d_in[i];
    a.out = (float*)d_out; a.ws = (unsigned char*)d_ws;
    if (MK_N_LAUNCHES == 1) { a.ph_lo = 0; a.ph_hi = NPH; hipLaunchKernelGGL(fwd, dim3(grid), dim3(NWAVES * 64), LDS_BYTES, stream, a); }
    else { for (int p = 0; p < NPH; ++p) { a.ph_lo = p; a.ph_hi = p + 1; hipLaunchKernelGGL(fwd, dim3(grid), dim3(NWAVES * 64), LDS_BYTES, stream, a); } }
    const hipError_t le = hipPeekAtLastError();
    if (le != hipSuccess) fprintf(stderr, "kernel_launch: launch failed: %s\n", hipGetErrorName(le));
}
```

```cpp
#include <hip/hip_runtime.h>
constexpr int PWG = 8448;
constexpr int PINC = 6272;
#include <cstdio>
#include <cstdint>
namespace pg8 {
#define PG8_LAS __attribute__((address_space(3)))
typedef unsigned short bf16_t;
typedef short bf16x8 __attribute__((ext_vector_type(8)));
typedef float f32x4 __attribute__((ext_vector_type(4)));
typedef unsigned u32x4 __attribute__((ext_vector_type(4)));
constexpr int BM = 256, BK = 64, HALF = 128, HTB = HALF * BK * 2  , STAGE_BYTES = 8 * HTB, NXCD = 8, WGM = 8;

__host__ __device__ __forceinline__ int lds_byte(int r, int c) { const int st = (r >> 4) * 2 + (c >> 5), rr = r & 15, cc = c & 31, ob = rr * 64 + cc * 2; return st * 1024 + (ob ^ (((ob >> 9) & 1) << 5)); }
__host__ __device__ __forceinline__ void stage_rc(int b, int& R, int& C) { const int st = b / 1024, sb = b % 1024, swz = sb ^ (((sb >> 9) & 1) << 5); R = (st >> 1) * 16 + swz / 64; C = (st & 1) * 32 + (swz % 64) / 2; }
__host__ __device__ __forceinline__ int perm32(int rho) { const int n = rho >> 4, i = rho & 15; return 8 * (i >> 2) + 4 * n + (i & 3); }

struct Unit { int pm, pn, e, cn, rows; long boff; };
struct Gemm { const bf16_t* A; const bf16_t* Bt; int M, N, K; int b_ntot, b_hstep; };

struct StaticOrder {
    int nM, nN, nwg, G, c;
    __host__ __device__ void init(int M, int N, int G_, int c_) { nM = M / BM; nN = N / BM; nwg = nM * nN; G = G_; c = c_; }
    __host__ __device__ bool next(int i, Unit& u) const {
        const long L = (long)i * G + c; if (L >= nwg) return false;
        int wgid = (int)L; { const int q = nwg / NXCD, r = nwg % NXCD, xcd = wgid % NXCD, off = wgid / NXCD; wgid = (xcd < r ? xcd * (q + 1) : r * (q + 1) + (xcd - r) * q) + off; }
        const int nig = WGM * nN, gid = wgid / nig, fm = gid * WGM, gsz = (nM - fm) < WGM ? (nM - fm) : WGM;
        u.pm = fm + ((wgid % nig) % gsz); u.pn = (wgid % nig) / gsz; u.e = 0; u.cn = u.pn; u.rows = BM; u.boff = 0; return true;
    }
    __device__ __forceinline__ void a_ready(const Unit&) const {}
    __device__ __forceinline__ void done(const Unit&) const {}
};
struct GroupedOrder {
    const PG8_LAS int* TS; const PG8_LAS int* CN; int nN, G, v; long b_estride; int b_cnstep;
    __device__ __forceinline__ bool next(int i, Unit& u) const {
        const PG8_LAS int* TH = TS + 33;
        const int U = i * G + v; const int FT = __builtin_amdgcn_readfirstlane(TS[32] * nN), total = FT + __builtin_amdgcn_readfirstlane(TH[32] * nN); if (U >= total) return false;
        int e = 0, pn, rt;
        if (U < FT) {
#pragma unroll 1
            for (int j = 1; j < 32; ++j) e += (TS[j] * nN <= U) ? 1 : 0;
            const int t0 = TS[e], nt = TS[e + 1] - t0, loc = U - t0 * nN; pn = loc / nt; rt = loc - pn * nt;
        } else { const int U2 = U - FT;
#pragma unroll 1
            for (int j = 1; j < 32; ++j) e += (TH[j] * nN <= U2) ? 1 : 0;
            pn = U2 - TH[e] * nN; rt = TS[e + 1] - TS[e]; }
        const int left = CN[e] - rt * BM;
        u.pm = __builtin_amdgcn_readfirstlane(e * 32 + rt); u.pn = __builtin_amdgcn_readfirstlane(e * nN + pn); u.e = __builtin_amdgcn_readfirstlane(e); u.cn = __builtin_amdgcn_readfirstlane(pn);
        u.rows = __builtin_amdgcn_readfirstlane(left < BM ? left : BM); u.boff = (long)u.e * b_estride + (long)u.cn * b_cnstep; return true;
    }
    __device__ __forceinline__ void a_ready(const Unit&) const {}
    __device__ __forceinline__ void done(const Unit&) const {}
};

__device__ __forceinline__ unsigned cvt_pk_bf16(float lo, float hi) { unsigned r; asm volatile("v_cvt_pk_bf16_f32 %0, %1, %2" : "=v"(r) : "v"(lo), "v"(hi)); return r; }

struct EpiBf16Plain {
    static constexpr bool PERM = true, AFTER_DRAIN = false;
    bf16_t* O; int ldc; float sc; const float* bias;
    __device__ __forceinline__ void operator()(const f32x4 (&acc)[2][2][4][2], const Unit& u, int wr, int wc, int fr, int fq) const {
        const int row0 = u.pm * BM + wr * 64 + fr, col0 = u.cn * BM + wc * 32 + 8 * fq;
        f32x4 bv[2][2];
#pragma unroll
        for (int bj = 0; bj < 2; ++bj)
#pragma unroll
            for (int n = 0; n < 2; ++n) bv[bj][n] = bias ? *(const f32x4*)(bias + (size_t)u.e * ldc + col0 + bj * HALF + 4 * n) : (f32x4){0.f, 0.f, 0.f, 0.f};
#pragma unroll
        for (int ai = 0; ai < 2; ++ai) { if (ai == 1 && u.rows <= HALF) break;
#pragma unroll
            for (int m = 0; m < 4; ++m) { bf16_t* rowp = O + (size_t)(row0 + ai * HALF + m * 16) * ldc + col0;
#pragma unroll
                for (int bj = 0; bj < 2; ++bj) { const f32x4 v0 = acc[ai][bj][m][0] * sc + bv[bj][0], v1 = acc[ai][bj][m][1] * sc + bv[bj][1];
                    u32x4 w; w.x = cvt_pk_bf16(v0[0], v0[1]); w.y = cvt_pk_bf16(v0[2], v0[3]); w.z = cvt_pk_bf16(v1[0], v1[1]); w.w = cvt_pk_bf16(v1[2], v1[3]);
                    *(u32x4*)(rowp + bj * HALF) = w; } } }
    }
};
struct EpiProj {
    static constexpr bool PERM = true, AFTER_DRAIN = false;
    bf16_t* O; const float* rope; float qscale;
    __device__ __forceinline__ void operator()(const f32x4 (&acc)[2][2][4][2], const Unit& u, int wr, int wc, int fr, int fq) const {
        const int row0 = u.pm * BM + wr * 64 + fr, col0 = u.cn * BM + wc * 32 + 8 * fq;
        const bool isq = (u.cn >= 6 && u.cn < 12), isk = (u.cn >= 12 && u.cn < 18);
        const bool rot = (isq || isk) && ((wc & 1) == 0);
        const float sc = isq ? qscale : 1.0f;
        const float sg = (fq == 0) ? -1.0f : 1.0f;
        const bool act = fq < 2;
#pragma unroll
        for (int ai = 0; ai < 2; ++ai)
#pragma unroll
            for (int m = 0; m < 4; ++m) { const int row = row0 + ai * HALF + m * 16; bf16_t* rowp = O + (size_t)row * PINC + col0;
                f32x4 c0 = {1.f, 1.f, 1.f, 1.f}, c1 = c0, s0 = {0.f, 0.f, 0.f, 0.f}, s1 = s0;
                if (rot) { const float* rp = rope + (row & 2047) * 16; c0 = *(const f32x4*)rp; c1 = *(const f32x4*)(rp + 4); s0 = *(const f32x4*)(rp + 8); s1 = *(const f32x4*)(rp + 12); }
#pragma unroll
                for (int bj = 0; bj < 2; ++bj) { f32x4 v0 = acc[ai][bj][m][0], v1 = acc[ai][bj][m][1];
                    if (rot) { f32x4 o0, o1;
#pragma unroll
                        for (int i = 0; i < 4; ++i) { o0[i] = __shfl_xor(v0[i], 16); o1[i] = __shfl_xor(v1[i], 16); }
                        const f32x4 r0 = v0 * c0 + (o0 * s0) * sg, r1 = v1 * c1 + (o1 * s1) * sg;
                        v0 = act ? r0 : v0; v1 = act ? r1 : v1; }
                    v0 = v0 * sc; v1 = v1 * sc;
                    u32x4 w; w.x = cvt_pk_bf16(v0[0], v0[1]); w.y = cvt_pk_bf16(v0[2], v0[3]); w.z = cvt_pk_bf16(v1[0], v1[1]); w.w = cvt_pk_bf16(v1[2], v1[3]);
                    *(u32x4*)(rowp + bj * HALF) = w; } }
    }
};
struct EpiResF32 {
    static constexpr bool PERM = false, AFTER_DRAIN = false;
    const float* base; float* out; int ldc;
    __device__ __forceinline__ void operator()(const f32x4 (&acc)[2][2][4][2], const Unit& u, int wr, int wc, int fr, int fq) const {
        const int row0 = u.pm * BM + wr * 64 + fr, col0 = u.cn * BM + wc * 32 + 4 * fq;
#pragma unroll
        for (int ai = 0; ai < 2; ++ai)
#pragma unroll
            for (int m = 0; m < 4; ++m) { const size_t off = (size_t)(row0 + ai * HALF + m * 16) * ldc + col0;
#pragma unroll
                for (int bj = 0; bj < 2; ++bj)
#pragma unroll
                    for (int n = 0; n < 2; ++n) { const f32x4 b = *(const f32x4*)(base + off + bj * HALF + n * 16); *(f32x4*)(out + off + bj * HALF + n * 16) = acc[ai][bj][m][n] + b; } }
    }
};
__device__ __forceinline__ float swiglu1(float g, float up) {
    g = fminf(g, 7.0f); up = fminf(fmaxf(up, -7.0f), 7.0f);
    const float e = __builtin_amdgcn_exp2f(g * (-1.702f * 1.4426950408889634f));
    return (up + 1.0f) * g * __builtin_amdgcn_rcpf(1.0f + e);
}
__device__ __forceinline__ unsigned pk4_fp8(float a, float b, float c, float d) {
    a = fminf(fmaxf(a, -448.f), 448.f); b = fminf(fmaxf(b, -448.f), 448.f); c = fminf(fmaxf(c, -448.f), 448.f); d = fminf(fmaxf(d, -448.f), 448.f);
    int w = 0; w = __builtin_amdgcn_cvt_pk_fp8_f32(a, b, w, false); w = __builtin_amdgcn_cvt_pk_fp8_f32(c, d, w, true); return (unsigned)w; }
constexpr float FP8_W_SCALE = 64.f, FP8_X_SCALE = 16.f, FP8_ACT_SCALE = 4.f;
struct EpiFp8Y {
    static constexpr bool PERM = true, AFTER_DRAIN = false;
    unsigned char* O; float sc; const float* bias;
    __device__ __forceinline__ void operator()(const f32x4 (&acc)[2][2][4][2], const Unit& u, int wr, int wc, int fr, int fq) const {
        const int row0 = u.pm * BM + wr * 64 + fr, col0 = u.cn * BM + wc * 32 + 8 * fq;
        f32x4 bv[2][2];
#pragma unroll
        for (int bj = 0; bj < 2; ++bj)
#pragma unroll
            for (int n = 0; n < 2; ++n) bv[bj][n] = *(const f32x4*)(bias + (size_t)u.e * 2048 + col0 + bj * HALF + 4 * n);
#pragma unroll
        for (int ai = 0; ai < 2; ++ai) { if (ai == 1 && u.rows <= HALF) break;
#pragma unroll
            for (int m = 0; m < 4; ++m) { unsigned char* rowp = O + (size_t)(row0 + ai * HALF + m * 16) * 2048 + col0;
#pragma unroll
                for (int bj = 0; bj < 2; ++bj) { const f32x4 v0 = (acc[ai][bj][m][0] * sc + bv[bj][0]) * 16.f, v1 = (acc[ai][bj][m][1] * sc + bv[bj][1]) * 16.f;
                    typedef unsigned u32x2y __attribute__((ext_vector_type(2))); u32x2y w; w.x = pk4_fp8(v0[0], v0[1], v0[2], v0[3]); w.y = pk4_fp8(v1[0], v1[1], v1[2], v1[3]);
                    *(u32x2y*)(rowp + bj * HALF) = w; } } }
    }
};
struct EpiSwiGLU {
    static constexpr bool PERM = true, AFTER_DRAIN = false;
    unsigned char* O; const float* bias;
    __device__ __forceinline__ void operator()(const f32x4 (&acc)[2][2][4][2], const Unit& u, int wr, int wc, int fr, int fq) const {
        const int row0 = u.pm * BM + wr * 64 + fr, colj = u.cn * HALF + wc * 32 + 8 * fq;
        const float* bg = bias + (size_t)u.e * 4096 + colj; const float isc = 1.0f / (FP8_W_SCALE * FP8_X_SCALE);
        const f32x4 bg0 = *(const f32x4*)(bg), bg1 = *(const f32x4*)(bg + 4), bu0 = *(const f32x4*)(bg + 2048), bu1 = *(const f32x4*)(bg + 2048 + 4);
#pragma unroll
        for (int ai = 0; ai < 2; ++ai) { if (ai == 1 && u.rows <= HALF) break;
#pragma unroll
            for (int m = 0; m < 4; ++m) { unsigned char* rowp = O + (size_t)(row0 + ai * HALF + m * 16) * 2048 + colj;
                const f32x4 g0 = acc[ai][0][m][0] * isc + bg0, g1 = acc[ai][0][m][1] * isc + bg1, u0 = acc[ai][1][m][0] * isc + bu0, u1 = acc[ai][1][m][1] * isc + bu1;
                typedef unsigned u32x2e __attribute__((ext_vector_type(2))); u32x2e w;
                w.x = pk4_fp8(FP8_ACT_SCALE * swiglu1(g0[0], u0[0]), FP8_ACT_SCALE * swiglu1(g0[1], u0[1]), FP8_ACT_SCALE * swiglu1(g0[2], u0[2]), FP8_ACT_SCALE * swiglu1(g0[3], u0[3]));
                w.y = pk4_fp8(FP8_ACT_SCALE * swiglu1(g1[0], u1[0]), FP8_ACT_SCALE * swiglu1(g1[1], u1[1]), FP8_ACT_SCALE * swiglu1(g1[2], u1[2]), FP8_ACT_SCALE * swiglu1(g1[3], u1[3]));
                *(u32x2e*)rowp = w; } }
    }
};
typedef short v4i16p_t __attribute__((ext_vector_type(4)));
typedef int v2i_t __attribute__((ext_vector_type(2)));
__device__ __forceinline__ v2i_t trb(PG8_LAS const unsigned char* p) { return __builtin_bit_cast(v2i_t, __builtin_amdgcn_ds_read_tr16_b64_v4i16((PG8_LAS v4i16p_t*)p)); }
typedef int v8i_t __attribute__((ext_vector_type(8)));
typedef int v4i_t __attribute__((ext_vector_type(4)));
__device__ __forceinline__ v8i_t cat8(bf16x8 a, bf16x8 b) { const v4i_t x = __builtin_bit_cast(v4i_t, a), y = __builtin_bit_cast(v4i_t, b); return __builtin_shufflevector(x, y, 0, 1, 2, 3, 4, 5, 6, 7); }
__device__ __forceinline__ void mfma_fp8(f32x4& c, v8i_t a, v8i_t b, int sc) { asm volatile("v_mfma_scale_f32_16x16x128_f8f6f4 %0, %1, %2, %0, %3, %3 op_sel_hi:[0,0,0]" : "+v"(c) : "v"(a), "v"(b), "v"(sc)); }
struct NoSide { static constexpr bool ON = false, TWO = false; int njobs; };
struct SideConv {
    static constexpr bool ON = true, TWO = true;
    const float* W; unsigned char* OUT; int ntot; int c0, njobs; unsigned stage; int opitch;
    __device__ __forceinline__ void addr(int j, int tid, const float*& s0, unsigned char*& d) const {
        const int c = c0 + j, cpk = ntot >> 11, kpg = c / cpk, half = c - kpg * cpk, e = kpg >> 10, kp = kpg & 1023;
        s0 = W + (size_t)e * 2048 * ntot + (size_t)(2 * kp) * ntot + half * 2048 + 4 * tid;
        d = OUT + ((size_t)e * 1024 + kp) * opitch + (size_t)(half * 2048 + 4 * tid) * 2;
    }
    __device__ __forceinline__ void issue(PG8_LAS unsigned char* lds0, int j, int tid, int wid) const {
        const float* s0; unsigned char* d; addr(j, tid, s0, d);
        __builtin_amdgcn_global_load_lds((const unsigned*)s0, (PG8_LAS unsigned*)(lds0 + stage + wid * 1024), 16, 0, 2);
        __builtin_amdgcn_global_load_lds((const unsigned*)(s0 + ntot), (PG8_LAS unsigned*)(lds0 + stage + 8192 + wid * 1024), 16, 0, 2);
    }
    __device__ __forceinline__ void read(v4i_t& t0, v4i_t& t1, int tid, unsigned ldsb) const {
        asm volatile("ds_read_b128 %0, %1" : "=&v"(t0) : "v"(ldsb + stage + 16u * (unsigned)tid) : "memory");
        asm volatile("ds_read_b128 %0, %1" : "=&v"(t1) : "v"(ldsb + stage + 8192u + 16u * (unsigned)tid) : "memory");
    }
    __device__ __forceinline__ void finish(v4i_t& t0, v4i_t& t1, int j, int tid) const {
        asm volatile("" : "+v"(t0), "+v"(t1));
        const float* s0; unsigned char* d; addr(j, tid, s0, d);
        const f32x4 r0 = __builtin_bit_cast(f32x4, t0) * 64.f, r1 = __builtin_bit_cast(f32x4, t1) * 64.f;
        int w0 = 0, w1 = 0; w0 = __builtin_amdgcn_cvt_pk_fp8_f32(r0[0], r1[0], w0, false); w0 = __builtin_amdgcn_cvt_pk_fp8_f32(r0[1], r1[1], w0, true);
        w1 = __builtin_amdgcn_cvt_pk_fp8_f32(r0[2], r1[2], w1, false); w1 = __builtin_amdgcn_cvt_pk_fp8_f32(r0[3], r1[3], w1, true);
        typedef int v2is __attribute__((ext_vector_type(2))); __builtin_nontemporal_store((v2is){w0, w1}, (v2is*)d);
    }
};
template <class Epi, class Sched, bool ALIGN_EPI = false, bool SP2 = false, bool FP8 = false, bool BPAIR = false, class Side = NoSide>
__device__ __forceinline__ void gemm_phase(PG8_LAS unsigned char* lds, const Gemm g, const Sched& S, const Epi& E, const Side SD = Side{}) {
    const int tid = threadIdx.x, wid = __builtin_amdgcn_readfirstlane(tid >> 6), lane = tid & 63, wr = wid >> 2, wc = wid & 3, fr = lane & 15, fq = lane >> 4;
    const int K = g.K, nt = K / BK;
    int fp8_scale1 = 0x7f7f7f7f; if constexpr (FP8) asm volatile("" : "+v"(fp8_scale1));
    unsigned voffA[2], voffB[2];
#pragma unroll
    for (int i = 0; i < 2; ++i) { int R, C; stage_rc(tid * 16 + i * 8192, R, C); const int Rb = Epi::PERM ? ((R & ~31) + perm32(R & 31)) : R;
        voffA[i] = (unsigned)(R * K + C) * 2u; voffB[i] = (unsigned)(Rb * K + C) * 2u;
        if constexpr (BPAIR) { const int b_ = tid * 16 + i * 8192, kp_ = b_ >> 8, sl_ = (b_ & 255) >> 4, pc_ = sl_ ^ (2 * ((kp_ & 3) | (((kp_ >> 3) & 1) << 2))); voffB[i] = (unsigned)(kp_ * g.b_ntot + 8 * pc_) * 2u; } }
    const size_t kstep = (size_t)(BK * 2);
    const size_t hstep = (size_t)HALF * K * 2;
    const size_t tstep = 2 * hstep;
    const size_t kstepB = BPAIR ? (size_t)64 * g.b_ntot * 2 : kstep, hstepB = BPAIR ? (size_t)g.b_hstep : hstep;
    const unsigned ldsw = (unsigned)wid * 1024u;
    const int aoff = lds_byte(wr * 64 + fr, fq * 8), boff = lds_byte(wc * 32 + fr, fq * 8);
    const int boffP = (8 * fq + ((lane & 15) >> 2)) * 256 + 16 * ((4 * wc + (lane & 3)) ^ (2 * (((lane & 15) >> 2) | ((fq & 1) << 2))));
#define PG8_SA(b, h) (((b) * 2 + (h)) * HTB)
#define PG8_SB(b, h) ((4 + (b) * 2 + (h)) * HTB)
#define PG8_STAGE(bufoff, gbase, voff) do { _Pragma("unroll") for (int _i = 0; _i < 2; ++_i) \
        __builtin_amdgcn_global_load_lds((const unsigned*)((const char*)(gbase) + (voff)[_i]), (PG8_LAS unsigned*)(lds + (bufoff) + ldsw + _i * 8192), 16, 0, 0); } while (0)
#define PG8_LDA(dst, b, h) do { _Pragma("unroll") for (int m = 0; m < 4; ++m) _Pragma("unroll") for (int k = 0; k < 2; ++k) dst[m][k] = *(const PG8_LAS bf16x8*)(lds + PG8_SA(b, h) + aoff + m * 2048 + k * 1024); } while (0)
#define PG8_TRA(dstv, addr, off) asm volatile("ds_read_b64_tr_b16 %0, %1 offset:%c2" : "=&v"(dstv) : "v"(addr), "i"(off) : "memory")
#define PG8_LDB(dst, b, h) do { if constexpr (BPAIR) { _Pragma("unroll") for (int n = 0; n < 2; ++n) { const unsigned a_ = ldsb32 + (unsigned)(PG8_SB(b, h) + boffP + 8 * n); \
            PG8_TRA(dst##r[n][0], a_, 0); PG8_TRA(dst##r[n][1], a_, 1024); PG8_TRA(dst##r[n][2], a_, 8192); PG8_TRA(dst##r[n][3], a_, 9216); } } \
        else { _Pragma("unroll") for (int n = 0; n < 2; ++n) _Pragma("unroll") for (int k = 0; k < 2; ++k) dst[n][k] = *(const PG8_LAS bf16x8*)(lds + PG8_SB(b, h) + boff + n * 2048 + k * 1024); } } while (0)
#define PG8_FIXB(dst) do { if constexpr (BPAIR) { _Pragma("unroll") for (int n = 0; n < 2; ++n) { \
            asm volatile("" : "+v"(dst##r[n][0]), "+v"(dst##r[n][1]), "+v"(dst##r[n][2]), "+v"(dst##r[n][3])); \
            dst[n][0] = __builtin_bit_cast(bf16x8, (v4i_t){dst##r[n][0][0], dst##r[n][0][1], dst##r[n][1][0], dst##r[n][1][1]}); dst[n][1] = __builtin_bit_cast(bf16x8, (v4i_t){dst##r[n][2][0], dst##r[n][2][1], dst##r[n][3][0], dst##r[n][3][1]}); } } } while (0)
#define PG8_MMA(ai, bj, At, Bt) do { __builtin_amdgcn_s_setprio(1); _Pragma("unroll") for (int m = 0; m < 4; ++m) _Pragma("unroll") for (int n = 0; n < 2; ++n) { \
        if constexpr (FP8) { mfma_fp8(acc[ai][bj][m][n], cat8(Bt[n][0], Bt[n][1]), cat8(At[m][0], At[m][1]), fp8_scale1); } \
        else { _Pragma("unroll") for (int k = 0; k < 2; ++k) acc[ai][bj][m][n] = __builtin_amdgcn_mfma_f32_16x16x32_bf16(Bt[n][k], At[m][k], acc[ai][bj][m][n], 0, 0, 0); } } \
        __builtin_amdgcn_s_setprio(0); } while (0)
#define PG8_WAIT_V(n) asm volatile("s_waitcnt vmcnt(" #n ")" ::: "memory")
#define PG8_WAIT_L(n) asm volatile("s_waitcnt lgkmcnt(" #n ")" ::: "memory")
#define PG8_BAR __builtin_amdgcn_s_barrier()
#define PG8_SCHED __builtin_amdgcn_sched_barrier(0)
    Unit cur, nxt; int ui = 0;
    if (!S.next(0, cur)) return;
    f32x4 acc[2][2][4][2];
#pragma unroll
    for (int a = 0; a < 2; ++a)
#pragma unroll
        for (int b = 0; b < 2; ++b)
#pragma unroll
            for (int m = 0; m < 4; ++m)
#pragma unroll
                for (int n = 0; n < 2; ++n) acc[a][b][m][n] = (f32x4){0.f, 0.f, 0.f, 0.f};
    bf16x8 At[4][2], B0[2][2], B1[2][2];
    int sj = 0; bool spend = false; v4i_t st0 = {0, 0, 0, 0}, st1 = st0; PG8_LAS unsigned char* const lds0 = lds;
    v2i_t B0r[2][4], B1r[2][4]; const unsigned ldsb32 = (unsigned)(size_t)lds;
    const char* cA = (const char*)g.A + (size_t)cur.pm * tstep; const char* cB = (const char*)g.Bt + (BPAIR ? (size_t)cur.boff : (size_t)cur.pn * tstep);
    S.a_ready(cur);
    if constexpr (SP2) {
        PG8_STAGE(PG8_SB(0, 0), cB, voffB); PG8_STAGE(PG8_SB(0, 1), cB + hstepB, voffB); PG8_STAGE(PG8_SA(0, 0), cA, voffA); PG8_STAGE(PG8_SA(0, 1), cA + hstep, voffA);
        if (wr == 1) PG8_BAR;
        PG8_WAIT_V(2); PG8_BAR;
        PG8_STAGE(PG8_SB(1, 0), cB + kstepB, voffB); PG8_STAGE(PG8_SA(1, 0), cA + kstep, voffA); PG8_STAGE(PG8_SB(1, 1), cB + hstepB + kstepB, voffB);
        PG8_WAIT_V(6); PG8_BAR;
    } else {
        PG8_STAGE(PG8_SB(0, 0), cB, voffB); PG8_STAGE(PG8_SA(0, 0), cA, voffA); PG8_STAGE(PG8_SB(0, 1), cB + hstepB, voffB); PG8_STAGE(PG8_SA(0, 1), cA + hstep, voffA);
        if (wr == 1) PG8_BAR;
        PG8_WAIT_V(4); PG8_BAR;
        PG8_STAGE(PG8_SB(1, 0), cB + kstepB, voffB); PG8_STAGE(PG8_SA(1, 0), cA + kstep, voffA); PG8_STAGE(PG8_SB(1, 1), cB + hstepB + kstepB, voffB);
        PG8_WAIT_V(6); PG8_BAR;
    }
    for (;;) {
        const bool has_next = S.next(ui + 1, nxt);
        const char* nA = has_next ? (const char*)g.A + (size_t)nxt.pm * tstep : cA; const char* nB = has_next ? (const char*)g.Bt + (BPAIR ? (size_t)nxt.boff : (size_t)nxt.pn * tstep) : cB;
        for (int t = 0; t < nt; t += 2) {
            const bool last = (t == nt - 2);
            const char* a1 = cA + (size_t)(t + 1) * kstep;
            const char* a2 = last ? nA : cA + (size_t)(t + 2) * kstep; const char* b2 = last ? nB : cB + (size_t)(t + 2) * kstepB;
            const char* a3 = a2 + kstep; const char* b3 = b2 + kstepB;
            if (last && has_next) S.a_ready(nxt);
            if constexpr (SP2) {
            PG8_LDB(B0, 0, 0); PG8_LDB(B1, 0, 1); PG8_SCHED; PG8_LDA(At, 0, 0); PG8_STAGE(PG8_SA(1, 1), a1 + hstep, voffA);
            PG8_WAIT_V(8);
            if constexpr (Side::ON) { if (spend) SD.read(st0, st1, tid, (unsigned)(size_t)lds); }
            PG8_WAIT_L(0); PG8_FIXB(B0); PG8_FIXB(B1);
            if constexpr (Side::ON) { if (spend) { SD.finish(st0, st1, sj - 1, tid); spend = false; } if (sj < SD.njobs) { SD.issue(lds0, sj, tid, wid); ++sj; spend = true; } }
            PG8_BAR; PG8_MMA(0, 0, At, B0); PG8_MMA(0, 1, At, B1); PG8_BAR; PG8_SCHED;
            PG8_LDA(At, 0, 1); PG8_STAGE(PG8_SB(0, 0), b2, voffB); PG8_STAGE(PG8_SB(0, 1), b2 + hstepB, voffB); PG8_STAGE(PG8_SA(0, 0), a2, voffA);
            PG8_WAIT_V(8); PG8_WAIT_L(0); PG8_BAR; if (!(FP8 && cur.rows <= HALF)) { PG8_MMA(1, 0, At, B0); PG8_MMA(1, 1, At, B1); } PG8_BAR; PG8_SCHED;
            PG8_LDB(B0, 1, 0); PG8_LDB(B1, 1, 1); PG8_SCHED; PG8_LDA(At, 1, 0); PG8_STAGE(PG8_SA(0, 1), a2 + hstep, voffA);
            PG8_WAIT_V(8);
            if constexpr (Side::ON) { if (Side::TWO && spend) SD.read(st0, st1, tid, (unsigned)(size_t)lds); }
            PG8_WAIT_L(0); PG8_FIXB(B0); PG8_FIXB(B1);
            if constexpr (Side::ON) { if (Side::TWO) { if (spend) { SD.finish(st0, st1, sj - 1, tid); spend = false; } if (sj < SD.njobs) { SD.issue(lds0, sj, tid, wid); ++sj; spend = true; } } }
            PG8_BAR; PG8_MMA(0, 0, At, B0); PG8_MMA(0, 1, At, B1); PG8_BAR; PG8_SCHED;
            PG8_LDA(At, 1, 1); PG8_STAGE(PG8_SB(1, 0), b3, voffB); PG8_STAGE(PG8_SB(1, 1), b3 + hstepB, voffB); PG8_STAGE(PG8_SA(1, 0), a3, voffA);
            PG8_WAIT_V(8); PG8_WAIT_L(0); PG8_BAR; if (!(FP8 && cur.rows <= HALF)) { PG8_MMA(1, 0, At, B0); PG8_MMA(1, 1, At, B1); } PG8_BAR; PG8_SCHED;
            } else {
            PG8_LDB(B0, 0, 0); PG8_SCHED; PG8_LDA(At, 0, 0); PG8_STAGE(PG8_SA(1, 1), a1 + hstep, voffA);
            PG8_WAIT_L(8); PG8_BAR; PG8_WAIT_L(0); PG8_MMA(0, 0, At, B0); PG8_BAR; PG8_SCHED;
            PG8_LDB(B1, 0, 1); PG8_STAGE(PG8_SB(0, 0), b2, voffB);
            PG8_BAR; PG8_WAIT_L(0); PG8_MMA(0, 1, At, B1); PG8_BAR;
            PG8_LDA(At, 0, 1); PG8_STAGE(PG8_SA(0, 0), a2, voffA);
            PG8_BAR; PG8_WAIT_L(0); PG8_MMA(1, 0, At, B0); PG8_BAR; PG8_SCHED;
            PG8_STAGE(PG8_SB(0, 1), b2 + hstepB, voffB);
            PG8_WAIT_V(6); PG8_BAR; PG8_MMA(1, 1, At, B1); PG8_BAR;
            PG8_LDB(B0, 1, 0); PG8_SCHED; PG8_LDA(At, 1, 0); PG8_STAGE(PG8_SA(0, 1), a2 + hstep, voffA);
            PG8_WAIT_L(8); PG8_BAR; PG8_WAIT_L(0); PG8_MMA(0, 0, At, B0); PG8_BAR; PG8_SCHED;
            PG8_LDB(B1, 1, 1); PG8_STAGE(PG8_SB(1, 0), b3, voffB);
            PG8_BAR; PG8_WAIT_L(0); PG8_MMA(0, 1, At, B1); PG8_BAR;
            PG8_LDA(At, 1, 1); PG8_STAGE(PG8_SA(1, 0), a3, voffA);
            PG8_BAR; PG8_WAIT_L(0); PG8_MMA(1, 0, At, B0); PG8_BAR; PG8_SCHED;
            PG8_STAGE(PG8_SB(1, 1), b3 + hstepB, voffB);
            PG8_WAIT_V(6); PG8_BAR; PG8_MMA(1, 1, At, B1); PG8_BAR;
            }
        }
        if constexpr (ALIGN_EPI) { if (wr == 0) PG8_BAR; }
        if constexpr (FP8) asm volatile("s_nop 15\n\ts_nop 15" ::: "memory");
        if constexpr (!Epi::AFTER_DRAIN) { int tz = threadIdx.x; asm volatile("" : "+v"(tz));
            const int wz = __builtin_amdgcn_readfirstlane(tz >> 6), lz = tz & 63; E(acc, cur, wz >> 2, wz & 3, lz & 15, lz >> 4); S.done(cur); }
        if (!has_next) break;
#pragma unroll
        for (int a = 0; a < 2; ++a)
#pragma unroll
            for (int b = 0; b < 2; ++b)
#pragma unroll
                for (int m = 0; m < 4; ++m)
#pragma unroll
                    for (int n = 0; n < 2; ++n) acc[a][b][m][n] = (f32x4){0.f, 0.f, 0.f, 0.f};
        cur = nxt; cA = nA; cB = nB; ++ui;
        if constexpr (ALIGN_EPI) { if (wr == 1) PG8_BAR; }
    }
    PG8_WAIT_V(0);
    if constexpr (!ALIGN_EPI) { if (wr == 0) PG8_BAR; }
    PG8_BAR;
    if constexpr (Side::ON) { if (spend) { SD.read(st0, st1, tid, (unsigned)(size_t)lds); PG8_WAIT_L(0); SD.finish(st0, st1, sj - 1, tid); spend = false; } }
    if constexpr (Epi::AFTER_DRAIN) { E.fused(acc, cur, wr, wc, fr, fq, lds, wid, lane); S.done(cur); }
#undef PG8_SA
#undef PG8_SB
#undef PG8_STAGE
#undef PG8_LDA
#undef PG8_LDB
#undef PG8_TRA
#undef PG8_FIXB
#undef PG8_MMA
#undef PG8_WAIT_V
#undef PG8_WAIT_L
#undef PG8_BAR
#undef PG8_SCHED
}
}
#define GAS __attribute__((address_space(1)))
#define LAS __attribute__((address_space(3)))
typedef unsigned short bf16;
typedef unsigned v4u __attribute__((ext_vector_type(4)));
typedef float f32x4 __attribute__((ext_vector_type(4)));
typedef short bf16x8 __attribute__((ext_vector_type(8)));
typedef GAS unsigned gu32;
typedef GAS unsigned long long gu64;
#define RLX_AGENT __ATOMIC_RELAXED, __HIP_MEMORY_SCOPE_AGENT
#define LDS_WAIT() asm volatile("s_waitcnt lgkmcnt(0)" ::: "memory")
#define VM_WAIT() asm volatile("s_waitcnt vmcnt(0)" ::: "memory")
__device__ __forceinline__ unsigned long long rt() { return __builtin_amdgcn_s_memrealtime(); }
__device__ __forceinline__ unsigned f2bf(float f) { unsigned u = __builtin_bit_cast(unsigned, f); return (u + 0x7fffu + ((u >> 16) & 1u)) >> 16; }
__device__ __forceinline__ unsigned pk2(float lo, float hi) { return f2bf(lo) | (f2bf(hi) << 16); }
__device__ __forceinline__ unsigned cpk_bf16(float lo, float hi) { unsigned r; asm("v_cvt_pk_bf16_f32 %0, %1, %2" : "=v"(r) : "v"(lo), "v"(hi)); return r; }

#define XB_TMO      128
#define XB_XCNT(j)  (256  + 64 * (j))
#define XB_XSUB(j)  (1280 + 64 * (j))
#define XB_XGEN(j)  (2304 + 64 * (j))
#define XB_TOP      3328
#define XB_TOPGEN   3392
#define XCD_BAR_WORDS 3456
#define XB_SPIN_CAP (1u << 18)

__device__ __forceinline__ unsigned xb_ld(unsigned* p)              { return __hip_atomic_load(p, __ATOMIC_RELAXED, __HIP_MEMORY_SCOPE_AGENT); }
__device__ __forceinline__ unsigned xb_add(unsigned* p, unsigned v) { return __hip_atomic_fetch_add(p, v, __ATOMIC_RELAXED, __HIP_MEMORY_SCOPE_AGENT); }
__device__ __forceinline__ unsigned xb_xcc_id() { return (unsigned)__builtin_amdgcn_s_getreg((3 << 11) | 20) & 0xFu; }
#define XB_SPIN(cond, bar) do { unsigned _sp = 0; while (cond) { __builtin_amdgcn_s_sleep(1); \
    if ((++_sp & 255u) == 0u) { if (xb_ld(&(bar)[XB_TMO])) break; if (_sp > XB_SPIN_CAP) { atomicAdd(&(bar)[XB_TMO], 1u); break; } } } } while (0)

struct XcdBarrier {
    unsigned* bar; unsigned x;
    volatile LAS unsigned* st;
};

__device__ __forceinline__ XcdBarrier xcd_barrier_post(unsigned* bar, volatile LAS unsigned* st) {
    XcdBarrier b; b.bar = bar; b.x = xb_xcc_id(); b.st = st;
    if (threadIdx.x == 0) (void)xb_add(&bar[XB_XCNT(b.x)], 1u);
    return b;
}
__device__ __forceinline__ void xcd_barrier_complete(unsigned* bar, unsigned x, unsigned& nloc, unsigned& nx) {
    const unsigned G = gridDim.x * gridDim.y * gridDim.z;
    unsigned sum, cnt, mine, sp = 0u;
    for (;;) {
        sum = 0u; cnt = 0u; mine = 0u;
#pragma unroll
        for (unsigned j = 0; j < 16; ++j) { const unsigned c = xb_ld(&bar[XB_XCNT(j)]); sum += c; cnt += (c > 0u) ? 1u : 0u; mine = (j == x) ? c : mine; }
        if (sum == G) break;
        __builtin_amdgcn_s_sleep(1);
        if ((++sp & 255u) == 0u) { if (xb_ld(&bar[XB_TMO])) break; if (sp > XB_SPIN_CAP) { atomicAdd(&bar[XB_TMO], 1u); break; } }
    }
    nloc = mine > 0u ? mine : 1u; nx = cnt > 0u ? cnt : 1u;
}

__device__ __forceinline__ void xcd_barrier(const XcdBarrier& b) {
    asm volatile("s_waitcnt vmcnt(0)" ::: "memory");
    __syncthreads();
    if (threadIdx.x == 0) {
        unsigned* bar = b.bar;
        __builtin_amdgcn_s_waitcnt(0);
        unsigned nloc = b.st[0], nx = b.st[1];
        if (nloc == 0u) { xcd_barrier_complete(bar, b.x, nloc, nx); b.st[0] = nloc; b.st[1] = nx; }
        const unsigned old = xb_add(&bar[XB_XSUB(b.x)], 1u);
        const unsigned gen = old / nloc;
        if (old + 1u == (gen + 1u) * nloc) {
            __builtin_amdgcn_fence(__ATOMIC_RELEASE, "agent");
            asm volatile("s_waitcnt vmcnt(0)" ::: "memory");
            const unsigned og = xb_add(&bar[XB_TOP], 1u);
            const unsigned tg = og / nx;
            if (og + 1u == (tg + 1u) * nx) xb_add(&bar[XB_TOPGEN], 1u);
            else XB_SPIN(xb_ld(&bar[XB_TOPGEN]) == tg, bar);
            __builtin_amdgcn_fence(__ATOMIC_ACQUIRE, "agent");
            xb_add(&bar[XB_XGEN(b.x)], 1u);
            asm volatile("s_waitcnt vmcnt(0)" ::: "memory");
        } else {
            XB_SPIN(xb_ld(&bar[XB_XGEN(b.x)]) == gen, bar);
            __builtin_amdgcn_fence(__ATOMIC_ACQUIRE, "agent");
            asm volatile("s_waitcnt vmcnt(0)" ::: "memory");
        }
    }
    __syncthreads();
}

constexpr int NB = 4, SEQ = 2048, DM = 2048, NTOK = NB * SEQ, INC = 6144, CW = 512, AW = 1536, NH = 24, HD = 64, NE = 32, TOPK = 4, DE = 2048;
constexpr int QOFF = 1536, KOFF = 3072, VOFF = 4608;
constexpr int MAXSLOT = NE * NTOK;
constexpr float EPS = 1e-5f;
typedef unsigned u32x2v __attribute__((ext_vector_type(2)));
constexpr int NWAVES = 8;
#ifndef MK_N_LAUNCHES
#define MK_N_LAUNCHES 1
#endif
#ifndef PROBE_MASK
#define PROBE_MASK 0
#endif
#ifndef PROBE_N
#define PROBE_N 2
#endif
#define REPS(k) (((PROBE_MASK >> (k)) & 1) ? PROBE_N : 1)
#ifndef PROBE_AMP
#define PROBE_AMP 0
#endif
#ifndef PROBE_AMP_N
#define PROBE_AMP_N 3
#endif
#define AMP_BEGIN(k) unsigned long long amp_t0_ = 0; if ((PROBE_AMP >> (k)) & 1) amp_t0_ = __builtin_amdgcn_s_memrealtime()
#define AMP_END(k) do { if ((PROBE_AMP >> (k)) & 1) { const unsigned long long t1_ = __builtin_amdgcn_s_memrealtime(); const unsigned long long tg_ = t1_ + (unsigned long long)PROBE_AMP_N * (t1_ - amp_t0_); while (__builtin_amdgcn_s_memrealtime() < tg_) __builtin_amdgcn_s_sleep(16); } } while (0)
constexpr int NPH = 10;

constexpr size_t MiB = 1u << 20;
constexpr size_t WS_CTL = 0, CTL_ZERO_BYTES = 1 * MiB;
constexpr size_t WS_ROPE = 1 * MiB;
constexpr size_t WS_TOKE = 2 * MiB, WS_TOKR = WS_TOKE + 128 * 1024, WS_TOKG = WS_TOKR + 128 * 1024;
constexpr size_t WS_LIST = 3 * MiB;
constexpr size_t WS_WIN = 8 * MiB;
constexpr size_t WS_WO = 32 * MiB;
constexpr size_t WS_XN = 40 * MiB;
constexpr size_t WS_PROJ = 1900 * MiB;
constexpr size_t WS_YATT = 168 * MiB;
constexpr size_t WS_MIXED = 192 * MiB;
constexpr size_t WS_X1 = 224 * MiB;
constexpr size_t WS_XN2 = 288 * MiB;
constexpr size_t WS_XS = 320 * MiB;
constexpr size_t WS_ACT = 832 * MiB;
constexpr size_t WS_Y = 1344 * MiB;
constexpr size_t WS_WGU = 2368 * MiB;
constexpr size_t WS_WDN = 2640 * MiB;
constexpr size_t WS_END = 2768 * MiB;
constexpr int CW_TMO = 0, CW_CODE = 1;
constexpr int CW_BAR = 4096;
constexpr int CW_CNT = 8192;
constexpr int CW_ATTQ = 12288;
constexpr int CW_CONVQ = 12288 + 4096;
constexpr int CW_P1DONE = 12288 + 8192;
#ifndef ATT_ITEM
#define ATT_ITEM item2
#endif
#ifndef ATT_NOFALL
#define ATT_NOFALL 1
#endif
#ifndef ATT_JOIN
#define ATT_JOIN 0
#endif
#ifndef SIDE_CONV
#define SIDE_CONV 3
#endif
#ifndef SPLIT_P1
#define SPLIT_P1 0
#endif
#ifndef FUSED2
#define FUSED2 0
#endif
#ifndef FUSED_CONV
#define FUSED_CONV 0
#endif
#ifndef ATT_WAVES
#define ATT_WAVES 6
#endif
constexpr int RING_BYTES = 131072;
constexpr int LDSCTL_OFF = RING_BYTES;
constexpr int MISC_OFF = LDSCTL_OFF + 320;
constexpr int TAB_TS = LDSCTL_OFF + 1024;
constexpr int TAB_CN = LDSCTL_OFF + 1024 + 512;
constexpr int PART_OFF = RING_BYTES + 16384;
constexpr int LDS_BYTES = 163840;

__device__ __forceinline__ float wave_sum(float v) {
#pragma unroll
    for (int o = 1; o < 64; o <<= 1) v += __shfl_xor(v, o);
    return v;
}
__device__ __forceinline__ float bf_lo(unsigned w) { return __uint_as_float(w << 16); }
__device__ __forceinline__ float bf_hi(unsigned w) { return __uint_as_float(w & 0xffff0000u); }

__device__ __forceinline__ void p0_transpose_item(const float* W, int N, int K, bf16* WT, int k0, int n0, int out_row0, LAS float* scr, int lane) {
#pragma unroll 8
    for (int i = 0; i < 32; ++i) { const int kk = 2 * i + (lane >> 5); scr[kk * 33 + (lane & 31)] = __builtin_nontemporal_load(W + (size_t)(k0 + kk) * N + n0 + (lane & 31)); }
    LDS_WAIT(); asm volatile("" ::: "memory");
    const int c = lane & 7;
#pragma unroll
    for (int j = 0; j < 4; ++j) { const int n = (lane >> 3) + 8 * j; const LAS float* s = scr + (8 * c) * 33 + n;
        v4u o; o.x = pk2(s[0 * 33], s[1 * 33]); o.y = pk2(s[2 * 33], s[3 * 33]); o.z = pk2(s[4 * 33], s[5 * 33]); o.w = pk2(s[6 * 33], s[7 * 33]);
        *(GAS v4u*)(WT + (size_t)(out_row0 + n) * K + k0 + 8 * c) = o; }
    LDS_WAIT(); asm volatile("" ::: "memory");
}

__device__ __forceinline__ void p0_transpose_item_fp8(const float* W, int N, int K, unsigned char* WT, int k0, int n0, int out_row0, float scale, LAS float* scr, int lane) {
#pragma unroll 8
    for (int i = 0; i < 32; ++i) { const int kk = 2 * i + (lane >> 5); scr[kk * 33 + (lane & 31)] = W[(size_t)(k0 + kk) * N + n0 + (lane & 31)]; }
    LDS_WAIT(); asm volatile("" ::: "memory");
    const int c = lane & 3;
#pragma unroll
    for (int j = 0; j < 2; ++j) { const int n = (lane >> 2) + 16 * j; const LAS float* s = scr + (16 * c) * 33 + n;
        v4u o;
        o.x = pg8::pk4_fp8(scale * s[0 * 33], scale * s[1 * 33], scale * s[2 * 33], scale * s[3 * 33]);
        o.y = pg8::pk4_fp8(scale * s[4 * 33], scale * s[5 * 33], scale * s[6 * 33], scale * s[7 * 33]);
        o.z = pg8::pk4_fp8(scale * s[8 * 33], scale * s[9 * 33], scale * s[10 * 33], scale * s[11 * 33]);
        o.w = pg8::pk4_fp8(scale * s[12 * 33], scale * s[13 * 33], scale * s[14 * 33], scale * s[15 * 33]);
        *(GAS v4u*)(WT + (size_t)(out_row0 + n) * K + k0 + 16 * c) = o; }
    LDS_WAIT(); asm volatile("" ::: "memory");
}

__device__ __forceinline__ unsigned pk4_fp8_nc(float a, float b, float c, float d) { int w = 0; w = __builtin_amdgcn_cvt_pk_fp8_f32(a, b, w, false); w = __builtin_amdgcn_cvt_pk_fp8_f32(c, d, w, true); return (unsigned)w; }
struct ConvDesc { const float* src; unsigned char* dstb; int N, isdn, opitch; };
constexpr int CV_NG = 16, PER_E = 256 + 128, NCONV = 32 * PER_E;
__device__ __forceinline__ ConvDesc conv_decode(int it, const float* w_gu, const float* w_dn, unsigned char* WGU, unsigned char* WDN, int lane) {
    const int e = it / PER_E, r = it - e * PER_E; ConvDesc d;
    if (r < 256) { const int kp0 = 4 * r; d.N = 4096; d.isdn = 0; d.src = w_gu + (size_t)e * 2048 * 4096 + (size_t)(2 * kp0) * 4096 + 4 * lane; d.opitch = PWG; d.dstb = WGU + (size_t)e * 1024 * PWG + (size_t)kp0 * PWG + 8 * lane; }
    else { const int kp0 = 8 * (r - 256); d.N = 2048; d.isdn = 1; d.opitch = 4096; d.src = w_dn + (size_t)e * 2048 * 2048 + (size_t)(2 * kp0) * 2048 + 4 * lane; d.dstb = WDN + (size_t)e * 1024 * 4096 + (size_t)kp0 * 4096 + 8 * lane; }
    return d;
}
#define CV_LOAD(R, D, g) do { const int ro_ = (D).isdn ? 4 * ((g) >> 3) : 0, co_ = (D).isdn ? 256 * ((g) & 7) : 256 * (g); \
        _Pragma("unroll") for (int t_ = 0; t_ < 4; ++t_) _Pragma("unroll") for (int i_ = 0; i_ < 2; ++i_) R[2 * t_ + i_] = __builtin_nontemporal_load((const GAS f32x4*)((D).src + (size_t)(2 * (ro_ + t_) + i_) * (D).N + co_)); } while (0)
#define CV_PROC(R, D, g) do { const int ro_ = (D).isdn ? 4 * ((g) >> 3) : 0, co_ = (D).isdn ? 256 * ((g) & 7) : 256 * (g); \
        _Pragma("unroll") for (int t_ = 0; t_ < 4; ++t_) { u32x2v o_; \
            o_.x = pk4_fp8_nc(pg8::FP8_W_SCALE * R[2 * t_][0], pg8::FP8_W_SCALE * R[2 * t_ + 1][0], pg8::FP8_W_SCALE * R[2 * t_][1], pg8::FP8_W_SCALE * R[2 * t_ + 1][1]); \
            o_.y = pk4_fp8_nc(pg8::FP8_W_SCALE * R[2 * t_][2], pg8::FP8_W_SCALE * R[2 * t_ + 1][2], pg8::FP8_W_SCALE * R[2 * t_][3], pg8::FP8_W_SCALE * R[2 * t_ + 1][3]); \
            __builtin_nontemporal_store(o_, (GAS u32x2v*)((D).dstb + (size_t)(ro_ + t_) * (D).opitch + 2 * co_)); } } while (0)

namespace att {
typedef short s16x8 __attribute__((ext_vector_type(8)));
typedef short s16x4 __attribute__((ext_vector_type(4)));
typedef float f32x16 __attribute__((ext_vector_type(16)));
typedef unsigned u32x4 __attribute__((ext_vector_type(4)));
constexpr int VP = 144;
constexpr int WAVE_LDS = 32 * VP;
constexpr float C2 = 0.125f * 1.4426950408889634f;
constexpr int NITEMS = 16 * NB * NH * 4;
typedef short v4i16_t __attribute__((ext_vector_type(4)));
__device__ __forceinline__ s16x4 vtr(LAS const char* p) { return __builtin_bit_cast(s16x4, __builtin_amdgcn_ds_read_tr16_b64_v4i16((LAS v4i16_t*)p)); }

struct TileD { int abase, kp_off, kp_mul, W, mod4, sel; };
__device__ __forceinline__ TileD tile_desc(int u, int n1, int n2, int first1, int first2, int m0, int r4) {
    TileD d;
    if (u < n1) { d.abase = 4 * m0 - 128 + 32 * (first1 + u); d.kp_off = 0; d.kp_mul = 1; d.W = 128; d.mod4 = 0; d.sel = 0; }
    else if (u < n1 + n2) { d.abase = m0 - 128 + 32 * (first2 + u - n1); d.kp_off = r4; d.kp_mul = 4; d.W = 128; d.mod4 = 0; d.sel = 1; }
    else { d.abase = 32 * (u - n1 - n2); d.kp_off = r4; d.kp_mul = 4; d.W = 0x7fffffff; d.mod4 = 1; d.sel = 1; }
    return d;
}
#define ATT_LOADT(KF, VF, D) do { _Pragma("unroll") for (int j_ = 0; j_ < 4; ++j_) { const int pos_ = (D).kp_off + (D).kp_mul * ((D).abase + 8 * j_ + (lane >> 3)); \
        KF[j_] = *(const GAS u32x4*)(Kb + (size_t)pos_ * PINC + 8 * (lane & 7)); VF[j_] = *(const GAS u32x4*)(Vb + (size_t)pos_ * PINC + 8 * (lane & 7)); } } while (0)

template <int PMODE = 0>
__device__ __forceinline__ void item(int it, const bf16* PROJ, bf16* YATT, LAS char* vl, int lane) {
    const int bh = it >> 6, jj = it & 63; const int b = bh / NH, head = bh - b * NH, mb = 15 - (jj >> 2), r4 = jj & 3;
    const int m0 = mb * 32, q = lane & 31, h = lane >> 5;
    const int qpos = r4 + 4 * (m0 + q);
    const bf16* base = PROJ + (size_t)b * SEQ * PINC;
    const bf16* Kb = base + KOFF + head * HD; const bf16* Vb = base + VOFF + head * HD;
    const int first1 = (mb == 0) ? 4 : 0, first2 = (mb < 4) ? 4 - mb : 0, n1 = 8 - first1, n2 = 5 - first2, ntile = n1 + n2 + mb + 1;
    u32x4 kA[4], vA[4], kB[4], vB[4];
    { const TileD d0 = tile_desc(0, n1, n2, first1, first2, m0, r4); ATT_LOADT(kA, vA, d0); }
    s16x8 qf[4];
    { const bf16* qp = base + (size_t)qpos * PINC + QOFF + head * HD + 8 * h;
#pragma unroll
      for (int d0 = 0; d0 < 4; ++d0) qf[d0] = __builtin_bit_cast(s16x8, *(const GAS u32x4*)(qp + 16 * d0)); }
    f32x16 o0 = {}, o1 = {}; float mrun = -1e30f, lrun = 0.f;
    const int g = lane >> 4, qq = (lane & 15) >> 2, pp = lane & 3;
    LAS const char* vb = vl + (4 * h + qq) * VP + (16 * (g & 1) + 4 * pp) * 2;
    LAS char* kl = vl + WAVE_LDS;
    LAS u32x4* vd = (LAS u32x4*)(vl + (lane >> 3) * VP + (lane & 7) * 16);
    LAS u32x4* kd = (LAS u32x4*)(kl + (lane >> 3) * VP + (lane & 7) * 16);
    LAS const char* kfp = kl + (lane & 31) * VP + h * 16;
#pragma unroll 1
    for (int u = 0; u < ntile; ++u) {
        const TileD d = tile_desc(u, n1, n2, first1, first2, m0, r4);
        if (PMODE != 1) { const int un = (u + 1 < ntile) ? u + 1 : u; const TileD dn = tile_desc(un, n1, n2, first1, first2, m0, r4); ATT_LOADT(kB, vB, dn); }
#pragma unroll
        for (int j = 0; j < 4; ++j) { *(LAS u32x4*)((LAS char*)kd + 8 * j * VP) = kA[j]; *(LAS u32x4*)((LAS char*)vd + 8 * j * VP) = vA[j]; }
        if (PMODE != 2) {
        f32x16 s = {};
#pragma unroll
        for (int d0 = 0; d0 < 4; ++d0) s = __builtin_amdgcn_mfma_f32_32x32x16_bf16(*(const LAS s16x8*)(kfp + 32 * d0), qf[d0], s, 0, 0, 0);
        const int bq = d.sel ? (m0 + q) : qpos;
        const int t0 = bq - d.abase - 4 * h; const unsigned W = (unsigned)d.W; const int m4 = d.mod4 ? 3 : 0;
        float mx = -INFINITY;
#pragma unroll
        for (int r = 0; r < 16; ++r) { const int dd = t0 - ((r & 3) + 8 * (r >> 2));
            const bool ok = ((unsigned)dd <= W) && ((dd & m4) == 0);
            s[r] = ok ? s[r] : -INFINITY; mx = fmaxf(mx, s[r]); }
        mx = fmaxf(mx, __shfl_xor(mx, 32));
        const float mnew = fmaxf(mrun, mx), alpha = __builtin_amdgcn_exp2f(mrun - mnew); mrun = mnew;
        float ps = 0.f;
#pragma unroll
        for (int r = 0; r < 16; ++r) { s[r] = __builtin_amdgcn_exp2f(s[r] - mnew); ps += s[r]; }
        lrun = lrun * alpha + ps;
#pragma unroll
        for (int r = 0; r < 16; ++r) { o0[r] *= alpha; o1[r] *= alpha; }
        u32x4 p0, p1;
        p0.x = pk2(s[0], s[1]); p0.y = pk2(s[2], s[3]); p0.z = pk2(s[4], s[5]); p0.w = pk2(s[6], s[7]);
        p1.x = pk2(s[8], s[9]); p1.y = pk2(s[10], s[11]); p1.z = pk2(s[12], s[13]); p1.w = pk2(s[14], s[15]);
        const s16x8 pf0 = __builtin_bit_cast(s16x8, p0), pf1 = __builtin_bit_cast(s16x8, p1);
#pragma unroll
        for (int sstep = 0; sstep < 2; ++sstep) {
#pragma unroll
            for (int dh = 0; dh < 2; ++dh) {
                const s16x4 lo = vtr(vb + (16 * sstep) * VP + dh * 64), hi = vtr(vb + (16 * sstep + 8) * VP + dh * 64);
                const s16x8 vf = (s16x8){lo[0], lo[1], lo[2], lo[3], hi[0], hi[1], hi[2], hi[3]};
                if (dh == 0) o0 = __builtin_amdgcn_mfma_f32_32x32x16_bf16(vf, sstep ? pf1 : pf0, o0, 0, 0, 0);
                else         o1 = __builtin_amdgcn_mfma_f32_32x32x16_bf16(vf, sstep ? pf1 : pf0, o1, 0, 0, 0);
            }
        }
        }
        if (PMODE == 1) continue;
#pragma unroll
        for (int c = 0; c < 4; ++c) { kA[c] = kB[c]; vA[c] = vB[c]; }
    }
    const float inv = 1.0f / (lrun + __shfl_xor(lrun, 32));
    bf16* orow = YATT + (size_t)(b * SEQ + qpos) * AW + head * HD + 4 * h;
#pragma unroll
    for (int gq = 0; gq < 4; ++gq) {
        u32x2v a, c; a.x = pk2(o0[4 * gq] * inv, o0[4 * gq + 1] * inv); a.y = pk2(o0[4 * gq + 2] * inv, o0[4 * gq + 3] * inv);
        c.x = pk2(o1[4 * gq] * inv, o1[4 * gq + 1] * inv); c.y = pk2(o1[4 * gq + 2] * inv, o1[4 * gq + 3] * inv);
        *(u32x2v*)(orow + 8 * gq) = a; *(u32x2v*)(orow + 32 + 8 * gq) = c; }
}

__device__ __forceinline__ int krp(int key) { return (key & 0x16) | ((key >> 3) & 1) | ((key & 1) << 3); }
__device__ __forceinline__ void item2(int it, const bf16* PROJ, bf16* YATT, LAS char* wl, int lane) {
    const int bh = it >> 6, jj = it & 63; const int b = bh / NH, head = bh - b * NH, mb = 15 - (jj >> 2), r4 = jj & 3;
    const int m0 = mb * 32, q = lane & 31, h = lane >> 5;
    const int qpos = r4 + 4 * (m0 + q), bq2 = m0 + q;
    const bf16* base = PROJ + (size_t)b * SEQ * PINC;
    const bf16* Kb = base + KOFF + head * HD; const bf16* Vb = base + VOFF + head * HD;
    const int first1 = (mb == 0) ? 4 : 0, first2 = (mb < 4) ? 4 - mb : 0, n1 = 8 - first1, n2 = 5 - first2, ntile = n1 + n2 + mb + 1, npair = (ntile + 1) >> 1;
    u32x4 k0[4], v0[4], k1[4], v1[4];
    { const TileD d0 = tile_desc(0, n1, n2, first1, first2, m0, r4); ATT_LOADT(k0, v0, d0); }
    { const TileD d1 = tile_desc(ntile > 1 ? 1 : 0, n1, n2, first1, first2, m0, r4); ATT_LOADT(k1, v1, d1); }
    s16x8 qf[4];
    { const bf16* qp = base + (size_t)qpos * PINC + QOFF + head * HD + 8 * h;
#pragma unroll
      for (int d0 = 0; d0 < 4; ++d0) qf[d0] = __builtin_bit_cast(s16x8, *(const GAS u32x4*)(qp + 16 * d0)); }
    f32x16 o0 = {}, o1 = {}; float mrun = -1e30f, lrun = 0.f;
    const int g = lane >> 4, qq = (lane & 15) >> 2, pp = lane & 3;
    int kws[4];
#pragma unroll
    for (int j = 0; j < 4; ++j) { const int key = 8 * j + (lane >> 3); kws[j] = krp(key) * 128 + (((lane & 7) ^ (key & 7)) << 4); }
    const int vws = (lane >> 3) * 128 + (lane & 7) * 16;
    const int kfr = krp(q) * 128, kx = q & 7;
    const int vfr = (4 * h + qq) * 128 + (16 * (g & 1) + 4 * pp) * 2;
#define ATT2_MASK(S, D, T0) do { if ((D).mod4) { _Pragma("unroll") for (int r = 0; r < 16; ++r) { const int dd = (T0) - ((r & 3) + 8 * (r >> 2)); S[r] = (dd >= 0 && (dd & 3) == 0) ? S[r] : -INFINITY; mx = fmaxf(mx, S[r]); } } \
        else { const unsigned W_ = (unsigned)(D).W; _Pragma("unroll") for (int r = 0; r < 16; ++r) { const int dd = (T0) - ((r & 3) + 8 * (r >> 2)); S[r] = ((unsigned)dd <= W_) ? S[r] : -INFINITY; mx = fmaxf(mx, S[r]); } } } while (0)
#pragma unroll 1
    for (int p = 0; p < npair; ++p) {
        const bool nul1 = (2 * p + 1 >= ntile);
        const TileD dA = tile_desc(2 * p, n1, n2, first1, first2, m0, r4), dB = tile_desc(nul1 ? 2 * p : 2 * p + 1, n1, n2, first1, first2, m0, r4);
#pragma unroll
        for (int j = 0; j < 4; ++j) { *(LAS u32x4*)(wl + kws[j]) = k0[j]; *(LAS u32x4*)(wl + 4096 + vws + 1024 * j) = v0[j]; *(LAS u32x4*)(wl + 8192 + kws[j]) = k1[j]; *(LAS u32x4*)(wl + 12288 + vws + 1024 * j) = v1[j]; }
        { const int ua = (2 * p + 2 < ntile) ? 2 * p + 2 : ntile - 1, ub = (2 * p + 3 < ntile) ? 2 * p + 3 : ntile - 1;
          const TileD na = tile_desc(ua, n1, n2, first1, first2, m0, r4), nb = tile_desc(ub, n1, n2, first1, first2, m0, r4); ATT_LOADT(k0, v0, na); ATT_LOADT(k1, v1, nb); }
        f32x16 sA = {}, sB = {};
#pragma unroll
        for (int d0 = 0; d0 < 4; ++d0) { const int co = ((2 * d0 + h) ^ kx) << 4;
            sA = __builtin_amdgcn_mfma_f32_32x32x16_bf16(*(const LAS s16x8*)(wl + kfr + co), qf[d0], sA, 0, 0, 0);
            sB = __builtin_amdgcn_mfma_f32_32x32x16_bf16(*(const LAS s16x8*)(wl + 8192 + kfr + co), qf[d0], sB, 0, 0, 0); }
        const int t0A = (dA.sel ? bq2 : qpos) - dA.abase - 4 * h; const int t0B = nul1 ? -(1 << 20) : ((dB.sel ? bq2 : qpos) - dB.abase - 4 * h);
        float mx = -INFINITY;
        ATT2_MASK(sA, dA, t0A); ATT2_MASK(sB, dB, t0B);
        mx = fmaxf(mx, __shfl_xor(mx, 32));
        const float mnew = fmaxf(mrun, mx), alpha = __builtin_amdgcn_exp2f(mrun - mnew); mrun = mnew;
        float ps = 0.f;
#pragma unroll
        for (int r = 0; r < 16; ++r) { sA[r] = __builtin_amdgcn_exp2f(sA[r] - mnew); sB[r] = __builtin_amdgcn_exp2f(sB[r] - mnew); ps += sA[r] + sB[r]; }
        lrun = lrun * alpha + ps;
#pragma unroll
        for (int r = 0; r < 16; ++r) { o0[r] *= alpha; o1[r] *= alpha; }
        u32x4 pa0, pa1, pb0, pb1;
        pa0.x = pk2(sA[0], sA[1]); pa0.y = pk2(sA[2], sA[3]); pa0.z = pk2(sA[4], sA[5]); pa0.w = pk2(sA[6], sA[7]);
        pa1.x = pk2(sA[8], sA[9]); pa1.y = pk2(sA[10], sA[11]); pa1.z = pk2(sA[12], sA[13]); pa1.w = pk2(sA[14], sA[15]);
        pb0.x = pk2(sB[0], sB[1]); pb0.y = pk2(sB[2], sB[3]); pb0.z = pk2(sB[4], sB[5]); pb0.w = pk2(sB[6], sB[7]);
        pb1.x = pk2(sB[8], sB[9]); pb1.y = pk2(sB[10], sB[11]); pb1.z = pk2(sB[12], sB[13]); pb1.w = pk2(sB[14], sB[15]);
#pragma unroll
        for (int tt = 0; tt < 2; ++tt) { LAS const char* vb = wl + 4096 + 8192 * tt + vfr;
#pragma unroll
            for (int sstep = 0; sstep < 2; ++sstep) { const s16x8 pf = __builtin_bit_cast(s16x8, tt ? (sstep ? pb1 : pb0) : (sstep ? pa1 : pa0));
#pragma unroll
                for (int dh = 0; dh < 2; ++dh) {
                    const s16x4 lo = vtr(vb + (16 * sstep) * 128 + dh * 64), hi = vtr(vb + (16 * sstep + 8) * 128 + dh * 64);
                    const s16x8 vf = (s16x8){lo[0], lo[1], lo[2], lo[3], hi[0], hi[1], hi[2], hi[3]};
                    if (dh == 0) o0 = __builtin_amdgcn_mfma_f32_32x32x16_bf16(vf, pf, o0, 0, 0, 0);
                    else         o1 = __builtin_amdgcn_mfma_f32_32x32x16_bf16(vf, pf, o1, 0, 0, 0); } } }
    }
#undef ATT2_MASK
    const float inv = 1.0f / (lrun + __shfl_xor(lrun, 32));
    bf16* orow = YATT + (size_t)(b * SEQ + qpos) * AW + head * HD + 4 * h;
#pragma unroll
    for (int gq = 0; gq < 4; ++gq) {
        u32x2v a, c; a.x = pk2(o0[4 * gq] * inv, o0[4 * gq + 1] * inv); a.y = pk2(o0[4 * gq + 2] * inv, o0[4 * gq + 3] * inv);
        c.x = pk2(o1[4 * gq] * inv, o1[4 * gq + 1] * inv); c.y = pk2(o1[4 * gq + 2] * inv, o1[4 * gq + 3] * inv);
        *(u32x2v*)(orow + 8 * gq) = a; *(u32x2v*)(orow + 32 + 8 * gq) = c; }
}
}

struct Args { const float* in[15]; float* out; unsigned char* ws; int ph_lo, ph_hi; };
static_assert(sizeof(Args) == 15 * 8 + 8 + 8 + 8, "Args has no padding");

__global__ void __launch_bounds__(NWAVES * 64, 2) fwd(Args args) {
    extern __shared__ __attribute__((aligned(16))) unsigned char lds[];
    LAS unsigned char* L = (LAS unsigned char*)lds;
    volatile LAS unsigned* MISC = (volatile LAS unsigned*)(L + MISC_OFF);
    const int tid = threadIdx.x, lane = tid & 63, wave = __builtin_amdgcn_readfirstlane(tid >> 6);
    const int G = gridDim.x; const int bx = blockIdx.x; const int vcu = (G % 8 == 0) ? (bx % 8) * (G / 8) + bx / 8 : bx;
    unsigned char* ws = args.ws;
    gu32* ctl = (gu32*)(ws + WS_CTL);
    const float* x = args.in[0]; const float* mix_g = args.in[1]; const float* w_in = args.in[2]; const float* conv_w = args.in[3]; const float* conv_g = args.in[4];
    const float* attn_g = args.in[5]; const float* w_out = args.in[6]; const float* ffn_g = args.in[7]; const float* w_router = args.in[8]; const float* b_router = args.in[9];
    const float* w_gu = args.in[10]; const float* b_gu = args.in[11]; const float* w_dn = args.in[12]; const float* b_dn = args.in[13]; const float* fin_g = args.in[14];
    float* out = args.out;
    float* ROPE = (float*)(ws + WS_ROPE); unsigned char* GWF = ws + WS_ROPE + 256 * 1024;
    int* TOKE = (int*)(ws + WS_TOKE); int* TOKR = (int*)(ws + WS_TOKR); float* TOKG = (float*)(ws + WS_TOKG); int* LIST = (int*)(ws + WS_LIST);
    bf16* WIN = (bf16*)(ws + WS_WIN); bf16* WO = (bf16*)(ws + WS_WO); bf16* XN = (bf16*)(ws + WS_XN); bf16* PROJ = (bf16*)(ws + WS_PROJ); bf16* YATT = (bf16*)(ws + WS_YATT);
    bf16* MIXED = (bf16*)(ws + WS_MIXED); float* X1 = (float*)(ws + WS_X1); unsigned char* XN2 = ws + WS_XN2; unsigned char* XS = ws + WS_XS; unsigned char* ACT = ws + WS_ACT;
    bf16* YB = (bf16*)(ws + WS_Y); unsigned char* WGU = ws + WS_WGU; unsigned char* WDN = ws + WS_WDN;

    for (int u = tid; u < (LDS_BYTES - LDSCTL_OFF) / 4; u += NWAVES * 64) ((LAS unsigned*)(L + LDSCTL_OFF))[u] = 0u;
    __syncthreads();
    XcdBarrier bar; bar.bar = (unsigned*)(ctl + CW_BAR); bar.x = 0; bar.st = nullptr;
    if (MK_N_LAUNCHES == 1) bar = xcd_barrier_post((unsigned*)(ctl + CW_BAR), MISC + 8);
    const int lo = args.ph_lo, hi = args.ph_hi;
#define IN(k) (lo <= (k) && (k) < hi)
#define BOTH(k) (IN(k) && IN((k) + 1))
#define GRID_BAR() do { if (MK_N_LAUNCHES == 1) xcd_barrier(bar); } while (0)
    const int gw = vcu * NWAVES + wave, NGW = G * NWAVES;
    const bool side_on = (MK_N_LAUNCHES == 1) && (G == 256) && (SIDE_CONV != 0);

    if (IN(0)) for (int rep = 0; rep < REPS(0); ++rep) {
        AMP_BEGIN(0);
        LAS float* scr = (LAS float*)(L + wave * 16384);
        constexpr int I_IN = 32 * (INC / 32), I_O = 32 * (DM / 32);
        constexpr int NIT = I_IN + I_O;
#define P0_DEC(itx, W_, N_, WT_, k0_, n0_) do { int r_ = (itx); if (r_ < I_IN) { W_ = w_in; N_ = INC; WT_ = WIN; } else { r_ -= I_IN; W_ = w_out; N_ = DM; WT_ = WO; } const int nblk_ = N_ / 32, kb_ = r_ / nblk_; k0_ = 64 * kb_; n0_ = 32 * (r_ - kb_ * nblk_); } while (0)
#define P0_LOAD(R, W_, N_, k0_, n0_) do { _Pragma("unroll") for (int i = 0; i < 32; ++i) { const int kk = 2 * i + (lane >> 5); R[i] = __builtin_nontemporal_load(W_ + (size_t)(k0_ + kk) * N_ + n0_ + (lane & 31)); } } while (0)
        if (gw < NIT) {
            const float* Wc; int Nc, k0c, n0c; bf16* WTc; P0_DEC(gw, Wc, Nc, WTc, k0c, n0c);
            float rr[32]; P0_LOAD(rr, Wc, Nc, k0c, n0c);
            for (int it = gw; it < NIT; it += NGW) {
                const int nx = (it + NGW < NIT) ? it + NGW : it;
                const float* Wn; int Nn, k0n, n0n; bf16* WTn; P0_DEC(nx, Wn, Nn, WTn, k0n, n0n);
                float rn[32]; P0_LOAD(rn, Wn, Nn, k0n, n0n);
#pragma unroll
                for (int i = 0; i < 32; ++i) { const int kk = 2 * i + (lane >> 5); scr[kk * 33 + (lane & 31)] = rr[i]; }
                LDS_WAIT(); asm volatile("" ::: "memory");
                const int c = lane & 7;
#pragma unroll
                for (int j = 0; j < 4; ++j) { const int n = (lane >> 3) + 8 * j; const LAS float* s = scr + (8 * c) * 33 + n;
                    v4u o; o.x = pk2(s[0 * 33], s[1 * 33]); o.y = pk2(s[2 * 33], s[3 * 33]); o.z = pk2(s[4 * 33], s[5 * 33]); o.w = pk2(s[6 * 33], s[7 * 33]);
                    *(GAS v4u*)(WTc + (size_t)(n0c + n) * DM + k0c + 8 * c) = o; }
                LDS_WAIT(); asm volatile("" ::: "memory");
#pragma unroll
                for (int i = 0; i < 32; ++i) rr[i] = rn[i];
                Wc = Wn; Nc = Nn; WTc = WTn; k0c = k0n; n0c = n0n;
            }
        }
#undef P0_DEC
#undef P0_LOAD
        for (int i = gw * 64 + lane; i < SEQ * 8; i += NGW * 64) { const int pos = i >> 3, f = i & 7;
            const float inv_freq = exp2f(-(float)f * 0.125f * 18.931568569324174f);
            const float ang = (float)pos * inv_freq;
            const double a = (double)ang; const double k = rint(a * 0.15915494309189535); const float red = (float)(a - k * 6.283185307179586);
            ROPE[pos * 16 + f] = cosf(red); ROPE[pos * 16 + 8 + f] = sinf(red); }
        for (int i = gw * 64 + lane; i < 64 * 2 * 64; i += NGW * 64) { const int ln = i & 63, eb = (i >> 6) & 1, ks = i >> 7; const int e = 16 * eb + (ln & 15), k0 = 32 * ks + 8 * (ln >> 4);
            unsigned hi[4], lo[4];
#pragma unroll
            for (int j = 0; j < 4; ++j) { const float v0 = w_router[(size_t)(k0 + 2 * j) * NE + e] * ffn_g[k0 + 2 * j], v1 = w_router[(size_t)(k0 + 2 * j + 1) * NE + e] * ffn_g[k0 + 2 * j + 1];
                const unsigned h0 = f2bf(v0), h1 = f2bf(v1); hi[j] = h0 | (h1 << 16); lo[j] = pk2(v0 - __uint_as_float(h0 << 16), v1 - __uint_as_float(h1 << 16)); }
            v4u* dst = (v4u*)GWF + ((size_t)(ks * 2 + eb) * 2) * 64 + ln; dst[0] = (v4u){hi[0], hi[1], hi[2], hi[3]}; dst[64] = (v4u){lo[0], lo[1], lo[2], lo[3]}; }
        if (gw < NTOK) {
            const GAS f32x4* gr = (const GAS f32x4*)mix_g + lane; f32x4 gg8[8];
#pragma unroll
            for (int j = 0; j < 8; ++j) gg8[j] = gr[64 * j];
            f32x4 v[8];
            { const GAS f32x4* xr = (const GAS f32x4*)(x + (size_t)gw * DM) + lane;
#pragma unroll
              for (int j = 0; j < 8; ++j) v[j] = __builtin_nontemporal_load(xr + 64 * j); }
            for (int m = gw; m < NTOK; m += NGW) {
                const int mn = (m + NGW < NTOK) ? m + NGW : m; const GAS f32x4* xn = (const GAS f32x4*)(x + (size_t)mn * DM) + lane; f32x4 nv[8];
#pragma unroll
                for (int j = 0; j < 8; ++j) nv[j] = __builtin_nontemporal_load(xn + 64 * j);
                float s = 0.f;
#pragma unroll
                for (int j = 0; j < 8; ++j) s += (v[j].x * v[j].x + v[j].y * v[j].y) + (v[j].z * v[j].z + v[j].w * v[j].w);
                const float rstd = 1.0f / sqrtf(wave_sum(s) * (1.0f / DM) + EPS);
                GAS u32x2v* o8 = (GAS u32x2v*)(XN + (size_t)m * DM) + lane;
#pragma unroll
                for (int j = 0; j < 8; ++j) { const f32x4 gg = gg8[j]; u32x2v o; o.x = pk2(v[j].x * rstd * gg.x, v[j].y * rstd * gg.y); o.y = pk2(v[j].z * rstd * gg.z, v[j].w * rstd * gg.w); o8[64 * j] = o; }
#pragma unroll
                for (int j = 0; j < 8; ++j) v[j] = nv[j];
            }
        }
        AMP_END(0);
        if (BOTH(0)) GRID_BAR();
    }

    const int ga = (side_on && (SIDE_CONV & 1)) ? 16 : 0, gb = (side_on && (SIDE_CONV & 2)) ? 32 : 0;
    const int cv_lo = ga < gb ? ga : gb, cv_hi = ga < gb ? gb : ga, cv_pn = ga < gb ? 256 : 128, cv_po = ga < gb ? 0 : 256;
    const int nconv_eff = (cv_hi - cv_lo) * cv_pn + (NE - cv_hi) * PER_E;
#define CV_MAP(ci) ((ci) < (cv_hi - cv_lo) * cv_pn ? (cv_lo + (ci) / cv_pn) * PER_E + cv_po + (ci) % cv_pn : (cv_hi + ((ci) - (cv_hi - cv_lo) * cv_pn) / PER_E) * PER_E + ((ci) - (cv_hi - cv_lo) * cv_pn) % PER_E)
#define RUN_P2(ATTW, QA, QC, TRIED0, STOPW, STOPN) do { \
        LAS char* vl = (LAS char*)(L + wave * 16384); \
        LAS unsigned char* T = L + wave * 16384; \
        int mode = (wave < (ATTW)) ? 0 : 1, tried = (TRIED0), aq = 0; const int xcc = (int)xb_xcc_id() & 7; \
        while (tried < 2) { \
            if (mode == 0) { \
                  \
                bool got = false; \
                while (aq < 8) { const int qx = (xcc + aq) & 7; int idx = 0; if (lane == 0) idx = (int)__hip_atomic_fetch_add(ctl + (QA) + 16 * qx, 1u, __ATOMIC_RELAXED, __HIP_MEMORY_SCOPE_AGENT); \
                    idx = __builtin_amdgcn_readfirstlane(idx); \
                    if (idx < 768) { const int it = 64 * (qx + 8 * (idx >> 6)) + (idx & 63); __builtin_amdgcn_s_setprio(0); att::ATT_ITEM(it, PROJ, YATT, vl, lane); __builtin_amdgcn_s_setprio(0); got = true; break; } \
                    ++aq; } \
                if (got) continue; \
            } else { \
                 \
                int it = 0; if (lane == 0) it = (int)__hip_atomic_fetch_add(ctl + (QC), 1u, __ATOMIC_RELAXED, __HIP_MEMORY_SCOPE_AGENT); \
                it = __builtin_amdgcn_readfirstlane(it); \
                if (it < nconv_eff) { \
                    ConvDesc cur = conv_decode(CV_MAP(it), w_gu, w_dn, WGU, WDN, lane); \
                    f32x4 ra[8], rb[8]; \
                    CV_LOAD(ra, cur, 0); \
                    bool stop = false; \
                    for (;;) { \
                        int nx = nconv_eff; if (!stop && lane == 0) nx = (int)__hip_atomic_fetch_add(ctl + (QC), 1u, __ATOMIC_RELAXED, __HIP_MEMORY_SCOPE_AGENT); \
                        unsigned sv = 0u; if ((STOPW) >= 0) sv = __hip_atomic_load(ctl + ((STOPW) >= 0 ? (STOPW) : 0), __ATOMIC_RELAXED, __HIP_MEMORY_SCOPE_AGENT); \
_Pragma("unroll 1") \
                        for (int g = 0; g < CV_NG - 2; g += 2) { CV_LOAD(rb, cur, g + 1); CV_PROC(ra, cur, g); CV_LOAD(ra, cur, g + 2); CV_PROC(rb, cur, g + 1); } \
                        CV_LOAD(rb, cur, CV_NG - 1); CV_PROC(ra, cur, CV_NG - 2); \
                        nx = __builtin_amdgcn_readfirstlane(nx); const bool more = nx < nconv_eff; \
                        const ConvDesc nd = conv_decode(CV_MAP(more ? nx : it), w_gu, w_dn, WGU, WDN, lane); \
                        CV_LOAD(ra, nd, 0);                                   \
                        CV_PROC(rb, cur, CV_NG - 1); \
                        if ((STOPW) >= 0) stop = (unsigned)__builtin_amdgcn_readfirstlane((int)sv) >= (unsigned)(STOPN); \
                        if (!more) break; \
                        cur = nd; it = nx; \
                    } \
                } \
            } \
            if (mode == 0 && (ATTW) < 8 && (ATTW) > 0 && ATT_NOFALL && wave < (ATTW) - ATT_JOIN) break;     \
            mode ^= 1; ++tried; \
        } \
    } while (0)
    if (IN(1)) {
        AMP_BEGIN(1);
        const bool split = (MK_N_LAUNCHES == 1) && (G == 256) && (SPLIT_P1 != 0);
        const bool conv_wg = split && (((bx >> 3) & 1) == 1);
        if (!conv_wg) {
            pg8::Gemm g{XN, WIN, NTOK, INC, DM}; pg8::StaticOrder S; S.init(NTOK, INC, split ? 128 : G, split ? (((bx >> 4) << 3) | (bx & 7)) : bx);
            pg8::EpiProj E{PROJ, ROPE, att::C2};
            if (side_on && (SIDE_CONV & 1)) { pg8::SideConv SD{w_gu, WGU, 4096, 128 * bx, 96, (unsigned)PART_OFF, PWG}; pg8::gemm_phase<pg8::EpiProj, pg8::StaticOrder, true, true, false, false, pg8::SideConv>(L, g, S, E, SD); }
            else pg8::gemm_phase<pg8::EpiProj, pg8::StaticOrder, true, true>(L, g, S, E);
            __syncthreads();
            if (tid == 0) __hip_atomic_fetch_add(ctl + CW_P1DONE, 1u, __ATOMIC_RELAXED, __HIP_MEMORY_SCOPE_AGENT);
        } else {
            RUN_P2(0, CW_ATTQ, CW_CONVQ, 1, CW_P1DONE, 128);
        }
        AMP_END(1);
        if (BOTH(1)) GRID_BAR();
    }

    if (IN(2)) {
        AMP_BEGIN(2);
        RUN_P2(ATT_WAVES, CW_ATTQ, CW_CONVQ, 0, -1, 0);
        AMP_END(2);
        if (BOTH(2)) GRID_BAR();
        if ((PROBE_MASK >> 10) & 1) { RUN_P2(0, CW_ATTQ, CW_CONVQ + 64, 0, -1, 0); GRID_BAR(); }
        if ((PROBE_MASK >> 12) & 1) {
            unsigned char* SCR = ws + (size_t)2048 * MiB;
            for (int itp = gw; itp < 2 * NE * 1024; itp += NGW) {
                const int isdn = itp >= NE * 1024; const int r = isdn ? itp - NE * 1024 : itp; const int e = r >> 10, kp = r & 1023; const int N = isdn ? 2048 : 4096;
                const float* s0 = (isdn ? w_dn + (size_t)e * 2048 * 2048 : w_gu + (size_t)e * 2048 * 4096) + (size_t)(2 * kp) * N + 4 * lane; const float* s1 = s0 + N;
                unsigned char* d = SCR + (isdn ? (size_t)NE * 1024 * 8192 + ((size_t)e * 1024 + kp) * 4096 : ((size_t)e * 1024 + kp) * 8192) + 8 * lane;
                for (int i0 = 0; i0 < N / 256; i0 += 8) {
                    f32x4 a[8], c[8];
#pragma unroll
                    for (int i = 0; i < 8; ++i) { a[i] = *(const GAS f32x4*)(s0 + 256 * (i0 + i)); c[i] = *(const GAS f32x4*)(s1 + 256 * (i0 + i)); }
#pragma unroll
                    for (int i = 0; i < 8; ++i) { u32x2v o; o.x = pk4_fp8_nc(64.f * a[i][0], 64.f * c[i][0], 64.f * a[i][1], 64.f * c[i][1]); o.y = pk4_fp8_nc(64.f * a[i][2], 64.f * c[i][2], 64.f * a[i][3], 64.f * c[i][3]);
                        *(GAS u32x2v*)(d + 512 * (i0 + i)) = o; }
                }
            }
            GRID_BAR();
        }
        if ((PROBE_MASK >> 14) & 1) { RUN_P2(ATT_WAVES, CW_ATTQ + 2048, CW_CONVQ + 192, 0, -1, 0); GRID_BAR(); }
        if ((PROBE_MASK >> 13) & 1) { RUN_P2(4, CW_ATTQ, CW_CONVQ + 128, 1, -1, 0); GRID_BAR(); }
        if ((PROBE_MASK >> 15) & 1) { for (;;) { int it = 0; if (lane == 0) it = (int)__hip_atomic_fetch_add(ctl + CW_ATTQ + 256 + 64, 1u, __ATOMIC_RELAXED, __HIP_MEMORY_SCOPE_AGENT); it = __builtin_amdgcn_readfirstlane(it); if (it >= att::NITEMS) break;
            att::item<1>(it, PROJ, (bf16*)(ws + (size_t)3000 * MiB), (LAS char*)(L + wave * 16384), lane); } GRID_BAR(); }
        if ((PROBE_MASK >> 16) & 1) { for (;;) { int it = 0; if (lane == 0) it = (int)__hip_atomic_fetch_add(ctl + CW_ATTQ + 256 + 128, 1u, __ATOMIC_RELAXED, __HIP_MEMORY_SCOPE_AGENT); it = __builtin_amdgcn_readfirstlane(it); if (it >= att::NITEMS) break;
            att::item<2>(it, PROJ, (bf16*)(ws + (size_t)3000 * MiB), (LAS char*)(L + wave * 16384), lane); } GRID_BAR(); }
        if ((PROBE_MASK >> 11) & 1) { RUN_P2(8, CW_ATTQ + 1024, CW_CONVQ, 0, -1, 0); GRID_BAR(); }
    }

    if (IN(3)) for (int rep = 0; rep < REPS(3); ++rep) {
        AMP_BEGIN(3);
        float cw0[8], cw1[8], cw2[8], cgq[8], agq[3][8];
#pragma unroll
        for (int j = 0; j < 8; ++j) { const int c = 8 * lane + j; cw0[j] = conv_w[c]; cw1[j] = conv_w[CW + c]; cw2[j] = conv_w[2 * CW + c]; cgq[j] = conv_g[c]; agq[0][j] = attn_g[c]; agq[1][j] = attn_g[512 + c]; agq[2][j] = attn_g[1024 + c]; }
#define P3_LOAD(A, CX, CC, CB, mm) do { const int sp_ = (mm) & (SEQ - 1); const bf16* ya_ = YATT + (size_t)(mm) * AW + 8 * lane; const bf16* pr_ = PROJ + (size_t)(mm) * PINC + 8 * lane; \
            _Pragma("unroll") for (int j = 0; j < 3; ++j) A[j] = *(const v4u*)(ya_ + 512 * j); \
            _Pragma("unroll") for (int d = 0; d < 3; ++d) { const int back = 2 - d; const bool ok_ = sp_ >= back; const bf16* q_ = ok_ ? pr_ - (size_t)back * PINC : pr_; CX[d] = *(const v4u*)q_; CC[d] = *(const v4u*)(q_ + 2 * CW); \
                if (!ok_) { CX[d] = (v4u){0u, 0u, 0u, 0u}; } } \
            CB = *(const v4u*)(pr_ + CW); } while (0)
        v4u a[3], cx[3], cc[3], cb;
        if (gw < NTOK) P3_LOAD(a, cx, cc, cb, gw);
        for (int m = gw; m < NTOK; m += NGW) {
            v4u na[3], ncx[3], ncc[3], ncb; const int mn = (m + NGW < NTOK) ? m + NGW : m;
            P3_LOAD(na, ncx, ncc, ncb, mn);
            float u[3][8];
#pragma unroll
            for (int d = 0; d < 3; ++d) {
                u[d][0] = bf_lo(cx[d].x) * bf_lo(cc[d].x); u[d][1] = bf_hi(cx[d].x) * bf_hi(cc[d].x); u[d][2] = bf_lo(cx[d].y) * bf_lo(cc[d].y); u[d][3] = bf_hi(cx[d].y) * bf_hi(cc[d].y);
                u[d][4] = bf_lo(cx[d].z) * bf_lo(cc[d].z); u[d][5] = bf_hi(cx[d].z) * bf_hi(cc[d].z); u[d][6] = bf_lo(cx[d].w) * bf_lo(cc[d].w); u[d][7] = bf_hi(cx[d].w) * bf_hi(cc[d].w); }
            float bb[8] = {bf_lo(cb.x), bf_hi(cb.x), bf_lo(cb.y), bf_hi(cb.y), bf_lo(cb.z), bf_hi(cb.z), bf_lo(cb.w), bf_hi(cb.w)};
            float y[8]; float s = 0.f;
#pragma unroll
            for (int j = 0; j < 8; ++j) { const float acc = cw0[j] * u[0][j] + cw1[j] * u[1][j] + cw2[j] * u[2][j]; y[j] = bb[j] * acc; s += y[j] * y[j]; }
            float s2 = 0.f;
#pragma unroll
            for (int j = 0; j < 3; ++j) {
                const float f0 = bf_lo(a[j].x), f1 = bf_hi(a[j].x), f2 = bf_lo(a[j].y), f3 = bf_hi(a[j].y), f4 = bf_lo(a[j].z), f5 = bf_hi(a[j].z), f6 = bf_lo(a[j].w), f7 = bf_hi(a[j].w);
                s2 += (f0 * f0 + f1 * f1) + (f2 * f2 + f3 * f3) + (f4 * f4 + f5 * f5) + (f6 * f6 + f7 * f7); }
#pragma unroll
            for (int o = 1; o < 64; o <<= 1) { s += __shfl_xor(s, o); s2 += __shfl_xor(s2, o); }
            const float rc = 1.0f / sqrtf(s * (1.0f / CW) + EPS), ra = 1.0f / sqrtf(s2 * (1.0f / AW) + EPS);
            { v4u o;
              o.x = pk2(y[0] * rc * cgq[0], y[1] * rc * cgq[1]); o.y = pk2(y[2] * rc * cgq[2], y[3] * rc * cgq[3]); o.z = pk2(y[4] * rc * cgq[4], y[5] * rc * cgq[5]); o.w = pk2(y[6] * rc * cgq[6], y[7] * rc * cgq[7]);
              *(v4u*)(MIXED + (size_t)m * DM + 8 * lane) = o; }
#pragma unroll
            for (int j = 0; j < 3; ++j) { const float* gq = agq[j]; v4u o;
                o.x = pk2(bf_lo(a[j].x) * ra * gq[0], bf_hi(a[j].x) * ra * gq[1]); o.y = pk2(bf_lo(a[j].y) * ra * gq[2], bf_hi(a[j].y) * ra * gq[3]);
                o.z = pk2(bf_lo(a[j].z) * ra * gq[4], bf_hi(a[j].z) * ra * gq[5]); o.w = pk2(bf_lo(a[j].w) * ra * gq[6], bf_hi(a[j].w) * ra * gq[7]);
                *(v4u*)(MIXED + (size_t)m * DM + CW + 512 * j + 8 * lane) = o; }
#pragma unroll
            for (int j = 0; j < 3; ++j) { a[j] = na[j]; cx[j] = ncx[j]; cc[j] = ncc[j]; }
            cb = ncb;
        }
#undef P3_LOAD
        AMP_END(3);
        if (BOTH(3)) GRID_BAR();
    }

    if (IN(4)) for (int rep = 0; rep < REPS(4); ++rep) {
        AMP_BEGIN(4);
        pg8::Gemm g{MIXED, WO, NTOK, DM, DM}; pg8::StaticOrder S; S.init(NTOK, DM, G, (int)blockIdx.x);
        pg8::EpiResF32 E{x, X1, DM};
        if (side_on && (SIDE_CONV & 1)) { pg8::SideConv SD{w_gu, WGU, 4096, 128 * bx + 96, 32, (unsigned)PART_OFF, PWG}; pg8::gemm_phase<pg8::EpiResF32, pg8::StaticOrder, false, true, false, false, pg8::SideConv>(L, g, S, E, SD); }
        else pg8::gemm_phase<pg8::EpiResF32, pg8::StaticOrder, false, true>(L, g, S, E);
        AMP_END(4);
        if (BOTH(4)) GRID_BAR();
    }

    if (IN(5)) for (int rep = 0; rep < REPS(5); ++rep) {
        AMP_BEGIN(5);
        const int cwc = CW_CNT + 2048 * rep; int* TOKE_ = TOKE + rep * (1 << 20); int* TOKR_ = TOKR + rep * (1 << 20); float* TOKG_ = TOKG + rep * (1 << 20); unsigned char* XS_ = XS + (size_t)rep * ((size_t)2752 * MiB - WS_XS);
        LAS float* X1L = (LAS float*)L; constexpr int XP = 2052;
        LAS float* PART = (LAS float*)(L + PART_OFF);
        const int e_ = lane & 31, kbase = 256 * wave + 128 * (lane >> 5);
        LAS int* LC = (LAS int*)(L + LDSCTL_OFF + 2048); LAS int* LB = (LAS int*)(L + LDSCTL_OFF + 2304);
        LAS int* AE = (LAS int*)(L + LDSCTL_OFF + 4096); LAS int* ALR = AE + 128; LAS float* AG = (LAS float*)(AE + 256); LAS float* RS = (LAS float*)(AE + 384);
        for (int blk = vcu; blk < NTOK / 32; blk += G) {
        if (tid < 32) LC[tid] = 0;
        __syncthreads();
        const int grp0 = 2 * blk;
#define P5_DMA_ISSUE(step) do { _Pragma("unroll") for (int r = 0; r < 2; ++r) _Pragma("unroll") for (int c = 0; c < 8; ++c) \
            __builtin_amdgcn_global_load_lds((const unsigned*)(X1 + (size_t)((grp0 + (step)) * 16 + 2 * wave + r) * DM + c * 256 + lane * 4), (LAS unsigned*)(L + (2 * wave + r) * (XP * 4) + c * 1024), 16, 0, 2); } while (0)
#define P5_DMA_WAIT() do { asm volatile("s_waitcnt vmcnt(0)" ::: "memory"); __syncthreads(); } while (0)
        P5_DMA_ISSUE(0);
        f32x4 fg8[8];
#pragma unroll
        for (int j = 0; j < 8; ++j) fg8[j] = ((const f32x4*)(ffn_g + 1024 * (j >> 2) + 16 * lane))[j & 3];
        for (int step = 0; step < 2; ++step) {
            v4u wfr[8][4];
#pragma unroll
            for (int s8 = 0; s8 < 8; ++s8) { const v4u* wf = (const v4u*)GWF + (size_t)((8 * wave + s8) * 4) * 64 + lane;
                wfr[s8][0] = wf[0]; wfr[s8][1] = wf[64]; wfr[s8][2] = wf[128]; wfr[s8][3] = wf[192]; }
            P5_DMA_WAIT();
            {
                typedef short s16x8b __attribute__((ext_vector_type(8)));
                f32x4 acc0 = {0.f, 0.f, 0.f, 0.f}, acc1 = acc0;
                const int tcol = lane & 15, kq = lane >> 4;
#pragma unroll
                for (int s8 = 0; s8 < 8; ++s8) { const int ks = 8 * wave + s8;
                    const LAS f32x4* xp = (const LAS f32x4*)(X1L + tcol * XP + 32 * ks + 8 * kq); const f32x4 xa = xp[0], xb = xp[1];
                    unsigned xh[4], xl[4];
                    xh[0] = cpk_bf16(xa.x, xa.y); xh[1] = cpk_bf16(xa.z, xa.w); xh[2] = cpk_bf16(xb.x, xb.y); xh[3] = cpk_bf16(xb.z, xb.w);
                    xl[0] = cpk_bf16(xa.x - bf_lo(xh[0]), xa.y - bf_hi(xh[0])); xl[1] = cpk_bf16(xa.z - bf_lo(xh[1]), xa.w - bf_hi(xh[1]));
                    xl[2] = cpk_bf16(xb.x - bf_lo(xh[2]), xb.y - bf_hi(xh[2])); xl[3] = cpk_bf16(xb.z - bf_lo(xh[3]), xb.w - bf_hi(xh[3]));
                    const s16x8b bxh = __builtin_bit_cast(s16x8b, (v4u){xh[0], xh[1], xh[2], xh[3]}), bxl = __builtin_bit_cast(s16x8b, (v4u){xl[0], xl[1], xl[2], xl[3]});
                    const s16x8b w0h = __builtin_bit_cast(s16x8b, wfr[s8][0]), w0l = __builtin_bit_cast(s16x8b, wfr[s8][1]), w1h = __builtin_bit_cast(s16x8b, wfr[s8][2]), w1l = __builtin_bit_cast(s16x8b, wfr[s8][3]);
                    acc0 = __builtin_amdgcn_mfma_f32_16x16x32_bf16(w0h, bxh, acc0, 0, 0, 0); acc0 = __builtin_amdgcn_mfma_f32_16x16x32_bf16(w0l, bxh, acc0, 0, 0, 0); acc0 = __builtin_amdgcn_mfma_f32_16x16x32_bf16(w0h, bxl, acc0, 0, 0, 0);
                    acc1 = __builtin_amdgcn_mfma_f32_16x16x32_bf16(w1h, bxh, acc1, 0, 0, 0); acc1 = __builtin_amdgcn_mfma_f32_16x16x32_bf16(w1l, bxh, acc1, 0, 0, 0); acc1 = __builtin_amdgcn_mfma_f32_16x16x32_bf16(w1h, bxl, acc1, 0, 0, 0); }
                *(LAS f32x4*)(PART + (wave * 16 + tcol) * 32 + 4 * kq) = acc0; *(LAS f32x4*)(PART + (wave * 16 + tcol) * 32 + 16 + 4 * kq) = acc1;
            }
            __syncthreads();
            v4u qw[2][2];
            {
                float tvv[2][4]; int tii[2][4];
#pragma unroll
                for (int r = 0; r < 2; ++r) { const int tl = 2 * wave + r;
                    const LAS f32x4* hp0 = (const LAS f32x4*)(X1L + tl * XP + 16 * lane); const LAS f32x4* hp1 = (const LAS f32x4*)(X1L + tl * XP + 1024 + 16 * lane); float ss = 0.f;
#pragma unroll
                    for (int j = 0; j < 4; ++j) { const f32x4 a = hp0[j], c = hp1[j]; ss += ((a.x * a.x + a.y * a.y) + (a.z * a.z + a.w * a.w)) + ((c.x * c.x + c.y * c.y) + (c.z * c.z + c.w * c.w)); }
                    const float rstd = 1.0f / sqrtf(wave_sum(ss) * (1.0f / DM) + EPS);
                    { const float sc = 16.f * rstd; v4u w0, w1;
                      { const f32x4 a = hp0[0] * fg8[0] * sc, c = hp0[1] * fg8[1] * sc, d = hp0[2] * fg8[2] * sc, f = hp0[3] * fg8[3] * sc;
                        w0.x = pg8::pk4_fp8(a.x, a.y, a.z, a.w); w0.y = pg8::pk4_fp8(c.x, c.y, c.z, c.w); w0.z = pg8::pk4_fp8(d.x, d.y, d.z, d.w); w0.w = pg8::pk4_fp8(f.x, f.y, f.z, f.w); }
                      { const f32x4 a = hp1[0] * fg8[4] * sc, c = hp1[1] * fg8[5] * sc, d = hp1[2] * fg8[6] * sc, f = hp1[3] * fg8[7] * sc;
                        w1.x = pg8::pk4_fp8(a.x, a.y, a.z, a.w); w1.y = pg8::pk4_fp8(c.x, c.y, c.z, c.w); w1.z = pg8::pk4_fp8(d.x, d.y, d.z, d.w); w1.w = pg8::pk4_fp8(f.x, f.y, f.z, f.w); }
                      qw[r][0] = w0; qw[r][1] = w1; }
                    float lg = -INFINITY;
                    if (lane < 32) { float s = 0.f;
#pragma unroll
                        for (int w = 0; w < 8; ++w) s += PART[(w * 16 + tl) * 32 + lane]; lg = s * rstd + b_router[lane]; }
                    int rank = 0; const int lgb = __float_as_int(lg);
#pragma unroll
                    for (int j = 0; j < 32; ++j) { const float vj = __int_as_float(__builtin_amdgcn_readlane(lgb, j)); rank += (vj > lg || (vj == lg && j < lane)) ? 1 : 0; }
#pragma unroll
                    for (int k = 0; k < 4; ++k) { const unsigned long long mk = __builtin_amdgcn_ballot_w64(lane < 32 && rank == k); const int idx = (int)__builtin_ctzll(mk);
                        tii[r][k] = idx; tvv[r][k] = __int_as_float(__builtin_amdgcn_readlane(lgb, idx)); } }
                if (lane < 8) { const int r = lane >> 2, k = lane & 3;
                    const float t0 = r ? tvv[1][0] : tvv[0][0], t1 = r ? tvv[1][1] : tvv[0][1], t2 = r ? tvv[1][2] : tvv[0][2], t3 = r ? tvv[1][3] : tvv[0][3];
                    const float e1 = __expf(t1 - t0), e2 = __expf(t2 - t0), e3 = __expf(t3 - t0); const float den = 1.0f / (1.0f + e1 + e2 + e3);
                    const int i0 = r ? tii[1][0] : tii[0][0], i1 = r ? tii[1][1] : tii[0][1], i2 = r ? tii[1][2] : tii[0][2], i3 = r ? tii[1][3] : tii[0][3];
                    const int ee = k == 0 ? i0 : k == 1 ? i1 : k == 2 ? i2 : i3; const float gg = (k == 0 ? 1.0f : k == 1 ? e1 : k == 2 ? e2 : e3) * den;
                    const int ai = (step * 16 + 2 * wave + r) * 4 + k;
                    AE[ai] = ee; ALR[ai] = __hip_atomic_fetch_add(LC + ee, 1, __ATOMIC_RELAXED, __HIP_MEMORY_SCOPE_WORKGROUP); AG[ai] = gg; }
            }
            __syncthreads();
            if (step == 0) P5_DMA_ISSUE(1);
            if (tid < 32) { const int c = LC[tid]; LC[tid] = 0; LB[tid] = c ? (int)__hip_atomic_fetch_add(ctl + cwc + 64 * tid, (unsigned)c, __ATOMIC_RELAXED, __HIP_MEMORY_SCOPE_AGENT) : 0; }
            __syncthreads();
#pragma unroll
            for (int r = 0; r < 2; ++r) { const int tl = 2 * wave + r; const int tok = (grp0 + step) * 16 + tl;
                int erank = 0;
#pragma unroll
                for (int k = 0; k < 4; ++k) { const int ai = (step * 16 + tl) * 4 + k; const int ee = AE[ai], rank = LB[ee] + ALR[ai];
                    unsigned char* row = XS_ + ((size_t)ee * NTOK + rank) * DM; *(GAS v4u*)(row + 16 * lane) = qw[r][0]; *(GAS v4u*)(row + 1024 + 16 * lane) = qw[r][1];
                    if (lane == k) erank = rank; }
                if (lane < 4) { const int ai = (step * 16 + tl) * 4 + lane; TOKE_[tok * 4 + lane] = AE[ai]; TOKR_[tok * 4 + lane] = erank; TOKG_[tok * 4 + lane] = AG[ai]; } }
        }
        __syncthreads();
        }
#undef P5_DMA_ISSUE
#undef P5_DMA_WAIT
        AMP_END(5);
        if (BOTH(5)) GRID_BAR();
    }

    LAS int* TS = (LAS int*)(L + TAB_TS); LAS int* CN = (LAS int*)(L + TAB_CN);
    if (hi > 6) {
        if (tid < NE) CN[tid] = (int)__hip_atomic_load(ctl + CW_CNT + 64 * tid, __ATOMIC_RELAXED, __HIP_MEMORY_SCOPE_AGENT);
        __syncthreads();
        if (tid == 0) { int acc = 0, acch = 0; for (int e = 0; e < NE; ++e) { const int c = CN[e]; TS[e] = acc; TS[33 + e] = acch;
            const int ntl = (c + 255) >> 8, hf = (c > 0 && c - ((ntl - 1) << 8) <= 128) ? 1 : 0; acc += ntl - hf; acch += hf; } TS[NE] = acc; TS[33 + NE] = acch; }
        __syncthreads();
    }


    if (IN(7)) for (int rep = 0; rep < REPS(7); ++rep) {
        AMP_BEGIN(7);
        {
        pg8::GroupedOrder S{(const PG8_LAS int*)TS, (const PG8_LAS int*)CN, 16, G, vcu, (long)1024 * PWG, 128 * 2};
        pg8::EpiSwiGLU E{ACT, b_gu};
        pg8::Gemm g{(const pg8::bf16_t*)XS, (const pg8::bf16_t*)WGU, MAXSLOT, NE * 4096, DM / 2, PWG / 2, 2048 * 2};
        if (side_on && (SIDE_CONV & 2)) { pg8::SideConv SD{w_dn, WDN, 2048, 128 * bx, 128, (unsigned)PART_OFF, 4096}; pg8::gemm_phase<pg8::EpiSwiGLU, pg8::GroupedOrder, true, true, true, true, pg8::SideConv>(L, g, S, E, SD); }
        else pg8::gemm_phase<pg8::EpiSwiGLU, pg8::GroupedOrder, true, true, true, true>(L, g, S, E); }
        AMP_END(7);
        if (BOTH(7)) GRID_BAR();
    }

    if (IN(8)) for (int rep = 0; rep < REPS(8); ++rep) {
        AMP_BEGIN(8);
        {
        pg8::GroupedOrder S{(const PG8_LAS int*)TS, (const PG8_LAS int*)CN, 8, G, vcu, (long)1024 * 2048 * 2, 256 * 2};
        pg8::EpiFp8Y E{(unsigned char*)YB, 1.0f / (pg8::FP8_W_SCALE * pg8::FP8_ACT_SCALE), b_dn};
        pg8::Gemm g{(const pg8::bf16_t*)ACT, (const pg8::bf16_t*)WDN, MAXSLOT, NE * 2048, DE / 2, 2048, 128 * 2};
        pg8::gemm_phase<pg8::EpiFp8Y, pg8::GroupedOrder, true, true, true, true>(L, g, S, E); }
        AMP_END(8);
        if (BOTH(8)) GRID_BAR();
    }

    if (IN(9)) for (int rep = 0; rep < REPS(9); ++rep) {
        AMP_BEGIN(9);
        unsigned poison = __hip_atomic_load(ctl + CW_BAR + XB_TMO, RLX_AGENT) != 0u;
        const f32x4 g8[8] = {((const GAS f32x4*)fin_g + lane)[0], ((const GAS f32x4*)fin_g + lane)[64], ((const GAS f32x4*)fin_g + lane)[128], ((const GAS f32x4*)fin_g + lane)[192], ((const GAS f32x4*)fin_g + lane)[256], ((const GAS f32x4*)fin_g + lane)[320], ((const GAS f32x4*)fin_g + lane)[384], ((const GAS f32x4*)fin_g + lane)[448]};
#define P9_IDX(TE, TR, TG, mm) do { TE = *(const int4*)(TOKE + (mm) * 4); TR = *(const int4*)(TOKR + (mm) * 4); TG = *(const f32x4*)(TOKG + (mm) * 4); } while (0)
#define P9_ROWS(V, YY, TE, TR, mm) do { const GAS f32x4* xr_ = (const GAS f32x4*)(X1 + (size_t)(mm) * DM) + lane; _Pragma("unroll") for (int j = 0; j < 8; ++j) V[j] = __builtin_nontemporal_load(xr_ + 64 * j); \
            const int ee_[4] = {TE.x, TE.y, TE.z, TE.w}, rr_[4] = {TR.x, TR.y, TR.z, TR.w}; \
            _Pragma("unroll") for (int k = 0; k < TOPK; ++k) { const GAS unsigned* yr_ = (const GAS unsigned*)((const unsigned char*)YB + ((size_t)ee_[k] * NTOK + rr_[k]) * DM) + lane; \
                _Pragma("unroll") for (int j = 0; j < 8; ++j) YY[k][j] = __builtin_nontemporal_load(yr_ + 64 * j); } } while (0)
        int4 te0, tr0, te1, tr1; f32x4 tg0, tg1; f32x4 v[8]; unsigned yy[4][8];
        if (gw < NTOK) { P9_IDX(te0, tr0, tg0, gw); const int m1 = (gw + NGW < NTOK) ? gw + NGW : gw; P9_IDX(te1, tr1, tg1, m1); P9_ROWS(v, yy, te0, tr0, gw); }
        for (int m = gw; m < NTOK; m += NGW) {
            const int mn = (m + NGW < NTOK) ? m + NGW : m, mnn = (m + 2 * NGW < NTOK) ? m + 2 * NGW : mn;
            int4 te2, tr2; f32x4 tg2; P9_IDX(te2, tr2, tg2, mnn);
            f32x4 nv[8]; unsigned nyy[4][8]; P9_ROWS(nv, nyy, te1, tr1, mn);
            const f32x4 tg = tg0;
#pragma unroll
            for (int k = 0; k < TOPK; ++k) { const float gt = tg[k] * (1.0f / 16.0f);
#pragma unroll
                for (int j = 0; j < 8; ++j) { typedef float f32x2y __attribute__((ext_vector_type(2))); const f32x2y lo = __builtin_amdgcn_cvt_pk_f32_fp8((int)yy[k][j], false), hi = __builtin_amdgcn_cvt_pk_f32_fp8((int)yy[k][j], true);
                    v[j].x += gt * lo.x; v[j].y += gt * lo.y; v[j].z += gt * hi.x; v[j].w += gt * hi.y; } }
            float s = 0.f;
#pragma unroll
            for (int j = 0; j < 8; ++j) s += (v[j].x * v[j].x + v[j].y * v[j].y) + (v[j].z * v[j].z + v[j].w * v[j].w);
            float rstd = 1.0f / sqrtf(wave_sum(s) * (1.0f / DM) + EPS);
            if (poison) rstd = __builtin_nanf("");
            GAS f32x4* orow = (GAS f32x4*)(out + (size_t)m * DM) + lane;
#pragma unroll
            for (int j = 0; j < 8; ++j) { const f32x4 gg = g8[j]; f32x4 o; o.x = v[j].x * rstd * gg.x; o.y = v[j].y * rstd * gg.y; o.z = v[j].z * rstd * gg.z; o.w = v[j].w * rstd * gg.w; __builtin_nontemporal_store(o, orow + 64 * j); }
#pragma unroll
            for (int j = 0; j < 8; ++j) { v[j] = nv[j];
#pragma unroll
                for (int k = 0; k < TOPK; ++k) yy[k][j] = nyy[k][j]; }
            te0 = te1; tr0 = tr1; tg0 = tg1; te1 = te2; tr1 = tr2; tg1 = tg2;
        }
#undef P9_IDX
#undef P9_ROWS
        AMP_END(9);
    }
#undef IN
#undef BOTH
#undef GRID_BAR
}

extern "C" void kernel_launch(void* const* d_in, const int* in_sizes, int n_in, void* d_out, int out_size, void* d_ws, size_t ws_size, hipStream_t stream) {
    static int grid = 0;
    if (grid == 0) {
        if (n_in != 15 || in_sizes[0] != NTOK * DM || out_size != NTOK * DM || ws_size < WS_END) { fprintf(stderr, "kernel_launch: unexpected shapes / workspace (n_in %d, ws %zu)\n", n_in, ws_size); grid = -1; return; }
        int dev = 0, cus = 0, per_cu = 0;
        if (hipGetDevice(&dev) != hipSuccess || hipDeviceGetAttribute(&cus, hipDeviceAttributeMultiprocessorCount, dev) != hipSuccess) { grid = -1; return; }
        if (hipFuncSetAttribute((const void*)fwd, hipFuncAttributeMaxDynamicSharedMemorySize, LDS_BYTES) != hipSuccess) { fprintf(stderr, "kernel_launch: hipFuncSetAttribute failed\n"); grid = -1; return; }
        if (hipOccupancyMaxActiveBlocksPerMultiprocessor(&per_cu, (const void*)fwd, NWAVES * 64, LDS_BYTES) != hipSuccess || per_cu < 1) fprintf(stderr, "kernel_launch: occupancy query says %d\n", per_cu);
        (void)hipGetLastError();
        grid = cus;
    }
    if (grid < 0) return;
    if (hipMemsetAsync((char*)d_ws + WS_CTL, 0, CTL_ZERO_BYTES, stream) != hipSuccess) return;
    Args a{};
    for (int i = 0; i < 15; ++i) a.in[i] = (const float*)d_in[i];
    a.out = (float*)d_out; a.ws = (unsigned char*)d_ws;
    if (MK_N_LAUNCHES == 1) { a.ph_lo = 0; a.ph_hi = NPH; hipLaunchKernelGGL(fwd, dim3(grid), dim3(NWAVES * 64), LDS_BYTES, stream, a); }
    else { for (int p = 0; p < NPH; ++p) { a.ph_lo = p; a.ph_hi = p + 1; hipLaunchKernelGGL(fwd, dim3(grid), dim3(NWAVES * 64), LDS_BYTES, stream, a); } }
    const hipError_t le = hipPeekAtLastError();
    if (le != hipSuccess) fprintf(stderr, "kernel_launch: launch failed: %s\n", hipGetErrorName(le));
}
```
